# Optimizing an MI355X kernel written in HIP

```python
import jax
import jax.numpy as jnp
from jax import lax
import numpy as np


D_MODEL = 2048
BATCH = 2
SEQ = 4096
DEPTH = 2

GRID_W = 64
CTX_LEN = 256
N_MIXERS = 4
GROUP_WIDTH = D_MODEL // N_MIXERS
HEAD_DIM = 64
N_HEADS = GROUP_WIDTH // HEAD_DIM
N_KV_HEADS = 2
GQA_GROUP = N_HEADS // N_KV_HEADS
Q_DIM = N_HEADS * HEAD_DIM
KV_DIM = N_KV_HEADS * HEAD_DIM
WINDOW = 128
BLOCK = 128
ROPE_BASE = 10000.0
ROPE_AXIS_DIM = HEAD_DIM // 2
FNET_DIM = GROUP_WIDTH
FNET_GROUPS = 4
FNET_GROUP_DIM = FNET_DIM // FNET_GROUPS
SCONV_DIM = GROUP_WIDTH
SCONV_WIDTH = 3
CONF_DIM = GROUP_WIDTH
CONF_WIDTH = 31
IN_DIM = Q_DIM + 2 * KV_DIM + FNET_DIM + 3 * SCONV_DIM + 2 * CONF_DIM
MIX_DIM = Q_DIM + FNET_DIM + SCONV_DIM + CONF_DIM
N_EXPERT_GROUPS = 4
EXPERTS_PER_GROUP = 4
N_EXPERTS = N_EXPERT_GROUPS * EXPERTS_PER_GROUP
TOP_K = 2
D_EXPERT = D_MODEL // 4
N_MOD = 6
NORM_EPS = 1e-6
NEG_INF = -1e30

kernel_name = 'hybrid_parallel_mixer_dit_block'


def rmsnorm(x, g):
    xf = x.astype(jnp.float32)
    y = xf * lax.rsqrt(jnp.mean(xf * xf, axis=-1, keepdims=True) + NORM_EPS)
    return (y * g.astype(jnp.float32)).astype(x.dtype)


def layernorm(x, g, b):
    xf = x.astype(jnp.float32)
    mu = jnp.mean(xf, axis=-1, keepdims=True)
    var = jnp.mean(jnp.square(xf - mu), axis=-1, keepdims=True)
    y = (xf - mu) * lax.rsqrt(var + NORM_EPS) * g.astype(jnp.float32) + b.astype(jnp.float32)
    return y.astype(x.dtype)


def modulate(h, shift, scale):
    return h * (1 + scale) + shift


def split_in(u):
    sizes = (Q_DIM, KV_DIM, KV_DIM, FNET_DIM, SCONV_DIM, SCONV_DIM, SCONV_DIM, CONF_DIM, CONF_DIM)
    offs = []
    acc = 0
    for s in sizes[:-1]:
        acc += s
        offs.append(acc)
    return jnp.split(u, offs, axis=-1)


def rope_tables(rows, dtype):
    row = jnp.repeat(jnp.arange(rows, dtype=jnp.float32), GRID_W)
    col = jnp.tile(jnp.arange(GRID_W, dtype=jnp.float32), rows)
    freqs = ROPE_BASE ** (-jnp.arange(0, ROPE_AXIS_DIM, 2, dtype=jnp.float32) / ROPE_AXIS_DIM)
    ang_r = row[:, None] * freqs
    ang_c = col[:, None] * freqs
    return (jnp.cos(ang_r).astype(dtype), jnp.sin(ang_r).astype(dtype),
            jnp.cos(ang_c).astype(dtype), jnp.sin(ang_c).astype(dtype))


def rotate_axis(z, cos, sin):
    half = ROPE_AXIS_DIM // 2
    z1, z2 = z[..., :half], z[..., half:]
    cos = cos[None, :, None, :]
    sin = sin[None, :, None, :]
    return jnp.concatenate([z1 * cos - z2 * sin, z1 * sin + z2 * cos], axis=-1)


def apply_rope_2d(x, tables):
    cos_r, sin_r, cos_c, sin_c = tables
    return jnp.concatenate([rotate_axis(x[..., :ROPE_AXIS_DIM], cos_r, sin_r),
                            rotate_axis(x[..., ROPE_AXIS_DIM:], cos_c, sin_c)], axis=-1)


def depthwise_conv(x, w):
    return lax.conv_general_dilated(x, w[:, None, :].astype(x.dtype), window_strides=(1,), padding='SAME',
                                    dimension_numbers=('NWC', 'WIO', 'NWC'), feature_group_count=x.shape[-1])


def latent_window_attention(q, k, v, kc, vc, sink):
    B, S = q.shape[0], q.shape[1]
    nb = S // BLOCK
    scale = HEAD_DIM ** -0.5
    qb = q.reshape(B, nb, BLOCK, N_KV_HEADS, GQA_GROUP, HEAD_DIM)

    def band(t):
        tp = jnp.pad(t, ((0, 0), (BLOCK, BLOCK), (0, 0), (0, 0))).reshape(B, nb + 2, BLOCK, N_KV_HEADS, HEAD_DIM)
        return jnp.concatenate([tp[:, :-2], tp[:, 1:-1], tp[:, 2:]], axis=2)

    kw, vw = band(k), band(v)
    s_loc = jnp.einsum('bnqhgd,bnjhd->bnhgqj', qb, kw).astype(jnp.float32) * scale
    s_ctx = jnp.einsum('bnqhgd,blhd->bnhgql', qb, kc).astype(jnp.float32) * scale
    qi = jnp.arange(BLOCK)[:, None]
    kj = jnp.arange(3 * BLOCK)[None, :]
    rel = kj - BLOCK - qi
    kpos = (jnp.arange(nb) * BLOCK - BLOCK)[:, None, None] + kj[None]
    valid = (jnp.abs(rel) <= WINDOW)[None] & (kpos >= 0) & (kpos < S)
    s_loc = jnp.where(valid[None, :, None, None], s_loc, NEG_INF)
    sink_l = jnp.broadcast_to(sink.astype(jnp.float32).reshape(1, 1, N_KV_HEADS, GQA_GROUP, 1, 1),
                              s_loc.shape[:-1] + (1,))
    p = jax.nn.softmax(jnp.concatenate([s_loc, s_ctx, sink_l], axis=-1), axis=-1).astype(v.dtype)
    n_loc = 3 * BLOCK
    n_ctx = kc.shape[1]
    o = (jnp.einsum('bnhgqj,bnjhd->bnqhgd', p[..., :n_loc], vw)
         + jnp.einsum('bnhgql,blhd->bnqhgd', p[..., n_loc:n_loc + n_ctx], vc))
    return o.reshape(B, S, Q_DIM)


def context_attention(qc, kc, vc, sink):
    B, L = qc.shape[0], qc.shape[1]
    s = jnp.einsum('blhgd,bmhd->bhglm', qc, kc).astype(jnp.float32) * (HEAD_DIM ** -0.5)
    sink_c = jnp.broadcast_to(sink.astype(jnp.float32).reshape(1, N_KV_HEADS, GQA_GROUP, 1, 1), s.shape[:-1] + (1,))
    p = jax.nn.softmax(jnp.concatenate([s, sink_c], axis=-1), axis=-1)[..., :L].astype(vc.dtype)
    return jnp.einsum('bhglm,bmhd->blhgd', p, vc).reshape(B, L, Q_DIM)


def fourier_mix(f):
    B, T, _ = f.shape
    fg = f.reshape(B, T, FNET_GROUPS, FNET_GROUP_DIM).astype(jnp.float32)
    out = jnp.fft.fftn(fg, axes=(1, 3), norm='ortho').real
    return out.reshape(B, T, FNET_DIM).astype(f.dtype)


def local_mixers(f, sb, sc, sv, da, dg, sconv_w, cconv_w, cconv_b, cnorm_g, cnorm_b):
    o_b = fourier_mix(f)
    o_c = sb * depthwise_conv(sc * sv, sconv_w)
    z = depthwise_conv(da * jax.nn.sigmoid(dg), cconv_w) + cconv_b
    o_d = jax.nn.silu(layernorm(z, cnorm_g, cnorm_b))
    return o_b, o_c, o_d


def hier_moe(h, wg, bg, we, be, w1, w3, w2):
    gl = (h @ wg).astype(jnp.float32) + bg.astype(jnp.float32)
    pg_sel = jnp.max(jax.nn.softmax(gl, axis=-1), axis=-1, keepdims=True)
    gsel = jnp.argmax(gl, axis=-1)
    el = ((h @ we).astype(jnp.float32) + be.astype(jnp.float32)).reshape(h.shape[0], h.shape[1], N_EXPERT_GROUPS, EXPERTS_PER_GROUP)
    el_g = jnp.einsum('btge,btg->bte', el, jax.nn.one_hot(gsel, N_EXPERT_GROUPS, dtype=jnp.float32))
    top_v, top_i = lax.top_k(el_g, TOP_K)
    wk = jax.nn.softmax(top_v, axis=-1) * pg_sel
    eid = gsel[..., None] * EXPERTS_PER_GROUP + top_i
    gates = jnp.sum(jax.nn.one_hot(eid, N_EXPERTS, dtype=jnp.float32) * wk[..., None], axis=-2)
    hid = jax.nn.silu(jnp.einsum('btd,edf->btef', h, w1)) * jnp.einsum('btd,edf->btef', h, w3)
    hid = hid * gates.astype(h.dtype)[..., None]
    return jnp.einsum('btef,efd->btd', hid, w2)


def setup_inputs(seed: int = 0) -> dict:
    key = jax.random.key(seed)
    ks = jax.random.split(key, 24)
    D = D_MODEL

    def nrm(k, shape, s):
        return jax.random.normal(k, shape, jnp.float32) * s

    return {
        'x': nrm(ks[0], (BATCH, SEQ, D), 1.0),
        'c': nrm(ks[1], (BATCH, D), 1.0),
        'ctx': nrm(ks[2], (BATCH, CTX_LEN, D), 1.0),
        'c_ctx': nrm(ks[3], (D,), 1.0),
        'w_mod': nrm(ks[4], (DEPTH, D, N_MOD * D), 0.5 * D ** -0.5),
        'b_mod': nrm(ks[5], (DEPTH, N_MOD * D), 0.02),
        'g_norm1': 1.0 + nrm(ks[6], (DEPTH, D), 0.02),
        'g_norm2': 1.0 + nrm(ks[7], (DEPTH, D), 0.02),
        'w_in': nrm(ks[8], (DEPTH, D, IN_DIM), D ** -0.5),
        'w_out': nrm(ks[9], (DEPTH, MIX_DIM, D), MIX_DIM ** -0.5),
        'attn_sink': nrm(ks[10], (DEPTH, N_HEADS), 0.5),
        'sconv_w': nrm(ks[11], (DEPTH, SCONV_WIDTH, SCONV_DIM), SCONV_WIDTH ** -0.5),
        'cconv_w': nrm(ks[12], (DEPTH, CONF_WIDTH, CONF_DIM), CONF_WIDTH ** -0.5),
        'cconv_b': nrm(ks[13], (DEPTH, CONF_DIM), 0.02),
        'cnorm_g': 1.0 + nrm(ks[14], (DEPTH, CONF_DIM), 0.02),
        'cnorm_b': nrm(ks[15], (DEPTH, CONF_DIM), 0.02),
        'w_route_group': nrm(ks[16], (DEPTH, D, N_EXPERT_GROUPS), D ** -0.5),
        'b_route_group': nrm(ks[17], (DEPTH, N_EXPERT_GROUPS), 0.01),
        'w_route_expert': nrm(ks[18], (DEPTH, D, N_EXPERTS), D ** -0.5),
        'b_route_expert': nrm(ks[19], (DEPTH, N_EXPERTS), 0.01),
        'w_gate_e': nrm(ks[20], (DEPTH, N_EXPERTS, D, D_EXPERT), D ** -0.5),
        'w_up_e': nrm(ks[21], (DEPTH, N_EXPERTS, D, D_EXPERT), D ** -0.5),
        'w_down_e': nrm(ks[22], (DEPTH, N_EXPERTS, D_EXPERT, D), D_EXPERT ** -0.5),
        'g_final': 1.0 + nrm(ks[23], (D,), 0.02),
    }


def reference(x, c, ctx, c_ctx, w_mod, b_mod, g_norm1, g_norm2, w_in, w_out, attn_sink, sconv_w, cconv_w,
              cconv_b, cnorm_g, cnorm_b, w_route_group, b_route_group, w_route_expert, b_route_expert,
              w_gate_e, w_up_e, w_down_e, g_final):
    B, S, _ = x.shape
    L = ctx.shape[1]
    rows = S // GRID_W
    tables = rope_tables(rows, x.dtype)
    xc = ctx
    for l in range(DEPTH):
        last = l == DEPTH - 1
        mod = jax.nn.silu(c) @ w_mod[l] + b_mod[l]
        sh1, sc1, ga1, sh2, sc2, ga2 = [m[:, None, :] for m in jnp.split(mod, N_MOD, axis=-1)]
        modc = jax.nn.silu(c_ctx) @ w_mod[l] + b_mod[l]
        csh1, csc1, cga1, csh2, csc2, cga2 = jnp.split(modc, N_MOD, axis=-1)

        h = modulate(rmsnorm(x, g_norm1[l]), sh1, sc1)
        hc = modulate(rmsnorm(xc, g_norm1[l]), csh1, csc1)
        q, k, v, f, sb, sc, sv, da, dg = split_in(h @ w_in[l])
        if last:
            kc_, vc_ = jnp.split(hc @ w_in[l][:, Q_DIM:Q_DIM + 2 * KV_DIM], 2, axis=-1)
        else:
            qc_, kc_, vc_, fc, sbc, scc, svc, dac, dgc = split_in(hc @ w_in[l])
        kc4 = kc_.reshape(B, L, N_KV_HEADS, HEAD_DIM)
        vc4 = vc_.reshape(B, L, N_KV_HEADS, HEAD_DIM)
        q4 = apply_rope_2d(q.reshape(B, S, N_HEADS, HEAD_DIM), tables).reshape(B, S, N_KV_HEADS, GQA_GROUP, HEAD_DIM)
        k4 = apply_rope_2d(k.reshape(B, S, N_KV_HEADS, HEAD_DIM), tables)
        v4 = v.reshape(B, S, N_KV_HEADS, HEAD_DIM)
        o_a = latent_window_attention(q4, k4, v4, kc4, vc4, attn_sink[l])
        o_b, o_c, o_d = local_mixers(f, sb, sc, sv, da, dg, sconv_w[l], cconv_w[l], cconv_b[l], cnorm_g[l], cnorm_b[l])
        x = x + ga1 * (jnp.concatenate([o_a, o_b, o_c, o_d], axis=-1) @ w_out[l])
        if not last:
            o_ac = context_attention(qc_.reshape(B, L, N_KV_HEADS, GQA_GROUP, HEAD_DIM), kc4, vc4, attn_sink[l])
            o_bc, o_cc, o_dc = local_mixers(fc, sbc, scc, svc, dac, dgc, sconv_w[l], cconv_w[l], cconv_b[l], cnorm_g[l], cnorm_b[l])
            xc = xc + cga1 * (jnp.concatenate([o_ac, o_bc, o_cc, o_dc], axis=-1) @ w_out[l])

        h2 = modulate(rmsnorm(x, g_norm2[l]), sh2, sc2)
        x = x + ga2 * hier_moe(h2, w_route_group[l], b_route_group[l], w_route_expert[l], b_route_expert[l],
                               w_gate_e[l], w_up_e[l], w_down_e[l])
        if not last:
            h2c = modulate(rmsnorm(xc, g_norm2[l]), csh2, csc2)
            xc = xc + cga2 * hier_moe(h2c, w_route_group[l], b_route_group[l], w_route_expert[l], b_route_expert[l],
                                      w_gate_e[l], w_up_e[l], w_down_e[l])
    return rmsnorm(x, g_final)
```

```cpp
#include <hip/hip_runtime.h>
#include <stdint.h>
#include <math.h>

typedef unsigned short bf16_t;
__device__ __forceinline__ float bf2f(bf16_t v) { return __uint_as_float(((unsigned)v) << 16); }
__device__ __forceinline__ bf16_t f2bf(float f) { unsigned u = __float_as_uint(f); return (bf16_t)((u + 0x7fffu + ((u >> 16) & 1u)) >> 16); }

constexpr int D = 2048, SEQ = 4096, CTXL = 256, NBATCH = 2;
constexpr int MLAT = NBATCH * SEQ, MCTX = NBATCH * CTXL, MROWS = MLAT + MCTX;
constexpr int IN_DIM = 3840, NMOD = 6;
constexpr int NEXP = 16, DEXP = 512;
constexpr float QSCALE = 0.125f * 1.4426950408889634f;
constexpr float LOG2E = 1.4426950408889634f;
constexpr int UQ = 0, UK = 512, UV = 640, UF = 768, USB = 1280, USC = 1792, USV = 2304, UDA = 2816, UDG = 3328;

__device__ __forceinline__ int modsel(int row) { return row < SEQ ? 0 : (row < MLAT ? 1 : 2); }
__device__ __forceinline__ void seqinfo(int row, int& base, int& t, int& len) {
    if (row < MLAT) { base = row & ~(SEQ - 1); t = row & (SEQ - 1); len = SEQ; }
    else { int r = row - MLAT; base = MLAT + (r & ~(CTXL - 1)); t = r & (CTXL - 1); len = CTXL; }
}
__device__ __forceinline__ float silu_f(float v) { return v / (1.f + __expf(-v)); }
__device__ __forceinline__ float sigmoid_f(float v) { return 1.f / (1.f + __expf(-v)); }

constexpr size_t MiB = 1u << 20;
constexpr size_t WS_CTL = 0;
constexpr size_t WS_MODP = 1 * MiB;
constexpr size_t WS_MOD = 6 * MiB;
constexpr size_t WS_ROPE = 7 * MiB;
constexpr size_t WS_TOK = 8 * MiB;
constexpr size_t WS_LIST = 9 * MiB;
constexpr size_t WS_X = 16 * MiB;
constexpr size_t WS_H = 88 * MiB;
constexpr size_t WS_U = 124 * MiB;
constexpr size_t WS_MIX = 190 * MiB;
constexpr size_t WS_P = 226 * MiB;
constexpr size_t WS_Q = 244 * MiB;
constexpr size_t WS_HID = 262 * MiB;
constexpr size_t WS_Y2 = 280 * MiB;
constexpr size_t WS_END = 350 * MiB;

__global__ void k_mod_partial(const float* __restrict__ c, const float* __restrict__ c_ctx, const float* __restrict__ w_mod, float* __restrict__ part) {
    const int j = blockIdx.x * 256 + threadIdx.x, l = blockIdx.y, kc = blockIdx.z;
    __shared__ float sc[3][128];
    if (threadIdx.x < 128) {
        const int k = kc * 128 + threadIdx.x;
        sc[0][threadIdx.x] = silu_f(c[k]); sc[1][threadIdx.x] = silu_f(c[D + k]); sc[2][threadIdx.x] = silu_f(c_ctx[k]);
    }
    __syncthreads();
    const float* w = w_mod + ((size_t)l * D + (size_t)kc * 128) * (NMOD * D) + j;
    float a0 = 0.f, a1 = 0.f, a2 = 0.f;
#pragma unroll 8
    for (int k = 0; k < 128; ++k) { const float wv = w[(size_t)k * (NMOD * D)]; a0 += sc[0][k] * wv; a1 += sc[1][k] * wv; a2 += sc[2][k] * wv; }
    float* p = part + (((size_t)kc * 2 + l) * 3) * (NMOD * D) + j;
    p[0] = a0; p[NMOD * D] = a1; p[2 * NMOD * D] = a2;
}
__global__ void k_mod_reduce(const float* __restrict__ part, const float* __restrict__ b_mod, float* __restrict__ modv) {
    const int idx = blockIdx.x * 256 + threadIdx.x;
    if (idx >= 2 * 3 * NMOD * D) return;
    const int j = idx % (NMOD * D), l = idx / (3 * NMOD * D);
    float a = b_mod[l * NMOD * D + j];
    for (int kc = 0; kc < 16; ++kc) a += part[(size_t)kc * (2 * 3 * NMOD * D) + idx];
    modv[idx] = a;
}
__global__ void k_rope_table(float* __restrict__ tab) {
    const int idx = blockIdx.x * 256 + threadIdx.x; if (idx >= 64 * 16) return;
    const int pos = idx >> 4, i = idx & 15;
    const float freq = powf(10000.f, -(float)(2 * i) / 32.f);
    const float ang = (float)pos * freq;
    tab[idx * 2] = cosf(ang); tab[idx * 2 + 1] = sinf(ang);
}
__global__ void k_init_x(const float* __restrict__ x, const float* __restrict__ ctx, float* __restrict__ X) {
    const size_t i = (size_t)blockIdx.x * 256 + threadIdx.x;
    const size_t nlat = (size_t)MLAT * D / 4, ntot = (size_t)MROWS * D / 4;
    if (i >= ntot) return;
    ((float4*)X)[i] = i < nlat ? ((const float4*)x)[i] : ((const float4*)ctx)[i - nlat];
}

__device__ __forceinline__ float wave_sum(float v) {
#pragma unroll
    for (int o = 32; o > 0; o >>= 1) v += __shfl_xor(v, o);
    return v;
}
template <int NW> __device__ __forceinline__ float block_sum(float v, float* red) {
    v = wave_sum(v);
    const int w = threadIdx.x >> 6;
    __syncthreads();
    if ((threadIdx.x & 63) == 0) red[w] = v;
    __syncthreads();
    float s = 0.f;
#pragma unroll
    for (int i = 0; i < NW; ++i) s += red[i];
    return s;
}

struct RouteW { const float* wg; const float* bg; const float* we; const float* be; int* tok_e; float* tok_w; unsigned* cnt; unsigned* list; };
template <bool ROUTE, bool COMBINE>
__global__ void __launch_bounds__(256) k_norm(float* __restrict__ X, const float* __restrict__ g, const float* __restrict__ modv_l, long long sh_idx, bf16_t* __restrict__ H,
                                              const bf16_t* __restrict__ Y2, const float* __restrict__ modv_prev, RouteW R) {
    __shared__ float red[4];
    __shared__ float rl[20][4];
    const int row = blockIdx.x, tid = threadIdx.x, s = modsel(row);
    float v[8];
    float* xr = X + (size_t)row * D;
#pragma unroll
    for (int i = 0; i < 2; ++i) { const float4 t = *(const float4*)(xr + i * 1024 + tid * 4); v[i * 4] = t.x; v[i * 4 + 1] = t.y; v[i * 4 + 2] = t.z; v[i * 4 + 3] = t.w; }
    if (COMBINE) {
        const float* ga = modv_prev + (size_t)s * (NMOD * D) + 5 * D;
#pragma unroll
        for (int i = 0; i < 2; ++i)
#pragma unroll
            for (int j = 0; j < 4; ++j) { const int col = i * 1024 + tid * 4 + j; v[i * 4 + j] += ga[col] * (bf2f(Y2[(size_t)(2 * row) * D + col]) + bf2f(Y2[(size_t)(2 * row + 1) * D + col])); }
#pragma unroll
        for (int i = 0; i < 2; ++i) *(float4*)(xr + i * 1024 + tid * 4) = make_float4(v[i * 4], v[i * 4 + 1], v[i * 4 + 2], v[i * 4 + 3]);
    }
    float ss = 0.f;
#pragma unroll
    for (int i = 0; i < 8; ++i) ss += v[i] * v[i];
    ss = block_sum<4>(ss, red);
    const float rstd = rsqrtf(ss * (1.f / D) + 1e-6f);
    const float* sh = modv_l + (size_t)s * (NMOD * D) + (size_t)sh_idx * D;
    const float* sc = sh + D;
    float hv[8];
#pragma unroll
    for (int i = 0; i < 2; ++i)
#pragma unroll
        for (int j = 0; j < 4; ++j) { const int col = i * 1024 + tid * 4 + j; hv[i * 4 + j] = v[i * 4 + j] * rstd * g[col] * (1.f + sc[col]) + sh[col]; }
#pragma unroll
    for (int i = 0; i < 2; ++i) {
        ushort4 o; o.x = f2bf(hv[i * 4]); o.y = f2bf(hv[i * 4 + 1]); o.z = f2bf(hv[i * 4 + 2]); o.w = f2bf(hv[i * 4 + 3]);
        *(ushort4*)(H + (size_t)row * D + i * 1024 + tid * 4) = o;
    }
    if (ROUTE) {
        float acc[20];
#pragma unroll
        for (int q = 0; q < 20; ++q) acc[q] = 0.f;
#pragma unroll
        for (int i = 0; i < 2; ++i)
#pragma unroll
            for (int j = 0; j < 4; ++j) {
                const int col = i * 1024 + tid * 4 + j; const float hvv = hv[i * 4 + j];
                const float4 wgv = *(const float4*)(R.wg + (size_t)col * 4);
                acc[0] += hvv * wgv.x; acc[1] += hvv * wgv.y; acc[2] += hvv * wgv.z; acc[3] += hvv * wgv.w;
#pragma unroll
                for (int q = 0; q < 4; ++q) { const float4 wv = *(const float4*)(R.we + (size_t)col * 16 + q * 4); acc[4 + q * 4] += hvv * wv.x; acc[5 + q * 4] += hvv * wv.y; acc[6 + q * 4] += hvv * wv.z; acc[7 + q * 4] += hvv * wv.w; }
            }
#pragma unroll
        for (int q = 0; q < 20; ++q) { const float t = wave_sum(acc[q]); if ((tid & 63) == 0) rl[q][tid >> 6] = t; }
        __syncthreads();
        if (tid == 0) {
            float gl[4], el[16];
            for (int q = 0; q < 4; ++q) gl[q] = rl[q][0] + rl[q][1] + rl[q][2] + rl[q][3] + R.bg[q];
            for (int q = 0; q < 16; ++q) el[q] = rl[4 + q][0] + rl[4 + q][1] + rl[4 + q][2] + rl[4 + q][3] + R.be[q];
            int gs = 0; for (int q = 1; q < 4; ++q) if (gl[q] > gl[gs]) gs = q;
            float den = 0.f; for (int q = 0; q < 4; ++q) den += __expf(gl[q] - gl[gs]);
            const float pg = 1.f / den;
            const float* eg = el + gs * 4;
            int i0 = 0; for (int q = 1; q < 4; ++q) if (eg[q] > eg[i0]) i0 = q;
            int i1 = -1; for (int q = 0; q < 4; ++q) if (q != i0 && (i1 < 0 || eg[q] > eg[i1])) i1 = q;
            const float w0 = 1.f / (1.f + __expf(eg[i1] - eg[i0])), w1 = 1.f - w0;
            const int e0 = gs * 4 + i0, e1 = gs * 4 + i1;
            R.tok_e[row * 2] = e0; R.tok_e[row * 2 + 1] = e1; R.tok_w[row * 2] = w0 * pg; R.tok_w[row * 2 + 1] = w1 * pg;
            const unsigned p0 = atomicAdd(R.cnt + e0, 1u); R.list[(size_t)e0 * (2 * MROWS) + p0] = row * 2;
            const unsigned p1 = atomicAdd(R.cnt + e1, 1u); R.list[(size_t)e1 * (2 * MROWS) + p1] = row * 2 + 1;
        }
    }
}

struct ARowsPlain { const bf16_t* A; long long lda; __device__ __forceinline__ const bf16_t* row(int m) const { return A + (size_t)m * lda; } __device__ __forceinline__ int nrows(int M) const { return M; } };
struct ARowsList { const bf16_t* A; long long lda; const unsigned* list; long long shift; const unsigned* cnt; __device__ __forceinline__ const bf16_t* row(int m) const { return A + (size_t)(list[m] >> shift) * lda; } __device__ __forceinline__ int nrows(int) const { return (int)*cnt; } };
template <class AR, class Epi, int NB>
__global__ void __launch_bounds__(256) k_gemm(AR ar, const float* __restrict__ W0, const float* __restrict__ W1, int ldw, int M, int N, int K, Epi epi) {
    __shared__ float As[16][65];
    __shared__ float Bs[NB][16][64];
    const int Mr = ar.nrows(M);
    const int m0 = blockIdx.y * 64, n0 = blockIdx.x * 64;
    if (m0 >= Mr) return;
    const int tid = threadIdx.x, tx = tid & 15, ty = tid >> 4;
    float acc[NB][4][4];
#pragma unroll
    for (int b = 0; b < NB; ++b)
#pragma unroll
        for (int i = 0; i < 4; ++i)
#pragma unroll
            for (int j = 0; j < 4; ++j) acc[b][i][j] = 0.f;
    const int ar_m = tid >> 2, ar_k = (tid & 3) * 4;
    const bool a_ok = (m0 + ar_m) < Mr;
    const bf16_t* arow = a_ok ? ar.row(m0 + ar_m) : nullptr;
    const int br_k = tid >> 4, br_n = (tid & 15) * 4;
    for (int k0 = 0; k0 < K; k0 += 16) {
        ushort4 av = make_ushort4(0, 0, 0, 0);
        if (a_ok) av = *(const ushort4*)(arow + k0 + ar_k);
        As[ar_k][ar_m] = bf2f(av.x); As[ar_k + 1][ar_m] = bf2f(av.y); As[ar_k + 2][ar_m] = bf2f(av.z); As[ar_k + 3][ar_m] = bf2f(av.w);
        { const float4 bv = *(const float4*)(W0 + (size_t)(k0 + br_k) * ldw + n0 + br_n); *(float4*)&Bs[0][br_k][br_n] = bv; }
        if (NB == 2) { const float4 bv = *(const float4*)(W1 + (size_t)(k0 + br_k) * ldw + n0 + br_n); *(float4*)&Bs[NB - 1][br_k][br_n] = bv; }
        __syncthreads();
#pragma unroll
        for (int k = 0; k < 16; ++k) {
            float a[4];
#pragma unroll
            for (int i = 0; i < 4; ++i) a[i] = As[k][ty * 4 + i];
#pragma unroll
            for (int b = 0; b < NB; ++b) {
                const float4 bv = *(const float4*)&Bs[b][k][tx * 4];
#pragma unroll
                for (int i = 0; i < 4; ++i) { acc[b][i][0] += a[i] * bv.x; acc[b][i][1] += a[i] * bv.y; acc[b][i][2] += a[i] * bv.z; acc[b][i][3] += a[i] * bv.w; }
            }
        }
        __syncthreads();
    }
#pragma unroll
    for (int i = 0; i < 4; ++i) { const int m = m0 + ty * 4 + i; if (m < Mr) epi(m, n0 + tx * 4, acc, i); }
}
struct EpiStoreBf16 { bf16_t* C; long long ldc;
    __device__ __forceinline__ void operator()(int m, int n, const float (&acc)[1][4][4], int i) const {
        ushort4 o; o.x = f2bf(acc[0][i][0]); o.y = f2bf(acc[0][i][1]); o.z = f2bf(acc[0][i][2]); o.w = f2bf(acc[0][i][3]); *(ushort4*)(C + (size_t)m * ldc + n) = o; } };
struct EpiResid { float* X; const float* modv_l; long long ga_idx;
    __device__ __forceinline__ void operator()(int m, int n, const float (&acc)[1][4][4], int i) const {
        const float* ga = modv_l + (size_t)modsel(m) * (NMOD * D) + (size_t)ga_idx * D + n; float4* p = (float4*)(X + (size_t)m * D + n); float4 x = *p;
        x.x += ga[0] * acc[0][i][0]; x.y += ga[1] * acc[0][i][1]; x.z += ga[2] * acc[0][i][2]; x.w += ga[3] * acc[0][i][3]; *p = x; } };
struct EpiMoeUp { bf16_t* Hid; const unsigned* list; const float* tok_w;
    __device__ __forceinline__ void operator()(int m, int n, const float (&acc)[2][4][4], int i) const {
        const unsigned ent = list[m]; const float w = tok_w[ent]; ushort4 o;
        o.x = f2bf(silu_f(acc[0][i][0]) * acc[1][i][0] * w); o.y = f2bf(silu_f(acc[0][i][1]) * acc[1][i][1] * w); o.z = f2bf(silu_f(acc[0][i][2]) * acc[1][i][2] * w); o.w = f2bf(silu_f(acc[0][i][3]) * acc[1][i][3] * w);
        *(ushort4*)(Hid + (size_t)ent * DEXP + n) = o; } };
struct EpiMoeDown { bf16_t* Y2; const unsigned* list;
    __device__ __forceinline__ void operator()(int m, int n, const float (&acc)[1][4][4], int i) const {
        const unsigned ent = list[m]; ushort4 o; o.x = f2bf(acc[0][i][0]); o.y = f2bf(acc[0][i][1]); o.z = f2bf(acc[0][i][2]); o.w = f2bf(acc[0][i][3]); *(ushort4*)(Y2 + (size_t)ent * D + n) = o; } };

__global__ void k_rope(bf16_t* __restrict__ U, const float* __restrict__ tab, long long nrows_) {
    const int idx = blockIdx.x * 256 + threadIdx.x;
    const int nrows = (int)nrows_; if (idx >= nrows * 320) return;
    const int row = idx / 320, r = idx % 320, hs = r >> 5, i = r & 31;
    const int axis = i >> 4, fi = i & 15;
    const int col0 = hs * 64 + axis * 32 + fi;
    bf16_t* p = U + (size_t)row * IN_DIM + col0;
    float z1 = bf2f(p[0]), z2 = bf2f(p[16]);
    const float sc = hs < 8 ? QSCALE : 1.f;
    if (row < MLAT) {
        const int t = row & (SEQ - 1); const int pos = axis ? (t & 63) : (t >> 6);
        const float c = tab[(pos * 16 + fi) * 2], s = tab[(pos * 16 + fi) * 2 + 1];
        const float o1 = z1 * c - z2 * s, o2 = z1 * s + z2 * c; z1 = o1; z2 = o2;
    }
    p[0] = f2bf(z1 * sc); p[16] = f2bf(z2 * sc);
}

__global__ void __launch_bounds__(64) k_attn(const bf16_t* __restrict__ U, const float* __restrict__ sink, bf16_t* __restrict__ MIX) {
    __shared__ float qs[64];
    __shared__ float ps[576];
    const int row = blockIdx.x, h = blockIdx.y, kvh = h >> 2, lane = threadIdx.x;
    int base, t, len; seqinfo(row, base, t, len);
    const int b = row < MLAT ? (row >> 12) : ((row - MLAT) >> 8);
    qs[lane] = bf2f(U[(size_t)row * IN_DIM + UQ + h * 64 + lane]);
    __syncthreads();
    int lo = 0, nloc = 0;
    if (row < MLAT) { lo = max(0, t - 128); const int hi = min(SEQ - 1, t + 128); nloc = hi - lo + 1; }
    const int nk = nloc + CTXL;
    const int cbase = MLAT + b * CTXL;
    float mx = sink[h] * LOG2E;
    for (int j = lane; j < nk; j += 64) {
        const int krow = j < nloc ? (base + lo + j) : (cbase + j - nloc);
        const bf16_t* kp = U + (size_t)krow * IN_DIM + UK + kvh * 64;
        float s = 0.f;
#pragma unroll 8
        for (int d = 0; d < 64; ++d) s += qs[d] * bf2f(kp[d]);
        ps[j] = s; mx = fmaxf(mx, s);
    }
#pragma unroll
    for (int o = 32; o > 0; o >>= 1) mx = fmaxf(mx, __shfl_xor(mx, o));
    float sum = 0.f;
    for (int j = lane; j < nk; j += 64) { const float p = exp2f(ps[j] - mx); ps[j] = p; sum += p; }
    sum = wave_sum(sum) + exp2f(sink[h] * LOG2E - mx);
    __syncthreads();
    float o = 0.f;
    for (int j = 0; j < nk; ++j) {
        const int krow = j < nloc ? (base + lo + j) : (cbase + j - nloc);
        o += ps[j] * bf2f(U[(size_t)krow * IN_DIM + UV + kvh * 64 + lane]);
    }
    MIX[(size_t)row * D + h * 64 + lane] = f2bf(o / sum);
}

__global__ void k_dftA(const bf16_t* __restrict__ U, float* __restrict__ P, float* __restrict__ Q) {
    __shared__ float ct[128], st[128];
    __shared__ float f[512];
    const int row = blockIdx.x, tid = threadIdx.x;
    if (tid < 128) { const float a = 6.283185307179586f * (float)tid / 128.f; ct[tid] = cosf(a); st[tid] = sinf(a); }
    f[tid] = bf2f(U[(size_t)row * IN_DIM + UF + tid]);
    __syncthreads();
    const int g = tid >> 7, cp = tid & 127;
    float p = 0.f, q = 0.f;
    for (int c = 0; c < 128; ++c) { const int k = (c * cp) & 127; const float fv = f[g * 128 + c]; p += fv * ct[k]; q += fv * st[k]; }
    P[(size_t)row * 512 + tid] = p; Q[(size_t)row * 512 + tid] = q;
}
__global__ void __launch_bounds__(256) k_dftB(const float* __restrict__ P, const float* __restrict__ Q, bf16_t* __restrict__ MIX, int T, int row0, int tabstep, int pad_) {
    __shared__ float ct[4096], st[4096];
    __shared__ float Ps[16][64], Qs[16][64];
    const int tid = threadIdx.x, tx = tid & 15, ty = tid >> 4;
    for (int i = tid; i < 4096; i += 256) { const float a = 6.283185307179586f * (float)i / 4096.f; ct[i] = cosf(a); st[i] = sinf(a); }
    const int n0 = blockIdx.x * 64, tp0 = blockIdx.y * 64, sbase = row0 + blockIdx.z * T;
    float acc[4][4];
#pragma unroll
    for (int i = 0; i < 4; ++i)
#pragma unroll
        for (int j = 0; j < 4; ++j) acc[i][j] = 0.f;
    const int lk = tid >> 4, ln = (tid & 15) * 4;
    for (int t0 = 0; t0 < T; t0 += 16) {
        __syncthreads();
        *(float4*)&Ps[lk][ln] = *(const float4*)(P + (size_t)(sbase + t0 + lk) * 512 + n0 + ln);
        *(float4*)&Qs[lk][ln] = *(const float4*)(Q + (size_t)(sbase + t0 + lk) * 512 + n0 + ln);
        __syncthreads();
#pragma unroll 4
        for (int k = 0; k < 16; ++k) {
            const float4 pv = *(const float4*)&Ps[k][tx * 4], qv = *(const float4*)&Qs[k][tx * 4];
#pragma unroll
            for (int i = 0; i < 4; ++i) {
                const int tp = tp0 + ty * 4 + i; const int idx = (((t0 + k) * tp) & (T - 1)) * tabstep;
                const float c = ct[idx], s = st[idx];
                acc[i][0] += c * pv.x - s * qv.x; acc[i][1] += c * pv.y - s * qv.y; acc[i][2] += c * pv.z - s * qv.z; acc[i][3] += c * pv.w - s * qv.w;
            }
        }
    }
    const float scale = rsqrtf((float)T * 128.f);
#pragma unroll
    for (int i = 0; i < 4; ++i) {
        const int tp = tp0 + ty * 4 + i; ushort4 o; o.x = f2bf(acc[i][0] * scale); o.y = f2bf(acc[i][1] * scale); o.z = f2bf(acc[i][2] * scale); o.w = f2bf(acc[i][3] * scale);
        *(ushort4*)(MIX + (size_t)(sbase + tp) * D + 512 + n0 + tx * 4) = o;
    }
}

__global__ void __launch_bounds__(512) k_convs(const bf16_t* __restrict__ U, const float* __restrict__ sw, const float* __restrict__ cw, const float* __restrict__ cb,
                                               const float* __restrict__ ng, const float* __restrict__ nb, bf16_t* __restrict__ MIX) {
    __shared__ float red[8];
    const int row = blockIdx.x, c = threadIdx.x;
    int base, t, len; seqinfo(row, base, t, len);
    float a = 0.f;
#pragma unroll
    for (int j = 0; j < 3; ++j) { const int tt = t + j - 1; if (tt >= 0 && tt < len) { const bf16_t* u = U + (size_t)(base + tt) * IN_DIM; a += sw[j * 512 + c] * bf2f(u[USC + c]) * bf2f(u[USV + c]); } }
    a *= bf2f(U[(size_t)row * IN_DIM + USB + c]);
    MIX[(size_t)row * D + 1024 + c] = f2bf(a);
    float z = cb[c];
    for (int j = 0; j < 31; ++j) { const int tt = t + j - 15; if (tt >= 0 && tt < len) { const bf16_t* u = U + (size_t)(base + tt) * IN_DIM; z += cw[j * 512 + c] * bf2f(u[UDA + c]) * sigmoid_f(bf2f(u[UDG + c])); } }
    const float mu = block_sum<8>(z, red) * (1.f / 512.f);
    const float dz = z - mu;
    const float var = block_sum<8>(dz * dz, red) * (1.f / 512.f);
    const float y = dz * rsqrtf(var + 1e-6f) * ng[c] + nb[c];
    MIX[(size_t)row * D + 1536 + c] = f2bf(silu_f(y));
}

__global__ void __launch_bounds__(256) k_final(const float* __restrict__ X, const float* __restrict__ g, const bf16_t* __restrict__ Y2, const float* __restrict__ modv_prev, float* __restrict__ out) {
    __shared__ float red[4];
    const int row = blockIdx.x, tid = threadIdx.x, s = modsel(row);
    const float* ga = modv_prev + (size_t)s * (NMOD * D) + 5 * D;
    float v[8];
#pragma unroll
    for (int i = 0; i < 2; ++i)
#pragma unroll
        for (int j = 0; j < 4; ++j) { const int col = i * 1024 + tid * 4 + j; v[i * 4 + j] = X[(size_t)row * D + col] + ga[col] * (bf2f(Y2[(size_t)(2 * row) * D + col]) + bf2f(Y2[(size_t)(2 * row + 1) * D + col])); }
    float ss = 0.f;
#pragma unroll
    for (int i = 0; i < 8; ++i) ss += v[i] * v[i];
    ss = block_sum<4>(ss, red);
    const float rstd = rsqrtf(ss * (1.f / D) + 1e-6f);
#pragma unroll
    for (int i = 0; i < 2; ++i) { const int col = i * 1024 + tid * 4; *(float4*)(out + (size_t)row * D + col) = make_float4(v[i * 4] * rstd * g[col], v[i * 4 + 1] * rstd * g[col + 1], v[i * 4 + 2] * rstd * g[col + 2], v[i * 4 + 3] * rstd * g[col + 3]); }
}


namespace pg8 {
#define PG8_LAS __attribute__((address_space(3)))
typedef short bf16x8 __attribute__((ext_vector_type(8)));
typedef float f32x4 __attribute__((ext_vector_type(4)));
typedef unsigned u32x4 __attribute__((ext_vector_type(4)));
typedef unsigned u32x2 __attribute__((ext_vector_type(2)));
constexpr int BM = 256, BK = 64, HALF = 128, HTB = HALF * BK * 2, STAGE_BYTES = 8 * HTB, NXCD = 8, WGM = 8;
__host__ __device__ __forceinline__ int lds_byte(int r, int c) { const int st = (r >> 4) * 2 + (c >> 5), rr = r & 15, cc = c & 31, ob = rr * 64 + cc * 2; return st * 1024 + (ob ^ (((ob >> 9) & 1) << 5)); }
__host__ __device__ __forceinline__ void stage_rc(int b, int& R, int& C) { const int st = b / 1024, sb = b % 1024, swz = sb ^ (((sb >> 9) & 1) << 5); R = (st >> 1) * 16 + swz / 64; C = (st & 1) * 32 + (swz % 64) / 2; }
__host__ __device__ __forceinline__ int perm32(int rho) { const int n = rho >> 4, i = rho & 15; return 8 * (i >> 2) + 4 * n + (i & 3); }

struct Unit { int pm, pn, grp, aux; };
struct Prob {
    const bf16_t* A; const bf16_t* Bt; int lda, ldb, K, pad;
    long long a_pm, a_grp, a_aux, b_pn, b_grp, b_aux;
    __device__ __forceinline__ const char* a_base(const Unit& u) const { return (const char*)(A + (long long)u.pm * a_pm + (long long)u.grp * a_grp + (long long)u.aux * a_aux); }
    __device__ __forceinline__ const char* b_base(const Unit& u) const { return (const char*)(Bt + (long long)u.pn * b_pn + (long long)u.grp * b_grp + (long long)u.aux * b_aux); }
};
struct StaticOrder {
    int nM, nN, nwg, G, c;
    __device__ void init(int nM_, int nN_, int G_, int c_) { nM = nM_; nN = nN_; nwg = nM * nN; G = G_; c = c_; }
    __device__ bool next(int i, Unit& u) const {
        const long L = (long)i * G + c; if (L >= nwg) return false;
        int wgid = (int)L; { const int q = nwg / NXCD, r = nwg % NXCD, xcd = wgid % NXCD, off = wgid / NXCD; wgid = (xcd < r ? xcd * (q + 1) : r * (q + 1) + (xcd - r) * q) + off; }
        const int nig = WGM * nN, gid = wgid / nig, fm = gid * WGM, gsz = (nM - fm) < WGM ? (nM - fm) : WGM;
        u.pm = fm + ((wgid % nig) % gsz); u.pn = (wgid % nig) / gsz; u.grp = 0; u.aux = 0; return true;
    }
};
struct ListSched {
    const PG8_LAS int* ul; int n;
    __device__ bool next(int i, Unit& u) const {
        if (i >= n) return false;
        u.pm = __builtin_amdgcn_readfirstlane(ul[i * 4]); u.pn = __builtin_amdgcn_readfirstlane(ul[i * 4 + 1]); u.grp = __builtin_amdgcn_readfirstlane(ul[i * 4 + 2]); u.aux = __builtin_amdgcn_readfirstlane(ul[i * 4 + 3]); return true;
    }
};
struct DftASched { int n, G, c, pad;
    __device__ bool next(int i, Unit& u) const { const int L = i * G + c; if (L >= n) return false; u.pm = 0; u.pn = L >> 2; u.grp = L & 3; u.aux = 0; return true; } };
struct DftBSched { int n, G, c, mode;
    __device__ bool next(int i, Unit& u) const { const int L = i * G + c; if (L >= n) return false;
        if (mode == 0) { const int x = L & 7, idx = L >> 3; u.aux = x & 3; u.pm = (x >> 2) * 8 + (idx & 7); u.grp = (idx >> 3) & 1; u.pn = idx >> 4; }
        else { u.grp = L >> 1; u.pn = L & 1; u.pm = 0; u.aux = 0; } return true; } };
__device__ __forceinline__ unsigned cvt_pk_bf16(float lo, float hi) { unsigned r; asm volatile("v_cvt_pk_bf16_f32 %0, %1, %2" : "=v"(r) : "v"(lo), "v"(hi)); return r; }

template <class Epi, class Sched, bool GATHER, bool ALIGN_EPI>
__device__ __forceinline__ void gemm_phase(PG8_LAS unsigned char* lds, const Prob P, const Sched& S, const Epi& E, const PG8_LAS unsigned* rows_lds) {
    int tid_ = threadIdx.x; asm volatile("" : "+v"(tid_));
    const int tid = tid_, wid = __builtin_amdgcn_readfirstlane(tid >> 6), lane = tid & 63, wr = wid >> 2, wc = wid & 3, fr = lane & 15, fq = lane >> 4;
    const int K = P.K, nt = K / BK;
    int Rr[2], Cc[2];
    unsigned voB[2], voA[2][2];
#pragma unroll
    for (int i = 0; i < 2; ++i) { int R, C; stage_rc(tid * 16 + i * 8192, R, C); Rr[i] = R; Cc[i] = C; const int Rb = Epi::PERM ? ((R & ~31) + perm32(R & 31)) : R;
        voB[i] = (unsigned)(Rb * P.ldb + C) * 2u; }
#define PG8_SETVOA(slot) do { _Pragma("unroll") for (int _h = 0; _h < 2; ++_h) _Pragma("unroll") for (int _i = 0; _i < 2; ++_i) { \
        unsigned _row = (unsigned)(_h * HALF + Rr[_i]); if (GATHER) { const unsigned _e = rows_lds[(slot) * 256 + _h * HALF + Rr[_i]]; _row = (_e == 0xFFFFFFFFu) ? 0u : (_e >> 1); } \
        voA[_h][_i] = (_row * (unsigned)P.lda + (unsigned)Cc[_i]) * 2u; } } while (0)
    const size_t kstep = (size_t)(BK * 2);
    const size_t hstepB = (size_t)HALF * P.ldb * 2;
    const unsigned ldsw = (unsigned)wid * 1024u;
    const int aoff = lds_byte(wr * 64 + fr, fq * 8), boff = lds_byte(wc * 32 + fr, fq * 8);
#define PG8_SA(b, h) (((b) * 2 + (h)) * HTB)
#define PG8_SB(b, h) ((4 + (b) * 2 + (h)) * HTB)
#define PG8_STAGE(bufoff, gbase, voff) do { _Pragma("unroll") for (int _i = 0; _i < 2; ++_i) \
        __builtin_amdgcn_global_load_lds((const unsigned*)((const char*)(gbase) + (voff)[_i]), (PG8_LAS unsigned*)(lds + (bufoff) + ldsw + _i * 8192), 16, 0, 0); } while (0)
#define PG8_LDA(dst, b, h) do { _Pragma("unroll") for (int m = 0; m < 4; ++m) _Pragma("unroll") for (int k = 0; k < 2; ++k) dst[m][k] = *(const PG8_LAS bf16x8*)(lds + PG8_SA(b, h) + aoff + m * 2048 + k * 1024); } while (0)
#define PG8_LDB(dst, b, h) do { _Pragma("unroll") for (int n = 0; n < 2; ++n) _Pragma("unroll") for (int k = 0; k < 2; ++k) dst[n][k] = *(const PG8_LAS bf16x8*)(lds + PG8_SB(b, h) + boff + n * 2048 + k * 1024); } while (0)
#define PG8_MMA(ai, bj, At, Bt) do { __builtin_amdgcn_s_setprio(1); _Pragma("unroll") for (int m = 0; m < 4; ++m) _Pragma("unroll") for (int n = 0; n < 2; ++n) _Pragma("unroll") for (int k = 0; k < 2; ++k) \
        acc[ai][bj][m][n] = __builtin_amdgcn_mfma_f32_16x16x32_bf16(Bt[n][k], At[m][k], acc[ai][bj][m][n], 0, 0, 0); __builtin_amdgcn_s_setprio(0); } while (0)
#define PG8_WAIT_V(n) asm volatile("s_waitcnt vmcnt(" #n ")" ::: "memory")
#define PG8_WAIT_L(n) asm volatile("s_waitcnt lgkmcnt(" #n ")" ::: "memory")
#define PG8_BAR __builtin_amdgcn_s_barrier()
#define PG8_SCHED __builtin_amdgcn_sched_barrier(0)
    Unit cur, nxt; int ui = 0;
    if (!S.next(0, cur)) return;
    f32x4 acc[2][2][4][2];
#pragma unroll
    for (int a = 0; a < 2; ++a)
#pragma unroll
        for (int b = 0; b < 2; ++b)
#pragma unroll
            for (int m = 0; m < 4; ++m)
#pragma unroll
                for (int n = 0; n < 2; ++n) acc[a][b][m][n] = (f32x4){0.f, 0.f, 0.f, 0.f};
    bf16x8 At[4][2], B0[2][2], B1[2][2];
    const char* cA = P.a_base(cur); const char* cB = P.b_base(cur);
    PG8_SETVOA(0);
    PG8_STAGE(PG8_SB(0, 0), cB, voB); PG8_STAGE(PG8_SB(0, 1), cB + hstepB, voB); PG8_STAGE(PG8_SA(0, 0), cA, voA[0]); PG8_STAGE(PG8_SA(0, 1), cA, voA[1]);
    if (wr == 1) PG8_BAR;
    PG8_WAIT_V(2); PG8_BAR;
    PG8_STAGE(PG8_SB(1, 0), cB + kstep, voB); PG8_STAGE(PG8_SA(1, 0), cA + kstep, voA[0]); PG8_STAGE(PG8_SB(1, 1), cB + hstepB + kstep, voB);
    PG8_WAIT_V(6); PG8_BAR;
    for (;;) {
        const bool has_next = S.next(ui + 1, nxt);
        const char* nA = has_next ? P.a_base(nxt) : cA; const char* nB = has_next ? P.b_base(nxt) : cB;
        for (int t = 0; t < nt; t += 2) {
            const bool last = (t == nt - 2);
            const char* a1 = cA + (size_t)(t + 1) * kstep;
            const char* a2 = last ? nA : cA + (size_t)(t + 2) * kstep; const char* b2 = last ? nB : cB + (size_t)(t + 2) * kstep;
            const char* a3 = a2 + kstep; const char* b3 = b2 + kstep;
            PG8_LDB(B0, 0, 0); PG8_LDB(B1, 0, 1); PG8_SCHED; PG8_LDA(At, 0, 0); PG8_STAGE(PG8_SA(1, 1), a1, voA[1]);
            PG8_WAIT_V(8); PG8_WAIT_L(0); PG8_BAR; PG8_MMA(0, 0, At, B0); PG8_MMA(0, 1, At, B1); PG8_BAR; PG8_SCHED;
            if (GATHER) { if (last && has_next) { PG8_SETVOA(ui + 1); } }
            PG8_LDA(At, 0, 1); PG8_STAGE(PG8_SB(0, 0), b2, voB); PG8_STAGE(PG8_SB(0, 1), b2 + hstepB, voB); PG8_STAGE(PG8_SA(0, 0), a2, voA[0]);
            PG8_WAIT_V(8); PG8_WAIT_L(0); PG8_BAR; PG8_MMA(1, 0, At, B0); PG8_MMA(1, 1, At, B1); PG8_BAR; PG8_SCHED;
            PG8_LDB(B0, 1, 0); PG8_LDB(B1, 1, 1); PG8_SCHED; PG8_LDA(At, 1, 0); PG8_STAGE(PG8_SA(0, 1), a2, voA[1]);
            PG8_WAIT_V(8); PG8_WAIT_L(0); PG8_BAR; PG8_MMA(0, 0, At, B0); PG8_MMA(0, 1, At, B1); PG8_BAR; PG8_SCHED;
            PG8_LDA(At, 1, 1); PG8_STAGE(PG8_SB(1, 0), b3, voB); PG8_STAGE(PG8_SB(1, 1), b3 + hstepB, voB); PG8_STAGE(PG8_SA(1, 0), a3, voA[0]);
            PG8_WAIT_V(8); PG8_WAIT_L(0); PG8_BAR; PG8_MMA(1, 0, At, B0); PG8_MMA(1, 1, At, B1); PG8_BAR; PG8_SCHED;
        }
        if constexpr (ALIGN_EPI) { if (wr == 0) PG8_BAR; }
        E(acc, cur, ui, wr, wc, fr, fq);
        if (!has_next) break;
#pragma unroll
        for (int a = 0; a < 2; ++a)
#pragma unroll
            for (int b = 0; b < 2; ++b)
#pragma unroll
                for (int m = 0; m < 4; ++m)
#pragma unroll
                    for (int n = 0; n < 2; ++n) acc[a][b][m][n] = (f32x4){0.f, 0.f, 0.f, 0.f};
        cur = nxt; cA = nA; cB = nB; ++ui;
        if constexpr (ALIGN_EPI) { if (wr == 1) PG8_BAR; }
    }
    PG8_WAIT_V(0);
    if constexpr (!ALIGN_EPI) { if (wr == 0) PG8_BAR; }
    PG8_BAR;
#undef PG8_SETVOA
#undef PG8_SA
#undef PG8_SB
#undef PG8_STAGE
#undef PG8_LDA
#undef PG8_LDB
#undef PG8_MMA
#undef PG8_WAIT_V
#undef PG8_WAIT_L
#undef PG8_BAR
#undef PG8_SCHED
}

struct EpiG1 {
    static constexpr bool PERM = true;
    bf16_t* U; const PG8_LAS float* rope;
    __device__ __forceinline__ void operator()(const f32x4 (&acc)[2][2][4][2], const Unit& u, int ui, int wr, int wc, int fr, int fq) const {
        const int row0 = u.pm * BM + wr * 64 + fr, colt = u.pn * BM, col0 = colt + wc * 32 + 8 * fq;
        const bool latent = u.pm < 32;
        const int axis = wc & 1; const float sgn = fq < 2 ? -1.f : 1.f;
#pragma unroll
        for (int ai = 0; ai < 2; ++ai)
#pragma unroll
            for (int m = 0; m < 4; ++m) {
                const int row = row0 + ai * HALF + m * 16;
                bf16_t* rowp = U + (size_t)row * IN_DIM + col0;
                const int t = row & (SEQ - 1); const int pos = axis ? (t & 63) : (t >> 6);
                const PG8_LAS f32x4* tp = (const PG8_LAS f32x4*)(rope + (pos * 16 + 8 * (fq & 1)) * 2);
#pragma unroll
                for (int bj = 0; bj < 2; ++bj) {
                    const int cb = colt + bj * HALF;
                    f32x4 v0 = acc[ai][bj][m][0], v1 = acc[ai][bj][m][1];
                    if (cb < 640) {
                        if (latent) {
                            const f32x4 t0 = tp[0], t1 = tp[1], t2 = tp[2], t3 = tp[3];
                            f32x4 p0, p1;
                            p0[0] = __shfl_xor(v0[0], 32); p0[1] = __shfl_xor(v0[1], 32); p0[2] = __shfl_xor(v0[2], 32); p0[3] = __shfl_xor(v0[3], 32);
                            p1[0] = __shfl_xor(v1[0], 32); p1[1] = __shfl_xor(v1[1], 32); p1[2] = __shfl_xor(v1[2], 32); p1[3] = __shfl_xor(v1[3], 32);
                            v0[0] = v0[0] * t0[0] + sgn * p0[0] * t0[1]; v0[1] = v0[1] * t0[2] + sgn * p0[1] * t0[3];
                            v0[2] = v0[2] * t1[0] + sgn * p0[2] * t1[1]; v0[3] = v0[3] * t1[2] + sgn * p0[3] * t1[3];
                            v1[0] = v1[0] * t2[0] + sgn * p1[0] * t2[1]; v1[1] = v1[1] * t2[2] + sgn * p1[1] * t2[3];
                            v1[2] = v1[2] * t3[0] + sgn * p1[2] * t3[1]; v1[3] = v1[3] * t3[2] + sgn * p1[3] * t3[3];
                        }
                        if (cb < 512) { float qs = QSCALE; asm volatile("" : "+v"(qs)); v0 = v0 * qs; v1 = v1 * qs; }
                    }
                    u32x4 w; w.x = cvt_pk_bf16(v0[0], v0[1]); w.y = cvt_pk_bf16(v0[2], v0[3]); w.z = cvt_pk_bf16(v1[0], v1[1]); w.w = cvt_pk_bf16(v1[2], v1[3]);
                    *(u32x4*)(rowp + bj * HALF) = w;
                }
            }
    }
};
struct EpiG2 {
    static constexpr bool PERM = false;
    float* X; const float* base_lat; const float* base_ctx; const float* modv_l;
    __device__ __forceinline__ void operator()(const f32x4 (&acc)[2][2][4][2], const Unit& u, int ui, int wr, int wc, int fr, int fq) const {
        const int s = u.pm < 16 ? 0 : (u.pm < 32 ? 1 : 2);
        const float* ga = modv_l + (size_t)s * (NMOD * D) + 2 * D;
        const int col0 = u.pn * BM + wc * 32 + 4 * fq;
        f32x4 gv[2][2];
#pragma unroll
        for (int bj = 0; bj < 2; ++bj)
#pragma unroll
            for (int n = 0; n < 2; ++n) gv[bj][n] = *(const f32x4*)(ga + col0 + bj * HALF + n * 16);
#pragma unroll
        for (int ai = 0; ai < 2; ++ai) {
            f32x4 bv[4][2][2];
#pragma unroll
            for (int m = 0; m < 4; ++m) {
                const int row = u.pm * BM + ai * HALF + wr * 64 + m * 16 + fr;
                const float* bp = (u.pm < 32 ? base_lat + (size_t)row * D : base_ctx + (size_t)(row - MLAT) * D) + col0;
#pragma unroll
                for (int bj = 0; bj < 2; ++bj)
#pragma unroll
                    for (int n = 0; n < 2; ++n) bv[m][bj][n] = *(const f32x4*)(bp + bj * HALF + n * 16);
            }
            asm volatile("" ::: "memory");
#pragma unroll
            for (int m = 0; m < 4; ++m) {
                const int row = u.pm * BM + ai * HALF + wr * 64 + m * 16 + fr;
                float* xp = X + (size_t)row * D + col0;
#pragma unroll
                for (int bj = 0; bj < 2; ++bj)
#pragma unroll
                    for (int n = 0; n < 2; ++n) *(f32x4*)(xp + bj * HALF + n * 16) = bv[m][bj][n] + gv[bj][n] * acc[ai][bj][m][n];
            }
            asm volatile("" ::: "memory");
        }
    }
};
struct EpiMoeUp {
    static constexpr bool PERM = true;
    bf16_t* Hid; const float* tok_w; const PG8_LAS unsigned* rows_lds;
    __device__ __forceinline__ void operator()(const f32x4 (&acc)[2][2][4][2], const Unit& u, int ui, int wr, int wc, int fr, int fq) const {
        const int col0 = u.pn * HALF + wc * 32 + 8 * fq;
        float wv[2][4];
#pragma unroll
        for (int ai = 0; ai < 2; ++ai)
#pragma unroll
            for (int m = 0; m < 4; ++m) { const unsigned ent = rows_lds[ui * 256 + ai * HALF + wr * 64 + m * 16 + fr]; wv[ai][m] = (ent == 0xFFFFFFFFu) ? 0.f : tok_w[ent]; }
        asm volatile("" ::: "memory");
#pragma unroll
        for (int ai = 0; ai < 2; ++ai)
#pragma unroll
            for (int m = 0; m < 4; ++m) {
                const int r = ai * HALF + wr * 64 + m * 16 + fr;
                const float w = wv[ai][m];
                const f32x4 g0 = acc[ai][0][m][0], g1 = acc[ai][0][m][1], u0 = acc[ai][1][m][0], u1 = acc[ai][1][m][1];
                float h[8];
#pragma unroll
                for (int j = 0; j < 4; ++j) { h[j] = silu_f(g0[j]) * u0[j] * w; h[4 + j] = silu_f(g1[j]) * u1[j] * w; }
                u32x4 o; o.x = cvt_pk_bf16(h[0], h[1]); o.y = cvt_pk_bf16(h[2], h[3]); o.z = cvt_pk_bf16(h[4], h[5]); o.w = cvt_pk_bf16(h[6], h[7]);
                *(u32x4*)(Hid + (size_t)(u.pm * BM + r) * DEXP + col0) = o;
            }
    }
};
struct EpiMoeDown {
    static constexpr bool PERM = true;
    bf16_t* Y2; const PG8_LAS unsigned* rows_lds;
    __device__ __forceinline__ void operator()(const f32x4 (&acc)[2][2][4][2], const Unit& u, int ui, int wr, int wc, int fr, int fq) const {
        const int col0 = u.pn * BM + wc * 32 + 8 * fq;
#pragma unroll
        for (int ai = 0; ai < 2; ++ai)
#pragma unroll
            for (int m = 0; m < 4; ++m) {
                const int r = ai * HALF + wr * 64 + m * 16 + fr;
                const unsigned ent = rows_lds[ui * 256 + r];
                if (ent != 0xFFFFFFFFu) {
                    bf16_t* yp = Y2 + (size_t)ent * D + col0;
#pragma unroll
                    for (int bj = 0; bj < 2; ++bj) { const f32x4 v0 = acc[ai][bj][m][0], v1 = acc[ai][bj][m][1];
                        u32x4 o; o.x = cvt_pk_bf16(v0[0], v0[1]); o.y = cvt_pk_bf16(v0[2], v0[3]); o.z = cvt_pk_bf16(v1[0], v1[1]); o.w = cvt_pk_bf16(v1[2], v1[3]);
                        *(u32x4*)(yp + bj * HALF) = o; }
                }
            }
    }
};
struct EpiDftA {
    static constexpr bool PERM = false;
    bf16_t* PQt; bf16_t* PQtc;
    __device__ __forceinline__ void operator()(const f32x4 (&acc)[2][2][4][2], const Unit& u, int ui, int wr, int wc, int fr, int fq) const {
        const int g = u.grp;
#pragma unroll
        for (int ai = 0; ai < 2; ++ai)
#pragma unroll
            for (int m = 0; m < 4; ++m) {
                const int cq = wr * 64 + m * 16 + fr;
                bf16_t* dst;
                if (u.pn < 32) { const int b = u.pn >> 4; dst = PQt + ((size_t)(b * 512 + g * 128 + cq) * (2 * SEQ) + (size_t)ai * SEQ + (size_t)(u.pn & 15) * BM); }
                else { const int b = u.pn - 32; dst = PQtc + ((size_t)(b * 512 + g * 128 + cq) * (2 * CTXL) + (size_t)ai * CTXL); }
#pragma unroll
                for (int bj = 0; bj < 2; ++bj)
#pragma unroll
                    for (int n = 0; n < 2; ++n) { const f32x4 v = acc[ai][bj][m][n]; u32x2 o; o.x = cvt_pk_bf16(v[0], v[1]); o.y = cvt_pk_bf16(v[2], v[3]);
                        *(u32x2*)(dst + bj * HALF + wc * 32 + n * 16 + 4 * fq) = o; }
            }
    }
};
struct EpiDftB {
    static constexpr bool PERM = false;
    float* PART; int row_base; int pad;
    long long seq_rows;
    __device__ __forceinline__ void operator()(const f32x4 (&acc)[2][2][4][2], const Unit& u, int ui, int wr, int wc, int fr, int fq) const {
        const int col0 = u.pn * BM + wc * 32 + 4 * fq;
#pragma unroll
        for (int ai = 0; ai < 2; ++ai)
#pragma unroll
            for (int m = 0; m < 4; ++m) {
                const int row = row_base + u.grp * (int)seq_rows + u.pm * BM + ai * HALF + wr * 64 + m * 16 + fr;
                float* pp = PART + ((size_t)u.aux * MROWS + row) * 512 + col0;
#pragma unroll
                for (int bj = 0; bj < 2; ++bj)
#pragma unroll
                    for (int n = 0; n < 2; ++n) *(f32x4*)(pp + bj * HALF + n * 16) = acc[ai][bj][m][n];
            }
    }
};
}


namespace att {
typedef short bf16x8 __attribute__((ext_vector_type(8)));
typedef short s16x4 __attribute__((ext_vector_type(4)));
typedef float f32x16 __attribute__((ext_vector_type(16)));
typedef unsigned u32x4 __attribute__((ext_vector_type(4)));
typedef unsigned u32x2 __attribute__((ext_vector_type(2)));
typedef short v4i16_t __attribute__((ext_vector_type(4)));
typedef __attribute__((address_space(3))) const unsigned char* lds_cptr;
__device__ __forceinline__ int crow(int r, int hi) { return (r & 3) + 8 * (r >> 2) + 4 * hi; }
__device__ __forceinline__ s16x4 vtr(lds_cptr p) { return __builtin_bit_cast(s16x4, __builtin_amdgcn_ds_read_tr16_b64_v4i16((__attribute__((address_space(3))) v4i16_t*)p)); }
__device__ __forceinline__ unsigned cvtpk(float lo, float hi) { unsigned r; asm volatile("v_cvt_pk_bf16_f32 %0, %1, %2" : "=v"(r) : "v"(lo), "v"(hi)); return r; }

__device__ __forceinline__ void attn_unit(__attribute__((address_space(3))) unsigned char* lds, const bf16_t* __restrict__ Ub, bf16_t* __restrict__ MIXb, const float* __restrict__ sink, int unit, int tid_in) {
    int tid = tid_in; asm volatile("" : "+v"(tid));
    const int lane = tid & 63, r32 = lane & 31, hi = lane >> 5; const int wid = __builtin_amdgcn_readfirstlane(tid >> 6);
    const bool latent = unit < 256;
    int b, kvh, p0;
    if (latent) { b = unit >> 7; kvh = (unit >> 6) & 1; p0 = (unit & 63) * 64; } else { const int u2 = unit - 256; b = u2 >> 3; kvh = (u2 >> 2) & 1; p0 = (u2 & 3) * 64; }
    const int g = wid >> 1, ph = wid & 1, head = kvh * 4 + g;
    const int qrow = (latent ? b * SEQ + p0 : MLAT + b * CTXL + p0) + 32 * ph + r32;
    bf16x8 qr[4];
#pragma unroll
    for (int d0 = 0; d0 < 4; ++d0) qr[d0] = *(const bf16x8*)(Ub + (size_t)qrow * IN_DIM + UQ + head * 64 + 16 * d0 + 8 * hi);
    const int jlo = latent ? (p0 >= 128 ? 0 : (p0 == 64 ? 1 : 2)) : 0;
    const int jhi = latent ? min(4, (4160 - p0) >> 6) : -1;
    const int nloc = latent ? (jhi - jlo + 1) : 0, ntl = nloc + 4;
    const int kkey = lane, kc = wid;
    const int vkey = 16 * (wid & 3) + (lane >> 2), vd = 32 * (wid >> 2) + 8 * (lane & 3);
    const bf16_t* kcol = Ub + UK + kvh * 64 + 8 * kc; const bf16_t* vcol = Ub + UV + kvh * 64 + vd;
#define ATT_KROW0(t) (((t) < nloc) ? (b * SEQ + p0 - 128 + 64 * (jlo + (t))) : (MLAT + b * CTXL + 64 * ((t) - nloc)))
    u32x4 kreg, vreg;
    { const int kr0 = ATT_KROW0(0); kreg = *(const u32x4*)(kcol + (size_t)(kr0 + kkey) * IN_DIM); vreg = *(const u32x4*)(vcol + (size_t)(kr0 + vkey) * IN_DIM); }
    *(__attribute__((address_space(3))) u32x4*)(lds + tid * 16) = kreg; *(__attribute__((address_space(3))) u32x4*)(lds + 16384 + tid * 16) = vreg;
    const float sk2 = sink[head] * LOG2E;
    float m = sk2, l = (hi == 0) ? 1.f : 0.f;
    f32x16 o[2]; o[0] = f32x16{}; o[1] = f32x16{};
    __syncthreads();
    for (int t = 0; t < ntl; ++t) {
        const int slot = (t & 1) * 8192;
        const bool more = (t + 1 < ntl);
        if (more) { const int kr0 = ATT_KROW0(t + 1); kreg = *(const u32x4*)(kcol + (size_t)(kr0 + kkey) * IN_DIM); vreg = *(const u32x4*)(vcol + (size_t)(kr0 + vkey) * IN_DIM); }
        f32x16 s0 = f32x16{}, s1 = f32x16{};
        { const lds_cptr kb = (lds_cptr)lds + slot + hi * 1024 + r32 * 16;
#pragma unroll
          for (int d0 = 0; d0 < 4; ++d0) { const bf16x8 b0 = *(const __attribute__((address_space(3))) bf16x8*)(kb + d0 * 2048); const bf16x8 b1 = *(const __attribute__((address_space(3))) bf16x8*)(kb + d0 * 2048 + 512);
              s0 = __builtin_amdgcn_mfma_f32_32x32x16_bf16(b0, qr[d0], s0, 0, 0, 0); s1 = __builtin_amdgcn_mfma_f32_32x32x16_bf16(b1, qr[d0], s1, 0, 0, 0); } }
        if (t < nloc) {
            const int rel0 = 64 * (jlo + t) - 128 - 32 * ph - r32 + 4 * hi;
#pragma unroll
            for (int r = 0; r < 16; ++r) { const int rel = rel0 + (r & 3) + 8 * (r >> 2); if (rel < -128 || rel > 128) s0[r] = -1e30f; if (rel + 32 < -128 || rel + 32 > 128) s1[r] = -1e30f; }
        }
        float tm = fmaxf(s0[0], s1[0]);
#pragma unroll
        for (int r = 1; r < 16; ++r) tm = fmaxf(tm, fmaxf(s0[r], s1[r]));
        tm = fmaxf(tm, __shfl_xor(tm, 32));
        const float mn = fmaxf(m, tm), alpha = exp2f(m - mn); m = mn;
        float ps = 0.f;
#pragma unroll
        for (int r = 0; r < 16; ++r) { s0[r] = exp2f(s0[r] - mn); s1[r] = exp2f(s1[r] - mn); ps += s0[r] + s1[r]; }
        l = l * alpha + ps;
#pragma unroll
        for (int r = 0; r < 16; ++r) { o[0][r] *= alpha; o[1][r] *= alpha; }
        u32x4 pw[4];
#pragma unroll
        for (int q = 0; q < 4; ++q) { pw[0][q] = cvtpk(s0[2 * q], s0[2 * q + 1]); pw[1][q] = cvtpk(s0[8 + 2 * q], s0[8 + 2 * q + 1]); pw[2][q] = cvtpk(s1[2 * q], s1[2 * q + 1]); pw[3][q] = cvtpk(s1[8 + 2 * q], s1[8 + 2 * q + 1]); }
        { const lds_cptr vp = (lds_cptr)lds + 16384 + slot + ((lane >> 4) & 1) * 32 + (lane & 3) * 8 + (4 * hi + ((lane & 15) >> 2)) * 64;
#pragma unroll
          for (int d0 = 0; d0 < 2; ++d0)
#pragma unroll
            for (int ks = 0; ks < 4; ++ks) { const s16x4 lo = vtr(vp + d0 * 4096 + ks * 1024), hh = vtr(vp + d0 * 4096 + ks * 1024 + 512);
                const bf16x8 vf = (bf16x8){lo[0], lo[1], lo[2], lo[3], hh[0], hh[1], hh[2], hh[3]};
                o[d0] = __builtin_amdgcn_mfma_f32_32x32x16_bf16(vf, __builtin_bit_cast(bf16x8, pw[ks]), o[d0], 0, 0, 0); } }
        if (more) { const int ns = ((t + 1) & 1) * 8192; *(__attribute__((address_space(3))) u32x4*)(lds + ns + tid * 16) = kreg; *(__attribute__((address_space(3))) u32x4*)(lds + 16384 + ns + tid * 16) = vreg; }
        __syncthreads();
    }
#undef ATT_KROW0
    l += __shfl_xor(l, 32);
    const float inv = 1.f / l;
    bf16_t* op = MIXb + (size_t)qrow * D + head * 64 + 4 * hi;
#pragma unroll
    for (int d0 = 0; d0 < 2; ++d0)
#pragma unroll
        for (int g4 = 0; g4 < 4; ++g4) { u32x2 w; w.x = cvtpk(o[d0][4 * g4] * inv, o[d0][4 * g4 + 1] * inv); w.y = cvtpk(o[d0][4 * g4 + 2] * inv, o[d0][4 * g4 + 3] * inv);
            *(u32x2*)(op + 32 * d0 + 8 * g4) = w; }
}
}

constexpr int CONV_W_OFF = 65536;
using pg8::f32x4;
__device__ __forceinline__ void unpack8(const pg8::u32x4 p, float (&f)[8]) {
#pragma unroll
    for (int q = 0; q < 4; ++q) { f[2 * q] = __uint_as_float(p[q] << 16); f[2 * q + 1] = __uint_as_float(p[q] & 0xffff0000u); }
}
__device__ __forceinline__ void conv_fill_w(__attribute__((address_space(3))) unsigned char* lds, const float* __restrict__ cw, int tid) {
    __attribute__((address_space(3))) f32x4* wl = (__attribute__((address_space(3))) f32x4*)(lds + CONV_W_OFF);
    for (int e = tid; e < 31 * 128; e += 512) wl[e] = *(const f32x4*)(cw + (size_t)e * 4);
}
__device__ __forceinline__ void conv_tile(__attribute__((address_space(3))) unsigned char* lds, const bf16_t* __restrict__ Ub, bf16_t* __restrict__ MIXb, const float* __restrict__ sw,
                                          const float* __restrict__ cb, const float* __restrict__ ng, const float* __restrict__ nb, int tile, int tid_in) {
    typedef pg8::u32x4 u32x4;
    int tid = tid_in; asm volatile("" : "+v"(tid));
    const int lane = tid & 63, w = tid >> 6, c8 = 8 * lane;
    int base, t0, len;
    if (tile < 256) { base = (tile >> 7) * SEQ; t0 = (tile & 127) * 32; len = SEQ; } else { const int u2 = tile - 256; base = MLAT + (u2 >> 3) * CTXL; t0 = (u2 & 7) * 32; len = CTXL; }
#pragma unroll 2
    for (int q = 0; q < 8; ++q) {
        const int it = tid + 512 * q;
        if (it < 62 * 64) {
            const int tok = it >> 6, cg = (it & 63) * 8; const int tt = t0 - 15 + tok;
            u32x4 o = (u32x4){0u, 0u, 0u, 0u};
            if (tt >= 0 && tt < len) {
                const bf16_t* u = Ub + (size_t)(base + tt) * IN_DIM;
                const u32x4 a = *(const u32x4*)(u + UDA + cg), g = *(const u32x4*)(u + UDG + cg);
                float fa[8], fg[8]; unpack8(a, fa); unpack8(g, fg);
#pragma unroll
                for (int e = 0; e < 4; ++e) o[e] = pg8::cvt_pk_bf16(fa[2 * e] * sigmoid_f(fg[2 * e]), fa[2 * e + 1] * sigmoid_f(fg[2 * e + 1]));
            }
            *(__attribute__((address_space(3))) u32x4*)(lds + (size_t)(tok * 512 + cg) * 2) = o;
        }
    }
    asm volatile("" ::: "memory"); __builtin_amdgcn_sched_barrier(0);
    {
        float v[6][8];
#pragma unroll
        for (int k = 0; k < 6; ++k) { const int tt = t0 + 4 * w - 1 + k;
            if (tt >= 0 && tt < len) { const bf16_t* u = Ub + (size_t)(base + tt) * IN_DIM; float a[8], b[8]; unpack8(*(const u32x4*)(u + USC + c8), a); unpack8(*(const u32x4*)(u + USV + c8), b);
#pragma unroll
                for (int e = 0; e < 8; ++e) v[k][e] = a[e] * b[e]; }
            else {
#pragma unroll
                for (int e = 0; e < 8; ++e) v[k][e] = 0.f; } }
        float w0[8], w1[8], w2[8];
#pragma unroll
        for (int h2 = 0; h2 < 2; ++h2) { const f32x4 a = *(const f32x4*)(sw + c8 + 4 * h2), b = *(const f32x4*)(sw + 512 + c8 + 4 * h2), cc = *(const f32x4*)(sw + 1024 + c8 + 4 * h2);
#pragma unroll
            for (int e = 0; e < 4; ++e) { w0[4 * h2 + e] = a[e]; w1[4 * h2 + e] = b[e]; w2[4 * h2 + e] = cc[e]; } }
#pragma unroll
        for (int i = 0; i < 4; ++i) { const size_t row = (size_t)(base + t0 + 4 * w + i); float sb[8]; unpack8(*(const u32x4*)(Ub + row * IN_DIM + USB + c8), sb);
            u32x4 o;
#pragma unroll
            for (int e = 0; e < 4; ++e) o[e] = pg8::cvt_pk_bf16(sb[2 * e] * (w0[2 * e] * v[i][2 * e] + w1[2 * e] * v[i + 1][2 * e] + w2[2 * e] * v[i + 2][2 * e]),
                                                          sb[2 * e + 1] * (w0[2 * e + 1] * v[i][2 * e + 1] + w1[2 * e + 1] * v[i + 1][2 * e + 1] + w2[2 * e + 1] * v[i + 2][2 * e + 1]));
            *(u32x4*)(MIXb + row * D + 1024 + c8) = o; }
    }
    asm volatile("" ::: "memory"); __builtin_amdgcn_sched_barrier(0);
    __syncthreads();
    float z[4][8];
    {
        const f32x4 b0 = *(const f32x4*)(cb + c8), b1 = *(const f32x4*)(cb + c8 + 4);
#pragma unroll
        for (int i = 0; i < 4; ++i)
#pragma unroll
            for (int e = 0; e < 4; ++e) { z[i][e] = b0[e]; z[i][4 + e] = b1[e]; }
        float wq[4][8];
        const __attribute__((address_space(3))) f32x4* wl = (const __attribute__((address_space(3))) f32x4*)(lds + CONV_W_OFF);
#pragma unroll 1
        for (int ko = 0; ko < 9; ++ko) {
#pragma unroll
            for (int ki = 0; ki < 4; ++ki) {
                const int k = 4 * ko + ki;
                if (k < 34) {
                    if (k < 31) { const f32x4 a = wl[k * 128 + 2 * lane], b = wl[k * 128 + 2 * lane + 1];
#pragma unroll
                        for (int e = 0; e < 4; ++e) { wq[ki][e] = a[e]; wq[ki][4 + e] = b[e]; } }
                    float g[8]; unpack8(*(const __attribute__((address_space(3))) u32x4*)(lds + (size_t)((4 * w + k) * 512 + c8) * 2), g);
#pragma unroll
                    for (int i = 0; i < 4; ++i) { const int j = k - i; if (j >= 0 && j < 31) {
#pragma unroll
                        for (int e = 0; e < 8; ++e) z[i][e] += wq[(ki - i) & 3][e] * g[e]; } }
                }
            }
        }
    }
    {
        float gg[8], bb[8];
        { const f32x4 a = *(const f32x4*)(ng + c8), b = *(const f32x4*)(ng + c8 + 4), cc = *(const f32x4*)(nb + c8), d = *(const f32x4*)(nb + c8 + 4);
#pragma unroll
          for (int e = 0; e < 4; ++e) { gg[e] = a[e]; gg[4 + e] = b[e]; bb[e] = cc[e]; bb[4 + e] = d[e]; } }
#pragma unroll
        for (int i = 0; i < 4; ++i) {
            float s = 0.f;
#pragma unroll
            for (int e = 0; e < 8; ++e) s += z[i][e];
            const float mu = wave_sum(s) * (1.f / 512.f);
            float s2 = 0.f;
#pragma unroll
            for (int e = 0; e < 8; ++e) { const float d = z[i][e] - mu; s2 += d * d; }
            const float rstd = rsqrtf(wave_sum(s2) * (1.f / 512.f) + 1e-6f);
            u32x4 o;
#pragma unroll
            for (int e = 0; e < 4; ++e) { const float y0 = (z[i][2 * e] - mu) * rstd * gg[2 * e] + bb[2 * e], y1 = (z[i][2 * e + 1] - mu) * rstd * gg[2 * e + 1] + bb[2 * e + 1]; o[e] = pg8::cvt_pk_bf16(silu_f(y0), silu_f(y1)); }
            *(u32x4*)(MIXb + (size_t)(base + t0 + 4 * w + i) * D + 1536 + c8) = o;
        }
    }
    __syncthreads();
}

constexpr int NWAVES = 8;
constexpr int RING_OFF = 0, RING_BYTES = 131072;
constexpr int ROWS_OFF = 131072;
constexpr int ULIST_OFF = ROWS_OFF + 4096;
constexpr int ROPE_OFF = ULIST_OFF + 256;
constexpr int LDSCTL_OFF = ROPE_OFF + 8192, MISC_OFF = LDSCTL_OFF + 320;
constexpr int LDS_BYTES = 147456;
static_assert(MISC_OFF + 256 <= LDS_BYTES, "LDS map");

#define GAS __attribute__((address_space(1)))
#define LAS __attribute__((address_space(3)))
typedef unsigned v4u __attribute__((ext_vector_type(4)));
typedef GAS unsigned gu32;
#define RLX_AGENT __ATOMIC_RELAXED, __HIP_MEMORY_SCOPE_AGENT
#define LDS_WAIT() asm volatile("s_waitcnt lgkmcnt(0)" ::: "memory")
#define VM_WAIT() asm volatile("s_waitcnt vmcnt(0)" ::: "memory")
__device__ __forceinline__ unsigned pk2(float lo, float hi) { return (unsigned)f2bf(lo) | ((unsigned)f2bf(hi) << 16); }

#define XB_TMO      128
#define XB_XCNT(j)  (256  + 64 * (j))
#define XB_XSUB(j)  (1280 + 64 * (j))
#define XB_XGEN(j)  (2304 + 64 * (j))
#define XB_TOP      3328
#define XB_TOPGEN   3392
#define XCD_BAR_WORDS 3456
#define XB_SPIN_CAP (1u << 20)
__device__ __forceinline__ unsigned xb_ld(unsigned* p)              { return __hip_atomic_load(p, __ATOMIC_RELAXED, __HIP_MEMORY_SCOPE_AGENT); }
__device__ __forceinline__ unsigned xb_add(unsigned* p, unsigned v) { return __hip_atomic_fetch_add(p, v, __ATOMIC_RELAXED, __HIP_MEMORY_SCOPE_AGENT); }
__device__ __forceinline__ unsigned xb_xcc_id() { return (unsigned)__builtin_amdgcn_s_getreg((3 << 11) | 20) & 0xFu; }
#define XB_SPIN(cond, bar) do { unsigned _sp = 0; while (cond) { __builtin_amdgcn_s_sleep(1); \
    if ((++_sp & 255u) == 0u) { if (xb_ld(&(bar)[XB_TMO])) break; if (_sp > XB_SPIN_CAP) { atomicAdd(&(bar)[XB_TMO], 1u); break; } } } } while (0)
struct XcdBarrier { unsigned* bar; unsigned x; volatile LAS unsigned* st; };
__device__ __forceinline__ XcdBarrier xcd_barrier_post(unsigned* bar, volatile LAS unsigned* st) {
    XcdBarrier b; b.bar = bar; b.x = xb_xcc_id(); b.st = st;
    if (threadIdx.x == 0) (void)xb_add(&bar[XB_XCNT(b.x)], 1u);
    return b;
}
__device__ __forceinline__ void xcd_barrier_complete(unsigned* bar, unsigned x, unsigned& nloc, unsigned& nx) {
    const unsigned G = gridDim.x * gridDim.y * gridDim.z;
    unsigned sum, cnt, mine, sp = 0u;
    for (;;) {
        sum = 0u; cnt = 0u; mine = 0u;
#pragma unroll
        for (unsigned j = 0; j < 16; ++j) { const unsigned c = xb_ld(&bar[XB_XCNT(j)]); sum += c; cnt += (c > 0u) ? 1u : 0u; mine = (j == x) ? c : mine; }
        if (sum == G) break;
        __builtin_amdgcn_s_sleep(1);
        if ((++sp & 255u) == 0u) { if (xb_ld(&bar[XB_TMO])) break; if (sp > XB_SPIN_CAP) { atomicAdd(&bar[XB_TMO], 1u); break; } }
    }
    nloc = mine > 0u ? mine : 1u; nx = cnt > 0u ? cnt : 1u;
}
__device__ __forceinline__ void xcd_barrier(const XcdBarrier& b) {
    asm volatile("s_waitcnt vmcnt(0)" ::: "memory");
    __syncthreads();
    if (threadIdx.x == 0) {
        unsigned* bar = b.bar;
        __builtin_amdgcn_s_waitcnt(0);
        unsigned nloc = b.st[0], nx = b.st[1];
        if (nloc == 0u) { xcd_barrier_complete(bar, b.x, nloc, nx); b.st[0] = nloc; b.st[1] = nx; }
        const unsigned old = xb_add(&bar[XB_XSUB(b.x)], 1u);
        const unsigned gen = old / nloc;
        if (old + 1u == (gen + 1u) * nloc) {
            __builtin_amdgcn_fence(__ATOMIC_RELEASE, "agent");
            asm volatile("s_waitcnt vmcnt(0)" ::: "memory");
            const unsigned og = xb_add(&bar[XB_TOP], 1u);
            const unsigned tg = og / nx;
            if (og + 1u == (tg + 1u) * nx) xb_add(&bar[XB_TOPGEN], 1u);
            else XB_SPIN(xb_ld(&bar[XB_TOPGEN]) == tg, bar);
            __builtin_amdgcn_fence(__ATOMIC_ACQUIRE, "agent");
            xb_add(&bar[XB_XGEN(b.x)], 1u);
            asm volatile("s_waitcnt vmcnt(0)" ::: "memory");
        } else {
            XB_SPIN(xb_ld(&bar[XB_XGEN(b.x)]) == gen, bar);
            __builtin_amdgcn_fence(__ATOMIC_ACQUIRE, "agent");
            asm volatile("s_waitcnt vmcnt(0)" ::: "memory");
        }
    }
    __syncthreads();
}

constexpr size_t WM_CTL = 0;
constexpr int CW_BAR = 4096;
constexpr size_t WM_WIN = 352 * MiB;
constexpr size_t WM_WOUT = 384 * MiB;
constexpr size_t WM_WGU = 400 * MiB;
constexpr size_t WM_WDN = 528 * MiB;
constexpr size_t WM_CS = 592 * MiB;
constexpr size_t WM_CSC = 656 * MiB;
constexpr size_t WM_WC = 657 * MiB;
constexpr size_t WM_PQT = 658 * MiB;
constexpr size_t WM_PQTC = 674 * MiB;
constexpr size_t WM_PART = 676 * MiB;
constexpr size_t WM_HIDB = 744 * MiB;
constexpr size_t WM_END = 768 * MiB;

struct MArgs { const float* in[24]; float* out; unsigned char* ws; int ph_lo, ph_hi, layer, use_bar; };

struct Frame {
    LAS unsigned char* lds; volatile LAS unsigned* MISC; unsigned* ctl;
    int tid, lane, wave, vcu, G;
};

__device__ __forceinline__ void p0_transpose_item(const float* W, int K, int N, bf16_t* WT, int n_row_base, LAS float* scr, int item, int lane) {
    const int nblk = N / 32, kb = item / nblk, nb = item % nblk, k0 = 64 * kb, n0 = 32 * nb;
    float tv[32];
    { const float* wp = W + (size_t)(k0 + (lane >> 5)) * N + n0 + (lane & 31);
#pragma unroll
      for (int i = 0; i < 32; ++i) tv[i] = __builtin_nontemporal_load(wp + (size_t)(2 * i) * N); }
#pragma unroll
    for (int i = 0; i < 32; ++i) scr[(2 * i + (lane >> 5)) * 33 + (lane & 31)] = tv[i];
    LDS_WAIT(); asm volatile("" ::: "memory");
    const int c = lane & 7;
#pragma unroll
    for (int j = 0; j < 4; ++j) { const int n = (lane >> 3) + 8 * j; const LAS float* s = scr + (8 * c) * 33 + n;
        v4u o; o.x = pk2(s[0 * 33], s[1 * 33]); o.y = pk2(s[2 * 33], s[3 * 33]); o.z = pk2(s[4 * 33], s[5 * 33]); o.w = pk2(s[6 * 33], s[7 * 33]);
        *(v4u*)(WT + (size_t)(n_row_base + n) * K + k0 + 8 * c) = o; }
    LDS_WAIT(); asm volatile("" ::: "memory");
}

__device__ __forceinline__ unsigned char* opq(unsigned char* p) { unsigned lo = (unsigned)(uintptr_t)p, hi = (unsigned)((uintptr_t)p >> 32); asm volatile("" : "+v"(lo), "+v"(hi)); lo = __builtin_amdgcn_readfirstlane(lo); hi = __builtin_amdgcn_readfirstlane(hi); return (unsigned char*)(((uintptr_t)hi << 32) | (uintptr_t)lo); }
__device__ __forceinline__ const char* opqc(const char* p) { return (const char*)opq((unsigned char*)p); }
__device__ __forceinline__ int opqv(int v) { asm volatile("" : "+v"(v)); return v; }
#define PHASE_PROLOG unsigned char* ws = opq(args.ws); const char* ka = opqc((const char*)__builtin_amdgcn_kernarg_segment_ptr()); const int lane = opqv(F.lane), tid = opqv(F.tid); (void)ws; (void)ka; (void)lane; (void)tid
#define INP(k) (*(const float* const*)(ka + (k) * 8))

struct N2Ctx { const float* X; bf16_t* H; const float* g2; const float* modl; const float* wg; const float* we; const float* bg; const float* be; int* tok_e; float* tok_w; unsigned* cnt; unsigned* list; };
template <int NR>
__device__ __forceinline__ void n2_group(const N2Ctx& C, LAS float* wt, const int (&rows)[NR], int mrows, int lane, int tid) {
    const int l4 = lane * 4;
    f32x4 h[NR][8]; float lg[NR][20];
#pragma unroll
    for (int i = 0; i < NR; ++i) {
        const int row = rows[i]; const bool ok = row < mrows; const int rr = ok ? row : 0; const int s = modsel(rr);
        f32x4 v[8]; float ss = 0.f;
#pragma unroll
        for (int j = 0; j < 8; ++j) { v[j] = *(const f32x4*)(C.X + (size_t)rr * D + l4 + 256 * j); ss += v[j][0] * v[j][0] + v[j][1] * v[j][1] + v[j][2] * v[j][2] + v[j][3] * v[j][3]; }
        ss = wave_sum(ss);
        const float rstd = rsqrtf(ss * (1.f / D) + 1e-6f);
        const float* sh = C.modl + (size_t)s * (NMOD * D) + 3 * D; const float* sc = sh + D;
#pragma unroll
        for (int j = 0; j < 8; ++j) { const int col = l4 + 256 * j; const f32x4 g = *(const f32x4*)(C.g2 + col), a = *(const f32x4*)(sc + col), b = *(const f32x4*)(sh + col);
            h[i][j] = v[j] * rstd * g * (a + 1.f) + b;
            if (ok) { pg8::u32x2 o; o.x = pk2(h[i][j][0], h[i][j][1]); o.y = pk2(h[i][j][2], h[i][j][3]); *(pg8::u32x2*)(C.H + (size_t)row * D + col) = o; } }
#pragma unroll
        for (int q = 0; q < 20; ++q) lg[i][q] = 0.f;
    }
#pragma unroll
    for (int half = 0; half < 2; ++half) {
        __syncthreads();
#pragma unroll
        for (int cc = 0; cc < 2; ++cc) { const int c = tid + 512 * cc; const int col = 1024 * half + c;
            const f32x4 a = *(const f32x4*)(C.wg + (size_t)col * 4);
            wt[0 * 1024 + c] = a[0]; wt[1 * 1024 + c] = a[1]; wt[2 * 1024 + c] = a[2]; wt[3 * 1024 + c] = a[3];
#pragma unroll
            for (int q = 0; q < 4; ++q) { const f32x4 b = *(const f32x4*)(C.we + (size_t)col * 16 + q * 4);
                wt[(4 + 4 * q) * 1024 + c] = b[0]; wt[(5 + 4 * q) * 1024 + c] = b[1]; wt[(6 + 4 * q) * 1024 + c] = b[2]; wt[(7 + 4 * q) * 1024 + c] = b[3]; } }
        __syncthreads();
#pragma unroll
        for (int jj = 0; jj < 4; ++jj) {
#pragma unroll
            for (int q = 0; q < 20; ++q) { const f32x4 w = *(const LAS f32x4*)(wt + q * 1024 + l4 + 256 * jj);
#pragma unroll
                for (int i = 0; i < NR; ++i) { const f32x4 hv = h[i][4 * half + jj]; lg[i][q] += hv[0] * w[0] + hv[1] * w[1] + hv[2] * w[2] + hv[3] * w[3]; } }
        }
    }
#pragma unroll
    for (int i = 0; i < NR; ++i)
#pragma unroll
        for (int q = 0; q < 20; ++q) lg[i][q] = wave_sum(lg[i][q]);
    if (lane < NR) {
        int row = rows[0];
#pragma unroll
        for (int i = 1; i < NR; ++i) row = (lane == i) ? rows[i] : row;
        if (row < mrows) {
            float gl[4], el[16];
#pragma unroll
            for (int q = 0; q < 20; ++q) { float vq = lg[0][q];
#pragma unroll
                for (int i = 1; i < NR; ++i) vq = (lane == i) ? lg[i][q] : vq;
                if (q < 4) gl[q] = vq + C.bg[q]; else el[q - 4] = vq + C.be[q - 4]; }
            int gs = 0; float gm = gl[0];
#pragma unroll
            for (int q = 1; q < 4; ++q) if (gl[q] > gm) { gm = gl[q]; gs = q; }
            float den = 0.f;
#pragma unroll
            for (int q = 0; q < 4; ++q) den += __expf(gl[q] - gm);
            const float pg = 1.f / den;
            float eg[4];
#pragma unroll
            for (int q = 0; q < 4; ++q) eg[q] = gs == 0 ? el[q] : (gs == 1 ? el[4 + q] : (gs == 2 ? el[8 + q] : el[12 + q]));
            int i0 = 0; float m0 = eg[0];
#pragma unroll
            for (int q = 1; q < 4; ++q) if (eg[q] > m0) { m0 = eg[q]; i0 = q; }
            int i1 = -1; float m1 = -3.0e38f;
#pragma unroll
            for (int q = 0; q < 4; ++q) if (q != i0 && eg[q] > m1) { m1 = eg[q]; i1 = q; }
            const float w0 = 1.f / (1.f + __expf(m1 - m0)), w1 = 1.f - w0;
            const int e0 = gs * 4 + i0, e1 = gs * 4 + i1;
            C.tok_e[row * 2] = e0; C.tok_e[row * 2 + 1] = e1; C.tok_w[row * 2] = w0 * pg; C.tok_w[row * 2 + 1] = w1 * pg;
            const unsigned p0 = atomicAdd(C.cnt + e0, 1u); C.list[(size_t)e0 * (2 * MROWS) + p0] = row * 2;
            const unsigned p1 = atomicAdd(C.cnt + e1, 1u); C.list[(size_t)e1 * (2 * MROWS) + p1] = row * 2 + 1;
        }
    }
}

__global__ void __launch_bounds__(NWAVES * 64, 2) mega_fwd(MArgs args) {
    extern __shared__ __attribute__((aligned(16))) unsigned char lds_raw[];
    Frame F;
    F.lds = (LAS unsigned char*)lds_raw;
    F.MISC = (volatile LAS unsigned*)(F.lds + MISC_OFF);
    F.tid = threadIdx.x; F.lane = F.tid & 63; F.wave = __builtin_amdgcn_readfirstlane(F.tid >> 6);
    F.G = gridDim.x; { const int bx = blockIdx.x; F.vcu = (F.G % 8 == 0) ? (bx % 8) * (F.G / 8) + bx / 8 : bx; }
    F.ctl = (unsigned*)(args.ws + WM_CTL);
    for (int u = F.tid; u < (LDS_BYTES - LDSCTL_OFF) / 4; u += NWAVES * 64) ((LAS unsigned*)(F.lds + LDSCTL_OFF))[u] = 0u;
    __syncthreads();
    XcdBarrier bar; bar.bar = F.ctl + CW_BAR; bar.x = 0; bar.st = nullptr;
    if (args.use_bar) bar = xcd_barrier_post(F.ctl + CW_BAR, F.MISC + 8);
#define GRID_BAR() do { if (args.use_bar) xcd_barrier(bar); } while (0)
    const int lo = args.ph_lo, hi = args.ph_hi;
#ifdef PROBE_DUP
#define PC_OF(pi) ((pi) <= PROBE_DUP ? (pi) : (pi) - 1)
#else
#define PC_OF(pi) (pi)
#endif
    const int gw = F.vcu * NWAVES + F.wave, NGW = F.G * NWAVES;
  for (int pi = lo; pi < hi; ++pi) {
    const int pc = PC_OF(pi);
    const int l = (pc >= 10 && pc < 19) ? 1 : 0;
    const int kk = (pc == 0) ? -1 : (pc == 19 ? -2 : pc - 1 - 9 * l);
    const int mrows = (l == 1) ? MLAT : MROWS;


#define x_in INP(0)
#define c_in INP(1)
#define ctx_in INP(2)
#define c_ctx INP(3)
#define w_mod INP(4)
#define b_mod INP(5)
#define w_in INP(8)
#define w_out INP(9)
#define w_gate INP(20)
#define w_up INP(21)
#define w_down INP(22)
#define modv   ((float*)(ws + WS_MOD))
#define rope   ((float*)(ws + WS_ROPE))
#define tok_w  ((float*)(ws + WS_TOK + 128 * 1024))
#define tok_e  ((int*)(ws + WS_TOK))
#define list   ((unsigned*)(ws + WS_LIST))
#define X      ((float*)(ws + WS_X))
#define H      ((bf16_t*)(ws + WS_H))
#define U      ((bf16_t*)(ws + WS_U))
#define MIX    ((bf16_t*)(ws + WS_MIX))
#define Y2     ((bf16_t*)(ws + WS_Y2))
#define Win_t  ((bf16_t*)(ws + WM_WIN))
#define Wout_t ((bf16_t*)(ws + WM_WOUT))
#define Wgu_t  ((bf16_t*)(ws + WM_WGU))
#define Wdn_t  ((bf16_t*)(ws + WM_WDN))
#define CS     ((bf16_t*)(ws + WM_CS))
#define CSC    ((bf16_t*)(ws + WM_CSC))
#define WC     ((bf16_t*)(ws + WM_WC))
#define PQT    ((bf16_t*)(ws + WM_PQT))
#define PQTC   ((bf16_t*)(ws + WM_PQTC))
#define PART   ((float*)(ws + WM_PART))
#define HIDB   ((bf16_t*)(ws + WM_HIDB))
#define g_norm1 INP(6)
#define g_norm2 INP(7)
#define g_final INP(23)
#define w_rg INP(16)
#define b_rg INP(17)
#define w_re INP(18)
#define b_re INP(19)
    const PG8_LAS unsigned* rows_lds = (const PG8_LAS unsigned*)(F.lds + ROWS_OFF);
    LAS int* ulist = (LAS int*)(F.lds + ULIST_OFF);

    if (pc == 0) {
        PHASE_PROLOG;
        LAS float* ctab = (LAS float*)(F.lds + 67584); LAS float* stab = ctab + 4096;
        for (int i = tid; i < 4096; i += NWAVES * 64) { float s, c; sincospif((float)i * (1.f / 2048.f), &s, &c); ctab[i] = c; stab[i] = s; }
        __syncthreads();
#ifdef PROBE_P0
        for (int rep_ = 0; rep_ < (PROBE_P0 == 1 ? 2 : 1); ++rep_)
#endif
        for (int tp = F.vcu; tp < SEQ; tp += F.G) {
#pragma unroll
            for (int j = 0; j < 2; ++j) { const int k0 = (tid + 512 * j) * 8; const int part = k0 >> 12; const int kk0 = k0 & 4095;
                float v[8];
#pragma unroll
                for (int q = 0; q < 8; ++q) { const float rev = (float)((tp * (kk0 + q)) & 4095) * (1.f / 4096.f);
                    v[q] = part ? -__builtin_amdgcn_sinf(rev) : __builtin_amdgcn_cosf(rev); }
                v4u o; o.x = pk2(v[0], v[1]); o.y = pk2(v[2], v[3]); o.z = pk2(v[4], v[5]); o.w = pk2(v[6], v[7]);
                *(v4u*)(CS + (size_t)tp * (2 * SEQ) + k0) = o; }
        }
        if (F.vcu == 1 % F.G) {
            for (int e = tid; e < 256 * 256; e += NWAVES * 64) { const int r = e >> 8, c = e & 255; const int part = r >> 7, cq = r & 127; float v = 0.f;
                if (c < 128) { const int idx = ((c * cq) & 127) * 32; v = part ? stab[idx] : ctab[idx]; } WC[e] = f2bf(v); }
        }
        if (F.vcu == 2 % F.G) {
            for (int e = tid; e < 256 * 512; e += NWAVES * 64) { const int tp = e >> 9, k = e & 511; const int part = k >> 8; const int idx = ((tp * (k & 255)) & 255) * 16;
                CSC[e] = f2bf(part ? -stab[idx] : ctab[idx]); }
        }
        if (F.vcu == 3 % F.G) {
            for (int e = tid; e < 64 * 16; e += NWAVES * 64) { const int pos = e >> 4, i = e & 15; const float freq = powf(10000.f, -(float)(2 * i) / 32.f); const float ang = (float)pos * freq;
                rope[e * 2] = cosf(ang); rope[e * 2 + 1] = sinf(ang); }
        }
        __syncthreads();
        {
            LAS float* sl = (LAS float*)(F.lds + 67584 + 32768 + 9216);
            for (int e = tid; e < 3 * D; e += NWAVES * 64) { const int sidx = e / D, k = e % D; sl[e] = silu_f(sidx == 0 ? c_in[k] : (sidx == 1 ? c_in[D + k] : c_ctx[k])); }
            __syncthreads();
#ifdef PROBE_P0
            for (int rep_ = 0; rep_ < (PROBE_P0 == 2 ? 2 : 1); ++rep_)
#endif
            for (int it = blockIdx.x; it < 256; it += F.G) {
                const int l = it >> 7, j0 = (it & 127) * 96;
                LAS float* red = (LAS float*)(F.lds + 67584 + 32768);
                float a[3][2] = {{0.f, 0.f}, {0.f, 0.f}, {0.f, 0.f}};
                if (lane < 48) {
                    const float* w = w_mod + ((size_t)l * D + (size_t)F.wave * 256) * (NMOD * D) + j0 + 2 * lane;
#pragma unroll 16
                    for (int k = 0; k < 256; ++k) { const int kk = F.wave * 256 + k; const float2 wv = *(const float2*)(w + (size_t)k * (NMOD * D));
                        const float s0 = sl[kk], s1 = sl[D + kk], s2 = sl[2 * D + kk];
                        a[0][0] += s0 * wv.x; a[0][1] += s0 * wv.y; a[1][0] += s1 * wv.x; a[1][1] += s1 * wv.y; a[2][0] += s2 * wv.x; a[2][1] += s2 * wv.y; }
#pragma unroll
                    for (int s = 0; s < 3; ++s) { red[(F.wave * 3 + s) * 96 + 2 * lane] = a[s][0]; red[(F.wave * 3 + s) * 96 + 2 * lane + 1] = a[s][1]; }
                }
                __syncthreads();
                if (tid < 288) { const int s = tid / 96, j = tid % 96; float v = b_mod[l * NMOD * D + j0 + j];
#pragma unroll
                    for (int w = 0; w < 8; ++w) v += red[(w * 3 + s) * 96 + j];
                    modv[((size_t)l * 3 + s) * (NMOD * D) + j0 + j] = v; }
                __syncthreads();
            }
        }
        {
            LAS float* scr = (LAS float*)(F.lds + F.wave * 8448);
            const int gw = F.vcu * NWAVES + F.wave, NGW = F.G * NWAVES;
            constexpr int I_IN = (D / 64) * (IN_DIM / 32), I_OUT = (D / 64) * (D / 32), I_GU = (D / 64) * (DEXP / 32), I_DN = (DEXP / 64) * (D / 32);
            constexpr int PER_L = I_IN + I_OUT + NEXP * (2 * I_GU + I_DN);
#ifdef PROBE_P0
            for (int rep_ = 0; rep_ < (PROBE_P0 == 3 ? 2 : 1); ++rep_)
#endif
            for (int it = gw; it < 2 * PER_L; it += NGW) {
                const int l = it / PER_L; int r = it % PER_L;
                if (r < I_IN) { const int nb = r % (IN_DIM / 32); p0_transpose_item(w_in + (size_t)l * D * IN_DIM, D, IN_DIM, Win_t + (size_t)l * IN_DIM * D, nb * 32, scr, r, lane); continue; } r -= I_IN;
                if (r < I_OUT) { const int nb = r % (D / 32); p0_transpose_item(w_out + (size_t)l * D * D, D, D, Wout_t + (size_t)l * D * D, nb * 32, scr, r, lane); continue; } r -= I_OUT;
                const int e = r / (2 * I_GU + I_DN); r %= (2 * I_GU + I_DN);
                const size_t le = (size_t)l * NEXP + e;
                if (r < 2 * I_GU) { const int up = r >= I_GU; if (up) r -= I_GU; const int nb = r % (DEXP / 32); const int n0 = nb * 32;
                    const int rowb = (n0 >> 7) * 256 + (n0 & 127) + up * 128;
                    p0_transpose_item((up ? w_up : w_gate) + le * D * DEXP, D, DEXP, Wgu_t + le * (2 * DEXP) * D, rowb, scr, r, lane); continue; } r -= 2 * I_GU;
                { const int nb = r % (D / 32); p0_transpose_item(w_down + le * DEXP * D, DEXP, D, Wdn_t + le * D * DEXP, nb * 32, scr, r, lane); }
            }
        }
    }


    if (kk == 0) {
        PHASE_PROLOG; const float* modl = modv + (size_t)l * 3 * NMOD * D; (void)modl;
        const float* g1 = g_norm1 + l * D;
        const int l4 = lane * 4;
#define N1_SRC(row) ((l == 0) ? ((row) < MLAT ? x_in + (size_t)(row) * D : ctx_in + (size_t)((row) - MLAT) * D) : X + (size_t)(row) * D)
        f32x4 vn[8]; pg8::u32x2 yn0[8], yn1[8];
        int row = gw;
        { const int r0 = min(row, MROWS - 1); const float* src = N1_SRC(r0);
#pragma unroll
            for (int j = 0; j < 8; ++j) vn[j] = *(const f32x4*)(src + l4 + 256 * j);
#pragma unroll
            for (int j = 0; j < 8; ++j) { yn0[j] = (pg8::u32x2){0u, 0u}; yn1[j] = (pg8::u32x2){0u, 0u}; }
            if (l == 1) {
#pragma unroll
                for (int j = 0; j < 8; ++j) { yn0[j] = *(const pg8::u32x2*)(Y2 + (size_t)(2 * r0) * D + l4 + 256 * j); yn1[j] = *(const pg8::u32x2*)(Y2 + (size_t)(2 * r0 + 1) * D + l4 + 256 * j); } } }
#pragma unroll 1
        for (; row < MROWS; row += NGW) {
            const int l4 = opqv(lane * 4);
            const int s = modsel(row);
            f32x4 v[8]; pg8::u32x2 y0[8], y1[8];
#pragma unroll
            for (int j = 0; j < 8; ++j) { v[j] = vn[j]; y0[j] = yn0[j]; y1[j] = yn1[j]; }
            const int nrow = min(row + NGW, MROWS - 1);
            { const float* src = N1_SRC(nrow);
#pragma unroll
                for (int j = 0; j < 8; ++j) vn[j] = *(const f32x4*)(src + l4 + 256 * j);
                if (l == 1) {
#pragma unroll
                    for (int j = 0; j < 8; ++j) { yn0[j] = *(const pg8::u32x2*)(Y2 + (size_t)(2 * nrow) * D + l4 + 256 * j); yn1[j] = *(const pg8::u32x2*)(Y2 + (size_t)(2 * nrow + 1) * D + l4 + 256 * j); } } }
            if (l == 1) {
                const float* ga = modv + (size_t)s * (NMOD * D) + 5 * D;
#pragma unroll
                for (int j = 0; j < 8; ++j) { const int col = l4 + 256 * j; const f32x4 g = *(const f32x4*)(ga + col);
                    v[j][0] += g[0] * (__uint_as_float(y0[j].x << 16) + __uint_as_float(y1[j].x << 16)); v[j][1] += g[1] * (__uint_as_float(y0[j].x & 0xffff0000u) + __uint_as_float(y1[j].x & 0xffff0000u));
                    v[j][2] += g[2] * (__uint_as_float(y0[j].y << 16) + __uint_as_float(y1[j].y << 16)); v[j][3] += g[3] * (__uint_as_float(y0[j].y & 0xffff0000u) + __uint_as_float(y1[j].y & 0xffff0000u));
                    *(f32x4*)(X + (size_t)row * D + col) = v[j]; }
            }
            float ss = 0.f;
#pragma unroll
            for (int j = 0; j < 8; ++j) ss += v[j][0] * v[j][0] + v[j][1] * v[j][1] + v[j][2] * v[j][2] + v[j][3] * v[j][3];
            ss = wave_sum(ss);
            const float rstd = rsqrtf(ss * (1.f / D) + 1e-6f);
            const float* sh = modl + (size_t)s * (NMOD * D); const float* sc = sh + D;
#pragma unroll
            for (int j = 0; j < 8; ++j) { const int col = l4 + 256 * j; const f32x4 g = *(const f32x4*)(g1 + col), a = *(const f32x4*)(sc + col), b = *(const f32x4*)(sh + col);
                const f32x4 h = v[j] * rstd * g * (a + 1.f) + b; pg8::u32x2 o; o.x = pk2(h[0], h[1]); o.y = pk2(h[2], h[3]); *(pg8::u32x2*)(H + (size_t)row * D + col) = o; }
        }
#undef N1_SRC
    }
    if (kk == 1) {
        PHASE_PROLOG; const float* modl = modv + (size_t)l * 3 * NMOD * D; (void)modl;
        pg8::Prob P{H, Win_t + (size_t)l * IN_DIM * D, D, D, D, 0, (long long)256 * D, 0, 0, (long long)256 * D, 0, 0};
        pg8::StaticOrder S; S.init(MROWS / 256, IN_DIM / 256, F.G, (int)blockIdx.x);
        for (int e = tid; e < 2048; e += NWAVES * 64) ((LAS float*)(F.lds + ROPE_OFF))[e] = rope[e];
        __syncthreads();
        pg8::EpiG1 E{U, (const PG8_LAS float*)(F.lds + ROPE_OFF)};
        pg8::gemm_phase<pg8::EpiG1, pg8::StaticOrder, false, true>(F.lds + RING_OFF, P, S, E, rows_lds);
    }
    if (kk == 2) {
        PHASE_PROLOG; const float* modl = modv + (size_t)l * 3 * NMOD * D; (void)modl;
        const int NT = mrows / 256;
        pg8::Prob P{WC, U + UF, 256, IN_DIM, 256, 0, 0, 0, 0, (long long)256 * IN_DIM, 128, 0};
        pg8::DftASched S{4 * NT, F.G, (int)blockIdx.x, 0};
        pg8::EpiDftA E{PQT, PQTC};
#ifdef PROBE_SUB
        for (int rep_ = 0; rep_ < (PROBE_SUB == 3 ? 2 : 1); ++rep_)
#endif
        pg8::gemm_phase<pg8::EpiDftA, pg8::DftASched, false, true>(F.lds + RING_OFF, P, S, E, rows_lds);
        __syncthreads();
        {
            const int nun = (l == 0) ? 272 : 256;
#ifdef PROBE_SUB
            for (int rep_ = 0; rep_ < (PROBE_SUB == 1 ? 2 : 1); ++rep_)
#endif
            for (int un = blockIdx.x; un < nun; un += F.G) att::attn_unit(F.lds + RING_OFF, U, MIX, INP(10) + l * 8, un, tid);
        }

        {
            const int nti = (l == 0) ? 272 : 256;
            if ((int)blockIdx.x < nti) { __syncthreads(); conv_fill_w(F.lds + RING_OFF, INP(12) + l * 31 * 512, tid); }
#ifdef PROBE_SUB
            for (int rep_ = 0; rep_ < (PROBE_SUB == 2 ? 2 : 1); ++rep_)
#endif
            for (int ti = blockIdx.x; ti < nti; ti += F.G) conv_tile(F.lds + RING_OFF, U, MIX, INP(11) + l * 3 * 512, INP(13) + l * 512, INP(14) + l * 512, INP(15) + l * 512, ti, tid);
        }
    }
    if (kk == 3) {
        PHASE_PROLOG; const float* modl = modv + (size_t)l * 3 * NMOD * D; (void)modl;
        { pg8::Prob P{CS, PQT, 2 * SEQ, 2 * SEQ, 2048, 0, (long long)256 * 2 * SEQ, 0, 2048, (long long)256 * 2 * SEQ, (long long)512 * 2 * SEQ, 2048};
          pg8::DftBSched S{256, F.G, (int)blockIdx.x, 0};
          pg8::EpiDftB E{PART, 0, 0, SEQ};
          pg8::gemm_phase<pg8::EpiDftB, pg8::DftBSched, false, true>(F.lds + RING_OFF, P, S, E, rows_lds); }
        if (l == 0) {
          pg8::Prob P{CSC, PQTC, 2 * CTXL, 2 * CTXL, 2 * CTXL, 0, 0, 0, 0, (long long)256 * 2 * CTXL, (long long)512 * 2 * CTXL, 0};
          pg8::DftBSched S{4, F.G, (int)blockIdx.x, 1};
          pg8::EpiDftB E{PART, MLAT, 0, CTXL};
          pg8::gemm_phase<pg8::EpiDftB, pg8::DftBSched, false, true>(F.lds + RING_OFF, P, S, E, rows_lds); }
    }
    if (kk == 4) {
        PHASE_PROLOG; const float* modl = modv + (size_t)l * 3 * NMOD * D; (void)modl;
        float sc_lat = 0.001381067932f, sc_ctx = 0.005524271728f;
        asm volatile("" : "+v"(sc_lat), "+v"(sc_ctx));
        const int nitems = mrows * 128;
        for (int it = blockIdx.x * (NWAVES * 64) + tid; it < nitems; it += F.G * NWAVES * 64) {
            const int row = it >> 7, n = (it & 127) * 4;
            f32x4 a = *(const f32x4*)(PART + (size_t)row * 512 + n);
            if (row < MLAT) { a += *(const f32x4*)(PART + ((size_t)MROWS + row) * 512 + n); a += *(const f32x4*)(PART + ((size_t)2 * MROWS + row) * 512 + n); a += *(const f32x4*)(PART + ((size_t)3 * MROWS + row) * 512 + n); a = a * sc_lat; }
            else a = a * sc_ctx;
            pg8::u32x2 o; o.x = pk2(a[0], a[1]); o.y = pk2(a[2], a[3]); *(pg8::u32x2*)(MIX + (size_t)row * D + 512 + n) = o;
        }
    }
    if (kk == 5) {
        PHASE_PROLOG; const float* modl = modv + (size_t)l * 3 * NMOD * D; (void)modl;
        pg8::Prob P{MIX, Wout_t + (size_t)l * D * D, D, D, D, 0, (long long)256 * D, 0, 0, (long long)256 * D, 0, 0};
        pg8::StaticOrder S; S.init(mrows / 256, D / 256, F.G, (int)blockIdx.x);
        pg8::EpiG2 E{X, l == 0 ? x_in : X, l == 0 ? ctx_in : X + (size_t)MLAT * D, modl};
        pg8::gemm_phase<pg8::EpiG2, pg8::StaticOrder, false, true>(F.lds + RING_OFF, P, S, E, rows_lds);
    }
    if (kk == 6) {
        PHASE_PROLOG; const float* modl = modv + (size_t)l * 3 * NMOD * D; (void)modl;
        N2Ctx C{X, H, g_norm2 + l * D, modl, w_rg + (size_t)l * D * 4, w_re + (size_t)l * D * 16, b_rg + l * 4, b_re + l * 16, tok_e, tok_w, F.ctl + 64 * l, list};
        LAS float* wt = (LAS float*)(F.lds + RING_OFF);
        const int nr = (mrows + F.G - 1) / F.G;
        const int rbeg = F.vcu * nr, rend = min(mrows, rbeg + nr);
        for (int rb = rbeg; rb < rend; rb += 40) {
            const int lim = min(rend, rb + 40);
#pragma unroll 1
            for (int gi = 0; gi < 3; ++gi) {
                int ra[2];
#pragma unroll
                for (int i = 0; i < 2; ++i) { const int r = rb + F.wave + 8 * (2 * gi + i); ra[i] = (r < lim && 2 * gi + i < 5) ? r : 0x7fffffff; }
                n2_group<2>(C, wt, ra, mrows, lane, tid);
            }
        }
        __syncthreads();
    }
    if (kk == 7 || kk == 8) {
        PHASE_PROLOG;
        const unsigned* cnt = F.ctl + 64 * l;
        { const int ph = kk;
            const int NPN = (ph == 7) ? 4 : 8;
            __syncthreads();
            if (tid == 0) {
                LAS int* pre = ulist + 40; pre[0] = 0;
                for (int e = 0; e < NEXP; ++e) pre[e + 1] = pre[e] + (int)((__hip_atomic_load(cnt + e, RLX_AGENT) + 255u) >> 8);
                int n = 0;
                for (int i = 0; i < 4; ++i) { const int L = i * F.G + (int)blockIdx.x; if (L >= pre[NEXP] * NPN) break; const int tau = L / NPN; int e = 0; while (pre[e + 1] <= tau) ++e;
                    ulist[n * 4] = tau; ulist[n * 4 + 1] = L % NPN; ulist[n * 4 + 2] = e; ulist[n * 4 + 3] = tau - pre[e]; ++n; }
                ulist[32] = n;
            }
            __syncthreads();
            const int nu = __builtin_amdgcn_readfirstlane(ulist[32]);
            for (int i = 0; i < nu; ++i) { const int e = ulist[i * 4 + 2], rt = ulist[i * 4 + 3]; const unsigned ce = __hip_atomic_load(cnt + e, RLX_AGENT);
                for (int r = tid; r < 256; r += NWAVES * 64) { const unsigned idx = (unsigned)rt * 256u + (unsigned)r; ((LAS unsigned*)(F.lds + ROWS_OFF))[i * 256 + r] = idx < ce ? list[(size_t)e * (2 * MROWS) + idx] : 0xFFFFFFFFu; } }
            __syncthreads();
            pg8::ListSched S{(const PG8_LAS int*)ulist, nu};
            if (ph == 7) {
                pg8::Prob P{H, Wgu_t + (size_t)l * NEXP * (2 * DEXP) * D, D, D, D, 0, 0, 0, 0, (long long)256 * D, (long long)(2 * DEXP) * D, 0};
                pg8::EpiMoeUp E{HIDB, tok_w, rows_lds};
                pg8::gemm_phase<pg8::EpiMoeUp, pg8::ListSched, true, true>(F.lds + RING_OFF, P, S, E, rows_lds);
            } else {
                pg8::Prob P{HIDB, Wdn_t + (size_t)l * NEXP * D * DEXP, DEXP, DEXP, DEXP, 0, (long long)256 * DEXP, 0, 0, (long long)256 * DEXP, (long long)D * DEXP, 0};
                pg8::EpiMoeDown E{Y2, rows_lds};
                pg8::gemm_phase<pg8::EpiMoeDown, pg8::ListSched, false, true>(F.lds + RING_OFF, P, S, E, rows_lds);
            }
        }
    }
    if (kk == -2) {
        PHASE_PROLOG;
        const float* modl1 = modv + (size_t)3 * NMOD * D;
        const int l4 = lane * 4;
        f32x4 vn[8]; pg8::u32x2 yn0[8], yn1[8];
        int row = gw;
        { const int r0 = min(row, MLAT - 1);
#pragma unroll
            for (int j = 0; j < 8; ++j) { vn[j] = *(const f32x4*)(X + (size_t)r0 * D + l4 + 256 * j); yn0[j] = *(const pg8::u32x2*)(Y2 + (size_t)(2 * r0) * D + l4 + 256 * j); yn1[j] = *(const pg8::u32x2*)(Y2 + (size_t)(2 * r0 + 1) * D + l4 + 256 * j); } }
#pragma unroll 1
        for (; row < MLAT; row += NGW) {
            const int l4 = opqv(lane * 4);
            const int s = modsel(row);
            const float* ga = modl1 + (size_t)s * (NMOD * D) + 5 * D;
            f32x4 v[8]; pg8::u32x2 y0[8], y1[8];
#pragma unroll
            for (int j = 0; j < 8; ++j) { v[j] = vn[j]; y0[j] = yn0[j]; y1[j] = yn1[j]; }
            const int nrow = min(row + NGW, MLAT - 1);
            {
#pragma unroll
                for (int j = 0; j < 8; ++j) { vn[j] = *(const f32x4*)(X + (size_t)nrow * D + l4 + 256 * j); yn0[j] = *(const pg8::u32x2*)(Y2 + (size_t)(2 * nrow) * D + l4 + 256 * j); yn1[j] = *(const pg8::u32x2*)(Y2 + (size_t)(2 * nrow + 1) * D + l4 + 256 * j); } }
            float ss = 0.f;
#pragma unroll
            for (int j = 0; j < 8; ++j) { const int col = l4 + 256 * j; const f32x4 g = *(const f32x4*)(ga + col);
                v[j][0] += g[0] * (__uint_as_float(y0[j].x << 16) + __uint_as_float(y1[j].x << 16)); v[j][1] += g[1] * (__uint_as_float(y0[j].x & 0xffff0000u) + __uint_as_float(y1[j].x & 0xffff0000u));
                v[j][2] += g[2] * (__uint_as_float(y0[j].y << 16) + __uint_as_float(y1[j].y << 16)); v[j][3] += g[3] * (__uint_as_float(y0[j].y & 0xffff0000u) + __uint_as_float(y1[j].y & 0xffff0000u));
                ss += v[j][0] * v[j][0] + v[j][1] * v[j][1] + v[j][2] * v[j][2] + v[j][3] * v[j][3]; }
            ss = wave_sum(ss);
            const float rstd = rsqrtf(ss * (1.f / D) + 1e-6f);
#pragma unroll
            for (int j = 0; j < 8; ++j) { const int col = l4 + 256 * j; const f32x4 g = *(const f32x4*)(g_final + col); *(f32x4*)(args.out + (size_t)row * D + col) = v[j] * rstd * g; }
        }
    }
    if (pi + 1 < hi) GRID_BAR();
  }
#undef x_in
#undef c_in
#undef ctx_in
#undef c_ctx
#undef w_mod
#undef b_mod
#undef w_in
#undef w_out
#undef w_gate
#undef w_up
#undef w_down
#undef modv
#undef rope
#undef tok_w
#undef tok_e
#undef list
#undef X
#undef H
#undef U
#undef MIX
#undef Y2
#undef Win_t
#undef Wout_t
#undef Wgu_t
#undef Wdn_t
#undef CS
#undef CSC
#undef WC
#undef PQT
#undef PQTC
#undef PART
#undef HIDB
#undef g_norm1
#undef g_norm2
#undef g_final
#undef w_rg
#undef b_rg
#undef w_re
#undef b_re
#undef PC_OF
#undef GRID_BAR
}

static int g_grid = 0;
static void mega_launch(MArgs a, int lo, int hi, int layer, int use_bar, hipStream_t stream) {
    a.ph_lo = lo; a.ph_hi = hi; a.layer = layer; a.use_bar = use_bar;
    hipLaunchKernelGGL(mega_fwd, dim3(g_grid), dim3(NWAVES * 64), LDS_BYTES, stream, a);
}
extern "C" void kernel_launch(void* const* d_in, const int* in_sizes, int n_in, void* d_out, int out_size, void* d_ws, size_t ws_size, hipStream_t stream) {
    if (g_grid == 0) {
        int dev = 0, cus = 0;
        (void)hipGetDevice(&dev); (void)hipDeviceGetAttribute(&cus, hipDeviceAttributeMultiprocessorCount, dev);
        (void)hipFuncSetAttribute((const void*)mega_fwd, hipFuncAttributeMaxDynamicSharedMemorySize, LDS_BYTES);
        g_grid = cus > 0 ? cus : 256;
    }
    const float* x_in = (const float*)d_in[0]; const float* ctx = (const float*)d_in[2];
    const float* g_norm1 = (const float*)d_in[6]; const float* g_norm2 = (const float*)d_in[7];
    const float* attn_sink = (const float*)d_in[10]; const float* sconv_w = (const float*)d_in[11];
    const float* cconv_w = (const float*)d_in[12]; const float* cconv_b = (const float*)d_in[13]; const float* cnorm_g = (const float*)d_in[14]; const float* cnorm_b = (const float*)d_in[15];
    const float* w_rg = (const float*)d_in[16]; const float* b_rg = (const float*)d_in[17]; const float* w_re = (const float*)d_in[18]; const float* b_re = (const float*)d_in[19];
    const float* g_final = (const float*)d_in[23];
    unsigned char* ws = (unsigned char*)d_ws;
    unsigned* ctl = (unsigned*)(ws + WS_CTL);
    float* modv = (float*)(ws + WS_MOD);
    int* tok_e = (int*)(ws + WS_TOK); float* tok_w = (float*)(ws + WS_TOK + 128 * 1024); unsigned* list = (unsigned*)(ws + WS_LIST);
    float* X = (float*)(ws + WS_X); bf16_t* H = (bf16_t*)(ws + WS_H); bf16_t* U = (bf16_t*)(ws + WS_U); bf16_t* MIX = (bf16_t*)(ws + WS_MIX);
    float* P = (float*)(ws + WS_P); float* Q = (float*)(ws + WS_Q); bf16_t* Y2 = (bf16_t*)(ws + WS_Y2);
    float* out = (float*)d_out;
    MArgs a{};
    for (int i = 0; i < 24; ++i) a.in[i] = (const float*)d_in[i];
    a.out = out; a.ws = ws;
    (void)hipMemsetAsync(ctl, 0, 65536, stream);
#ifdef PROBE_DUP
    mega_launch(a, 0, 21, 0, 1, stream);
#else
    mega_launch(a, 0, 20, 0, 1, stream);
#endif
}
```

```cpp
#include <hip/hip_runtime.h>
#include <stdint.h>
#include <math.h>

typedef unsigned short bf16_t;
__device__ __forceinline__ float bf2f(bf16_t v) { return __uint_as_float(((unsigned)v) << 16); }
__device__ __forceinline__ bf16_t f2bf(float f) { unsigned u = __float_as_uint(f); return (bf16_t)((u + 0x7fffu + ((u >> 16) & 1u)) >> 16); }

constexpr int D = 2048, SEQ = 4096, CTXL = 256, NBATCH = 2;
constexpr int MLAT = NBATCH * SEQ, MCTX = NBATCH * CTXL, MROWS = MLAT + MCTX;
constexpr int IN_DIM = 3840, NMOD = 6;
constexpr int NEXP = 16, DEXP = 512;
constexpr float QSCALE = 0.125f * 1.4426950408889634f;
constexpr float LOG2E = 1.4426950408889634f;
constexpr int UQ = 0, UK = 512, UV = 640, UF = 768, USB = 1280, USC = 1792, USV = 2304, UDA = 2816, UDG = 3328;

__device__ __forceinline__ int modsel(int row) { return row < SEQ ? 0 : (row < MLAT ? 1 : 2); }
__device__ __forceinline__ void seqinfo(int row, int& base, int& t, int& len) {
    if (row < MLAT) { base = row & ~(SEQ - 1); t = row & (SEQ - 1); len = SEQ; }
    else { int r = row - MLAT; base = MLAT + (r & ~(CTXL - 1)); t = r & (CTXL - 1); len = CTXL; }
}
__device__ __forceinline__ float silu_f(float v) { return v / (1.f + __expf(-v)); }
__device__ __forceinline__ float sigmoid_f(float v) { return 1.f / (1.f + __expf(-v)); }

constexpr size_t MiB = 1u << 20;
constexpr size_t WS_CTL = 0;
constexpr size_t WS_MODP = 1 * MiB;
constexpr size_t WS_MOD = 6 * MiB;
constexpr size_t WS_ROPE = 7 * MiB;
constexpr size_t WS_TOK = 8 * MiB;
constexpr size_t WS_LIST = 9 * MiB;
constexpr size_t WS_X = 16 * MiB;
constexpr size_t WS_H = 88 * MiB;
constexpr size_t WS_U = 124 * MiB;
constexpr size_t WS_MIX = 190 * MiB;
constexpr size_t WS_P = 226 * MiB;
constexpr size_t WS_Q = 244 * MiB;
constexpr size_t WS_HID = 262 * MiB;
constexpr size_t WS_Y2 = 280 * MiB;
constexpr size_t WS_END = 350 * MiB;

__global__ void k_mod_partial(const float* __restrict__ c, const float* __restrict__ c_ctx, const float* __restrict__ w_mod, float* __restrict__ part) {
    const int j = blockIdx.x * 256 + threadIdx.x, l = blockIdx.y, kc = blockIdx.z;
    __shared__ float sc[3][128];
    if (threadIdx.x < 128) {
        const int k = kc * 128 + threadIdx.x;
        sc[0][threadIdx.x] = silu_f(c[k]); sc[1][threadIdx.x] = silu_f(c[D + k]); sc[2][threadIdx.x] = silu_f(c_ctx[k]);
    }
    __syncthreads();
    const float* w = w_mod + ((size_t)l * D + (size_t)kc * 128) * (NMOD * D) + j;
    float a0 = 0.f, a1 = 0.f, a2 = 0.f;
#pragma unroll 8
    for (int k = 0; k < 128; ++k) { const float wv = w[(size_t)k * (NMOD * D)]; a0 += sc[0][k] * wv; a1 += sc[1][k] * wv; a2 += sc[2][k] * wv; }
    float* p = part + (((size_t)kc * 2 + l) * 3) * (NMOD * D) + j;
    p[0] = a0; p[NMOD * D] = a1; p[2 * NMOD * D] = a2;
}
__global__ void k_mod_reduce(const float* __restrict__ part, const float* __restrict__ b_mod, float* __restrict__ modv) {
    const int idx = blockIdx.x * 256 + threadIdx.x;
    if (idx >= 2 * 3 * NMOD * D) return;
    const int j = idx % (NMOD * D), l = idx / (3 * NMOD * D);
    float a = b_mod[l * NMOD * D + j];
    for (int kc = 0; kc < 16; ++kc) a += part[(size_t)kc * (2 * 3 * NMOD * D) + idx];
    modv[idx] = a;
}
__global__ void k_rope_table(float* __restrict__ tab) {
    const int idx = blockIdx.x * 256 + threadIdx.x; if (idx >= 64 * 16) return;
    const int pos = idx >> 4, i = idx & 15;
    const float freq = powf(10000.f, -(float)(2 * i) / 32.f);
    const float ang = (float)pos * freq;
    tab[idx * 2] = cosf(ang); tab[idx * 2 + 1] = sinf(ang);
}
__global__ void k_init_x(const float* __restrict__ x, const float* __restrict__ ctx, float* __restrict__ X) {
    const size_t i = (size_t)blockIdx.x * 256 + threadIdx.x;
    const size_t nlat = (size_t)MLAT * D / 4, ntot = (size_t)MROWS * D / 4;
    if (i >= ntot) return;
    ((float4*)X)[i] = i < nlat ? ((const float4*)x)[i] : ((const float4*)ctx)[i - nlat];
}

__device__ __forceinline__ float wave_sum(float v) {
#pragma unroll
    for (int o = 32; o > 0; o >>= 1) v += __shfl_xor(v, o);
    return v;
}
template <int NW> __device__ __forceinline__ float block_sum(float v, float* red) {
    v = wave_sum(v);
    const int w = threadIdx.x >> 6;
    __syncthreads();
    if ((threadIdx.x & 63) == 0) red[w] = v;
    __syncthreads();
    float s = 0.f;
#pragma unroll
    for (int i = 0; i < NW; ++i) s += red[i];
    return s;
}

struct RouteW { const float* wg; const float* bg; const float* we; const float* be; int* tok_e; float* tok_w; unsigned* cnt; unsigned* list; };
template <bool ROUTE, bool COMBINE>
__global__ void __launch_bounds__(256) k_norm(float* __restrict__ X, const float* __restrict__ g, const float* __restrict__ modv_l, long long sh_idx, bf16_t* __restrict__ H,
                                              const bf16_t* __restrict__ Y2, const float* __restrict__ modv_prev, RouteW R) {
    __shared__ float red[4];
    __shared__ float rl[20][4];
    const int row = blockIdx.x, tid = threadIdx.x, s = modsel(row);
    float v[8];
    float* xr = X + (size_t)row * D;
#pragma unroll
    for (int i = 0; i < 2; ++i) { const float4 t = *(const float4*)(xr + i * 1024 + tid * 4); v[i * 4] = t.x; v[i * 4 + 1] = t.y; v[i * 4 + 2] = t.z; v[i * 4 + 3] = t.w; }
    if (COMBINE) {
        const float* ga = modv_prev + (size_t)s * (NMOD * D) + 5 * D;
#pragma unroll
        for (int i = 0; i < 2; ++i)
#pragma unroll
            for (int j = 0; j < 4; ++j) { const int col = i * 1024 + tid * 4 + j; v[i * 4 + j] += ga[col] * (bf2f(Y2[(size_t)(2 * row) * D + col]) + bf2f(Y2[(size_t)(2 * row + 1) * D + col])); }
#pragma unroll
        for (int i = 0; i < 2; ++i) *(float4*)(xr + i * 1024 + tid * 4) = make_float4(v[i * 4], v[i * 4 + 1], v[i * 4 + 2], v[i * 4 + 3]);
    }
    float ss = 0.f;
#pragma unroll
    for (int i = 0; i < 8; ++i) ss += v[i] * v[i];
    ss = block_sum<4>(ss, red);
    const float rstd = rsqrtf(ss * (1.f / D) + 1e-6f);
    const float* sh = modv_l + (size_t)s * (NMOD * D) + (size_t)sh_idx * D;
    const float* sc = sh + D;
    float hv[8];
#pragma unroll
    for (int i = 0; i < 2; ++i)
#pragma unroll
        for (int j = 0; j < 4; ++j) { const int col = i * 1024 + tid * 4 + j; hv[i * 4 + j] = v[i * 4 + j] * rstd * g[col] * (1.f + sc[col]) + sh[col]; }
#pragma unroll
    for (int i = 0; i < 2; ++i) {
        ushort4 o; o.x = f2bf(hv[i * 4]); o.y = f2bf(hv[i * 4 + 1]); o.z = f2bf(hv[i * 4 + 2]); o.w = f2bf(hv[i * 4 + 3]);
        *(ushort4*)(H + (size_t)row * D + i * 1024 + tid * 4) = o;
    }
    if (ROUTE) {
        float acc[20];
#pragma unroll
        for (int q = 0; q < 20; ++q) acc[q] = 0.f;
#pragma unroll
        for (int i = 0; i < 2; ++i)
#pragma unroll
            for (int j = 0; j < 4; ++j) {
                const int col = i * 1024 + tid * 4 + j; const float hvv = hv[i * 4 + j];
                const float4 wgv = *(const float4*)(R.wg + (size_t)col * 4);
                acc[0] += hvv * wgv.x; acc[1] += hvv * wgv.y; acc[2] += hvv * wgv.z; acc[3] += hvv * wgv.w;
#pragma unroll
                for (int q = 0; q < 4; ++q) { const float4 wv = *(const float4*)(R.we + (size_t)col * 16 + q * 4); acc[4 + q * 4] += hvv * wv.x; acc[5 + q * 4] += hvv * wv.y; acc[6 + q * 4] += hvv * wv.z; acc[7 + q * 4] += hvv * wv.w; }
            }
#pragma unroll
        for (int q = 0; q < 20; ++q) { const float t = wave_sum(acc[q]); if ((tid & 63) == 0) rl[q][tid >> 6] = t; }
        __syncthreads();
        if (tid == 0) {
            float gl[4], el[16];
            for (int q = 0; q < 4; ++q) gl[q] = rl[q][0] + rl[q][1] + rl[q][2] + rl[q][3] + R.bg[q];
            for (int q = 0; q < 16; ++q) el[q] = rl[4 + q][0] + rl[4 + q][1] + rl[4 + q][2] + rl[4 + q][3] + R.be[q];
            int gs = 0; for (int q = 1; q < 4; ++q) if (gl[q] > gl[gs]) gs = q;
            float den = 0.f; for (int q = 0; q < 4; ++q) den += __expf(gl[q] - gl[gs]);
            const float pg = 1.f / den;
            const float* eg = el + gs * 4;
            int i0 = 0; for (int q = 1; q < 4; ++q) if (eg[q] > eg[i0]) i0 = q;
            int i1 = -1; for (int q = 0; q < 4; ++q) if (q != i0 && (i1 < 0 || eg[q] > eg[i1])) i1 = q;
            const float w0 = 1.f / (1.f + __expf(eg[i1] - eg[i0])), w1 = 1.f - w0;
            const int e0 = gs * 4 + i0, e1 = gs * 4 + i1;
            R.tok_e[row * 2] = e0; R.tok_e[row * 2 + 1] = e1; R.tok_w[row * 2] = w0 * pg; R.tok_w[row * 2 + 1] = w1 * pg;
            const unsigned p0 = atomicAdd(R.cnt + e0, 1u); R.list[(size_t)e0 * (2 * MROWS) + p0] = row * 2;
            const unsigned p1 = atomicAdd(R.cnt + e1, 1u); R.list[(size_t)e1 * (2 * MROWS) + p1] = row * 2 + 1;
        }
    }
}

struct ARowsPlain { const bf16_t* A; long long lda; __device__ __forceinline__ const bf16_t* row(int m) const { return A + (size_t)m * lda; } __device__ __forceinline__ int nrows(int M) const { return M; } };
struct ARowsList { const bf16_t* A; long long lda; const unsigned* list; long long shift; const unsigned* cnt; __device__ __forceinline__ const bf16_t* row(int m) const { return A + (size_t)(list[m] >> shift) * lda; } __device__ __forceinline__ int nrows(int) const { return (int)*cnt; } };
template <class AR, class Epi, int NB>
__global__ void __launch_bounds__(256) k_gemm(AR ar, const float* __restrict__ W0, const float* __restrict__ W1, int ldw, int M, int N, int K, Epi epi) {
    __shared__ float As[16][65];
    __shared__ float Bs[NB][16][64];
    const int Mr = ar.nrows(M);
    const int m0 = blockIdx.y * 64, n0 = blockIdx.x * 64;
    if (m0 >= Mr) return;
    const int tid = threadIdx.x, tx = tid & 15, ty = tid >> 4;
    float acc[NB][4][4];
#pragma unroll
    for (int b = 0; b < NB; ++b)
#pragma unroll
        for (int i = 0; i < 4; ++i)
#pragma unroll
            for (int j = 0; j < 4; ++j) acc[b][i][j] = 0.f;
    const int ar_m = tid >> 2, ar_k = (tid & 3) * 4;
    const bool a_ok = (m0 + ar_m) < Mr;
    const bf16_t* arow = a_ok ? ar.row(m0 + ar_m) : nullptr;
    const int br_k = tid >> 4, br_n = (tid & 15) * 4;
    for (int k0 = 0; k0 < K; k0 += 16) {
        ushort4 av = make_ushort4(0, 0, 0, 0);
        if (a_ok) av = *(const ushort4*)(arow + k0 + ar_k);
        As[ar_k][ar_m] = bf2f(av.x); As[ar_k + 1][ar_m] = bf2f(av.y); As[ar_k + 2][ar_m] = bf2f(av.z); As[ar_k + 3][ar_m] = bf2f(av.w);
        { const float4 bv = *(const float4*)(W0 + (size_t)(k0 + br_k) * ldw + n0 + br_n); *(float4*)&Bs[0][br_k][br_n] = bv; }
        if (NB == 2) { const float4 bv = *(const float4*)(W1 + (size_t)(k0 + br_k) * ldw + n0 + br_n); *(float4*)&Bs[NB - 1][br_k][br_n] = bv; }
        __syncthreads();
#pragma unroll
        for (int k = 0; k < 16; ++k) {
            float a[4];
#pragma unroll
            for (int i = 0; i < 4; ++i) a[i] = As[k][ty * 4 + i];
#pragma unroll
            for (int b = 0; b < NB; ++b) {
                const float4 bv = *(const float4*)&Bs[b][k][tx * 4];
#pragma unroll
                for (int i = 0; i < 4; ++i) { acc[b][i][0] += a[i] * bv.x; acc[b][i][1] += a[i] * bv.y; acc[b][i][2] += a[i] * bv.z; acc[b][i][3] += a[i] * bv.w; }
            }
        }
        __syncthreads();
    }
#pragma unroll
    for (int i = 0; i < 4; ++i) { const int m = m0 + ty * 4 + i; if (m < Mr) epi(m, n0 + tx * 4, acc, i); }
}
struct EpiStoreBf16 { bf16_t* C; long long ldc;
    __device__ __forceinline__ void operator()(int m, int n, const float (&acc)[1][4][4], int i) const {
        ushort4 o; o.x = f2bf(acc[0][i][0]); o.y = f2bf(acc[0][i][1]); o.z = f2bf(acc[0][i][2]); o.w = f2bf(acc[0][i][3]); *(ushort4*)(C + (size_t)m * ldc + n) = o; } };
struct EpiResid { float* X; const float* modv_l; long long ga_idx;
    __device__ __forceinline__ void operator()(int m, int n, const float (&acc)[1][4][4], int i) const {
        const float* ga = modv_l + (size_t)modsel(m) * (NMOD * D) + (size_t)ga_idx * D + n; float4* p = (float4*)(X + (size_t)m * D + n); float4 x = *p;
        x.x += ga[0] * acc[0][i][0]; x.y += ga[1] * acc[0][i][1]; x.z += ga[2] * acc[0][i][2]; x.w += ga[3] * acc[0][i][3]; *p = x; } };
struct EpiMoeUp { bf16_t* Hid; const unsigned* list; const float* tok_w;
    __device__ __forceinline__ void operator()(int m, int n, const float (&acc)[2][4][4], int i) const {
        const unsigned ent = list[m]; const float w = tok_w[ent]; ushort4 o;
        o.x = f2bf(silu_f(acc[0][i][0]) * acc[1][i][0] * w); o.y = f2bf(silu_f(acc[0][i][1]) * acc[1][i][1] * w); o.z = f2bf(silu_f(acc[0][i][2]) * acc[1][i][2] * w); o.w = f2bf(silu_f(acc[0][i][3]) * acc[1][i][3] * w);
        *(ushort4*)(Hid + (size_t)ent * DEXP + n) = o; } };
struct EpiMoeDown { bf16_t* Y2; const unsigned* list;
    __device__ __forceinline__ void operator()(int m, int n, const float (&acc)[1][4][4], int i) const {
        const unsigned ent = list[m]; ushort4 o; o.x = f2bf(acc[0][i][0]); o.y = f2bf(acc[0][i][1]); o.z = f2bf(acc[0][i][2]); o.w = f2bf(acc[0][i][3]); *(ushort4*)(Y2 + (size_t)ent * D + n) = o; } };

__global__ void k_rope(bf16_t* __restrict__ U, const float* __restrict__ tab, long long nrows_) {
    const int idx = blockIdx.x * 256 + threadIdx.x;
    const int nrows = (int)nrows_; if (idx >= nrows * 320) return;
    const int row = idx / 320, r = idx % 320, hs = r >> 5, i = r & 31;
    const int axis = i >> 4, fi = i & 15;
    const int col0 = hs * 64 + axis * 32 + fi;
    bf16_t* p = U + (size_t)row * IN_DIM + col0;
    float z1 = bf2f(p[0]), z2 = bf2f(p[16]);
    const float sc = hs < 8 ? QSCALE : 1.f;
    if (row < MLAT) {
        const int t = row & (SEQ - 1); const int pos = axis ? (t & 63) : (t >> 6);
        const float c = tab[(pos * 16 + fi) * 2], s = tab[(pos * 16 + fi) * 2 + 1];
        const float o1 = z1 * c - z2 * s, o2 = z1 * s + z2 * c; z1 = o1; z2 = o2;
    }
    p[0] = f2bf(z1 * sc); p[16] = f2bf(z2 * sc);
}

__global__ void __launch_bounds__(64) k_attn(const bf16_t* __restrict__ U, const float* __restrict__ sink, bf16_t* __restrict__ MIX) {
    __shared__ float qs[64];
    __shared__ float ps[576];
    const int row = blockIdx.x, h = blockIdx.y, kvh = h >> 2, lane = threadIdx.x;
    int base, t, len; seqinfo(row, base, t, len);
    const int b = row < MLAT ? (row >> 12) : ((row - MLAT) >> 8);
    qs[lane] = bf2f(U[(size_t)row * IN_DIM + UQ + h * 64 + lane]);
    __syncthreads();
    int lo = 0, nloc = 0;
    if (row < MLAT) { lo = max(0, t - 128); const int hi = min(SEQ - 1, t + 128); nloc = hi - lo + 1; }
    const int nk = nloc + CTXL;
    const int cbase = MLAT + b * CTXL;
    float mx = sink[h] * LOG2E;
    for (int j = lane; j < nk; j += 64) {
        const int krow = j < nloc ? (base + lo + j) : (cbase + j - nloc);
        const bf16_t* kp = U + (size_t)krow * IN_DIM + UK + kvh * 64;
        float s = 0.f;
#pragma unroll 8
        for (int d = 0; d < 64; ++d) s += qs[d] * bf2f(kp[d]);
        ps[j] = s; mx = fmaxf(mx, s);
    }
#pragma unroll
    for (int o = 32; o > 0; o >>= 1) mx = fmaxf(mx, __shfl_xor(mx, o));
    float sum = 0.f;
    for (int j = lane; j < nk; j += 64) { const float p = exp2f(ps[j] - mx); ps[j] = p; sum += p; }
    sum = wave_sum(sum) + exp2f(sink[h] * LOG2E - mx);
    __syncthreads();
    float o = 0.f;
    for (int j = 0; j < nk; ++j) {
        const int krow = j < nloc ? (base + lo + j) : (cbase + j - nloc);
        o += ps[j] * bf2f(U[(size_t)krow * IN_DIM + UV + kvh * 64 + lane]);
    }
    MIX[(size_t)row * D + h * 64 + lane] = f2bf(o / sum);
}

__global__ void k_dftA(const bf16_t* __restrict__ U, float* __restrict__ P, float* __restrict__ Q) {
    __shared__ float ct[128], st[128];
    __shared__ float f[512];
    const int row = blockIdx.x, tid = threadIdx.x;
    if (tid < 128) { const float a = 6.283185307179586f * (float)tid / 128.f; ct[tid] = cosf(a); st[tid] = sinf(a); }
    f[tid] = bf2f(U[(size_t)row * IN_DIM + UF + tid]);
    __syncthreads();
    const int g = tid >> 7, cp = tid & 127;
    float p = 0.f, q = 0.f;
    for (int c = 0; c < 128; ++c) { const int k = (c * cp) & 127; const float fv = f[g * 128 + c]; p += fv * ct[k]; q += fv * st[k]; }
    P[(size_t)row * 512 + tid] = p; Q[(size_t)row * 512 + tid] = q;
}
__global__ void __launch_bounds__(256) k_dftB(const float* __restrict__ P, const float* __restrict__ Q, bf16_t* __restrict__ MIX, int T, int row0, int tabstep, int pad_) {
    __shared__ float ct[4096], st[4096];
    __shared__ float Ps[16][64], Qs[16][64];
    const int tid = threadIdx.x, tx = tid & 15, ty = tid >> 4;
    for (int i = tid; i < 4096; i += 256) { const float a = 6.283185307179586f * (float)i / 4096.f; ct[i] = cosf(a); st[i] = sinf(a); }
    const int n0 = blockIdx.x * 64, tp0 = blockIdx.y * 64, sbase = row0 + blockIdx.z * T;
    float acc[4][4];
#pragma unroll
    for (int i = 0; i < 4; ++i)
#pragma unroll
        for (int j = 0; j < 4; ++j) acc[i][j] = 0.f;
    const int lk = tid >> 4, ln = (tid & 15) * 4;
    for (int t0 = 0; t0 < T; t0 += 16) {
        __syncthreads();
        *(float4*)&Ps[lk][ln] = *(const float4*)(P + (size_t)(sbase + t0 + lk) * 512 + n0 + ln);
        *(float4*)&Qs[lk][ln] = *(const float4*)(Q + (size_t)(sbase + t0 + lk) * 512 + n0 + ln);
        __syncthreads();
#pragma unroll 4
        for (int k = 0; k < 16; ++k) {
            const float4 pv = *(const float4*)&Ps[k][tx * 4], qv = *(const float4*)&Qs[k][tx * 4];
#pragma unroll
            for (int i = 0; i < 4; ++i) {
                const int tp = tp0 + ty * 4 + i; const int idx = (((t0 + k) * tp) & (T - 1)) * tabstep;
                const float c = ct[idx], s = st[idx];
                acc[i][0] += c * pv.x - s * qv.x; acc[i][1] += c * pv.y - s * qv.y; acc[i][2] += c * pv.z - s * qv.z; acc[i][3] += c * pv.w - s * qv.w;
            }
        }
    }
    const float scale = rsqrtf((float)T * 128.f);
#pragma unroll
    for (int i = 0; i < 4; ++i) {
        const int tp = tp0 + ty * 4 + i; ushort4 o; o.x = f2bf(acc[i][0] * scale); o.y = f2bf(acc[i][1] * scale); o.z = f2bf(acc[i][2] * scale); o.w = f2bf(acc[i][3] * scale);
        *(ushort4*)(MIX + (size_t)(sbase + tp) * D + 512 + n0 + tx * 4) = o;
    }
}

__global__ void __launch_bounds__(512) k_convs(const bf16_t* __restrict__ U, const float* __restrict__ sw, const float* __restrict__ cw, const float* __restrict__ cb,
                                               const float* __restrict__ ng, const float* __restrict__ nb, bf16_t* __restrict__ MIX) {
    __shared__ float red[8];
    const int row = blockIdx.x, c = threadIdx.x;
    int base, t, len; seqinfo(row, base, t, len);
    float a = 0.f;
#pragma unroll
    for (int j = 0; j < 3; ++j) { const int tt = t + j - 1; if (tt >= 0 && tt < len) { const bf16_t* u = U + (size_t)(base + tt) * IN_DIM; a += sw[j * 512 + c] * bf2f(u[USC + c]) * bf2f(u[USV + c]); } }
    a *= bf2f(U[(size_t)row * IN_DIM + USB + c]);
    MIX[(size_t)row * D + 1024 + c] = f2bf(a);
    float z = cb[c];
    for (int j = 0; j < 31; ++j) { const int tt = t + j - 15; if (tt >= 0 && tt < len) { const bf16_t* u = U + (size_t)(base + tt) * IN_DIM; z += cw[j * 512 + c] * bf2f(u[UDA + c]) * sigmoid_f(bf2f(u[UDG + c])); } }
    const float mu = block_sum<8>(z, red) * (1.f / 512.f);
    const float dz = z - mu;
    const float var = block_sum<8>(dz * dz, red) * (1.f / 512.f);
    const float y = dz * rsqrtf(var + 1e-6f) * ng[c] + nb[c];
    MIX[(size_t)row * D + 1536 + c] = f2bf(silu_f(y));
}

__global__ void __launch_bounds__(256) k_final(const float* __restrict__ X, const float* __restrict__ g, const bf16_t* __restrict__ Y2, const float* __restrict__ modv_prev, float* __restrict__ out) {
    __shared__ float red[4];
    const int row = blockIdx.x, tid = threadIdx.x, s = modsel(row);
    const float* ga = modv_prev + (size_t)s * (NMOD * D) + 5 * D;
    float v[8];
#pragma unroll
    for (int i = 0; i < 2; ++i)
#pragma unroll
        for (int j = 0; j < 4; ++j) { const int col = i * 1024 + tid * 4 + j; v[i * 4 + j] = X[(size_t)row * D + col] + ga[col] * (bf2f(Y2[(size_t)(2 * row) * D + col]) + bf2f(Y2[(size_t)(2 * row + 1) * D + col])); }
    float ss = 0.f;
#pragma unroll
    for (int i = 0; i < 8; ++i) ss += v[i] * v[i];
    ss = block_sum<4>(ss, red);
    const float rstd = rsqrtf(ss * (1.f / D) + 1e-6f);
#pragma unroll
    for (int i = 0; i < 2; ++i) { const int col = i * 1024 + tid * 4; *(float4*)(out + (size_t)row * D + col) = make_float4(v[i * 4] * rstd * g[col], v[i * 4 + 1] * rstd * g[col + 1], v[i * 4 + 2] * rstd * g[col + 2], v[i * 4 + 3] * rstd * g[col + 3]); }
}


namespace pg8 {
#define PG8_LAS __attribute__((address_space(3)))
typedef short bf16x8 __attribute__((ext_vector_type(8)));
typedef float f32x4 __attribute__((ext_vector_type(4)));
typedef unsigned u32x4 __attribute__((ext_vector_type(4)));
typedef unsigned u32x2 __attribute__((ext_vector_type(2)));
constexpr int BM = 256, BK = 64, HALF = 128, HTB = HALF * BK * 2, STAGE_BYTES = 8 * HTB, NXCD = 8, WGM = 8;
__host__ __device__ __forceinline__ int lds_byte(int r, int c) { const int st = (r >> 4) * 2 + (c >> 5), rr = r & 15, cc = c & 31, ob = rr * 64 + cc * 2; return st * 1024 + (ob ^ (((ob >> 9) & 1) << 5)); }
__host__ __device__ __forceinline__ void stage_rc(int b, int& R, int& C) { const int st = b / 1024, sb = b % 1024, swz = sb ^ (((sb >> 9) & 1) << 5); R = (st >> 1) * 16 + swz / 64; C = (st & 1) * 32 + (swz % 64) / 2; }
__host__ __device__ __forceinline__ int perm32(int rho) { const int n = rho >> 4, i = rho & 15; return 8 * (i >> 2) + 4 * n + (i & 3); }

struct Unit { int pm, pn, grp, aux; };
struct Prob {
    const bf16_t* A; const bf16_t* Bt; int lda, ldb, K, pad;
    long long a_pm, a_grp, a_aux, b_pn, b_grp, b_aux;
    __device__ __forceinline__ const char* a_base(const Unit& u) const { return (const char*)(A + (long long)u.pm * a_pm + (long long)u.grp * a_grp + (long long)u.aux * a_aux); }
    __device__ __forceinline__ const char* b_base(const Unit& u) const { return (const char*)(Bt + (long long)u.pn * b_pn + (long long)u.grp * b_grp + (long long)u.aux * b_aux); }
};
struct StaticOrder {
    int nM, nN, nwg, G, c;
    __device__ void init(int nM_, int nN_, int G_, int c_) { nM = nM_; nN = nN_; nwg = nM * nN; G = G_; c = c_; }
    __device__ bool next(int i, Unit& u) const {
        const long L = (long)i * G + c; if (L >= nwg) return false;
        int wgid = (int)L; { const int q = nwg / NXCD, r = nwg % NXCD, xcd = wgid % NXCD, off = wgid / NXCD; wgid = (xcd < r ? xcd * (q + 1) : r * (q + 1) + (xcd - r) * q) + off; }
        const int nig = WGM * nN, gid = wgid / nig, fm = gid * WGM, gsz = (nM - fm) < WGM ? (nM - fm) : WGM;
        u.pm = fm + ((wgid % nig) % gsz); u.pn = (wgid % nig) / gsz; u.grp = 0; u.aux = 0; return true;
    }
};
struct ListSched {
    const PG8_LAS int* ul; int n;
    __device__ bool next(int i, Unit& u) const {
        if (i >= n) return false;
        u.pm = __builtin_amdgcn_readfirstlane(ul[i * 4]); u.pn = __builtin_amdgcn_readfirstlane(ul[i * 4 + 1]); u.grp = __builtin_amdgcn_readfirstlane(ul[i * 4 + 2]); u.aux = __builtin_amdgcn_readfirstlane(ul[i * 4 + 3]); return true;
    }
};
struct DftASched { int n, G, c, pad;
    __device__ bool next(int i, Unit& u) const { const int L = i * G + c; if (L >= n) return false; u.pm = 0; u.pn = L >> 2; u.grp = L & 3; u.aux = 0; return true; } };
struct DftBSched { int n, G, c, mode;
    __device__ bool next(int i, Unit& u) const { const int L = i * G + c; if (L >= n) return false;
        if (mode == 0) { const int x = L & 7, idx = L >> 3; u.aux = x & 3; u.pm = (x >> 2) * 8 + (idx & 7); u.grp = (idx >> 3) & 1; u.pn = idx >> 4; }
        else { u.grp = L >> 1; u.pn = L & 1; u.pm = 0; u.aux = 0; } return true; } };
__device__ __forceinline__ unsigned cvt_pk_bf16(float lo, float hi) { unsigned r; asm volatile("v_cvt_pk_bf16_f32 %0, %1, %2" : "=v"(r) : "v"(lo), "v"(hi)); return r; }

template <class Epi, class Sched, bool GATHER, bool ALIGN_EPI>
__device__ __forceinline__ void gemm_phase(PG8_LAS unsigned char* lds, const Prob P, const Sched& S, const Epi& E, const PG8_LAS unsigned* rows_lds) {
    int tid_ = threadIdx.x; asm volatile("" : "+v"(tid_));
    const int tid = tid_, wid = __builtin_amdgcn_readfirstlane(tid >> 6), lane = tid & 63, wr = wid >> 2, wc = wid & 3, fr = lane & 15, fq = lane >> 4;
    const int K = P.K, nt = K / BK;
    int Rr[2], Cc[2];
    unsigned voB[2], voA[2][2];
#pragma unroll
    for (int i = 0; i < 2; ++i) { int R, C; stage_rc(tid * 16 + i * 8192, R, C); Rr[i] = R; Cc[i] = C; const int Rb = Epi::PERM ? ((R & ~31) + perm32(R & 31)) : R;
        voB[i] = (unsigned)(Rb * P.ldb + C) * 2u; }
#define PG8_SETVOA(slot) do { _Pragma("unroll") for (int _h = 0; _h < 2; ++_h) _Pragma("unroll") for (int _i = 0; _i < 2; ++_i) { \
        unsigned _row = (unsigned)(_h * HALF + Rr[_i]); if (GATHER) { const unsigned _e = rows_lds[(slot) * 256 + _h * HALF + Rr[_i]]; _row = (_e == 0xFFFFFFFFu) ? 0u : (_e >> 1); } \
        voA[_h][_i] = (_row * (unsigned)P.lda + (unsigned)Cc[_i]) * 2u; } } while (0)
    const size_t kstep = (size_t)(BK * 2);
    const size_t hstepB = (size_t)HALF * P.ldb * 2;
    const unsigned ldsw = (unsigned)wid * 1024u;
    const int aoff = lds_byte(wr * 64 + fr, fq * 8), boff = lds_byte(wc * 32 + fr, fq * 8);
#define PG8_SA(b, h) (((b) * 2 + (h)) * HTB)
#define PG8_SB(b, h) ((4 + (b) * 2 + (h)) * HTB)
#define PG8_STAGE(bufoff, gbase, voff) do { _Pragma("unroll") for (int _i = 0; _i < 2; ++_i) \
        __builtin_amdgcn_global_load_lds((const unsigned*)((const char*)(gbase) + (voff)[_i]), (PG8_LAS unsigned*)(lds + (bufoff) + ldsw + _i * 8192), 16, 0, 0); } while (0)
#define PG8_LDA(dst, b, h) do { _Pragma("unroll") for (int m = 0; m < 4; ++m) _Pragma("unroll") for (int k = 0; k < 2; ++k) dst[m][k] = *(const PG8_LAS bf16x8*)(lds + PG8_SA(b, h) + aoff + m * 2048 + k * 1024); } while (0)
#define PG8_LDB(dst, b, h) do { _Pragma("unroll") for (int n = 0; n < 2; ++n) _Pragma("unroll") for (int k = 0; k < 2; ++k) dst[n][k] = *(const PG8_LAS bf16x8*)(lds + PG8_SB(b, h) + boff + n * 2048 + k * 1024); } while (0)
#define PG8_MMA(ai, bj, At, Bt) do { __builtin_amdgcn_s_setprio(1); _Pragma("unroll") for (int m = 0; m < 4; ++m) _Pragma("unroll") for (int n = 0; n < 2; ++n) _Pragma("unroll") for (int k = 0; k < 2; ++k) \
        acc[ai][bj][m][n] = __builtin_amdgcn_mfma_f32_16x16x32_bf16(Bt[n][k], At[m][k], acc[ai][bj][m][n], 0, 0, 0); __builtin_amdgcn_s_setprio(0); } while (0)
#define PG8_WAIT_V(n) asm volatile("s_waitcnt vmcnt(" #n ")" ::: "memory")
#define PG8_WAIT_L(n) asm volatile("s_waitcnt lgkmcnt(" #n ")" ::: "memory")
#define PG8_BAR __builtin_amdgcn_s_barrier()
#define PG8_SCHED __builtin_amdgcn_sched_barrier(0)
    Unit cur, nxt; int ui = 0;
    if (!S.next(0, cur)) return;
    f32x4 acc[2][2][4][2];
#pragma unroll
    for (int a = 0; a < 2; ++a)
#pragma unroll
        for (int b = 0; b < 2; ++b)
#pragma unroll
            for (int m = 0; m < 4; ++m)
#pragma unroll
                for (int n = 0; n < 2; ++n) acc[a][b][m][n] = (f32x4){0.f, 0.f, 0.f, 0.f};
    bf16x8 At[4][2], B0[2][2], B1[2][2];
    const char* cA = P.a_base(cur); const char* cB = P.b_base(cur);
    PG8_SETVOA(0);
    PG8_STAGE(PG8_SB(0, 0), cB, voB); PG8_STAGE(PG8_SB(0, 1), cB + hstepB, voB); PG8_STAGE(PG8_SA(0, 0), cA, voA[0]); PG8_STAGE(PG8_SA(0, 1), cA, voA[1]);
    if (wr == 1) PG8_BAR;
    PG8_WAIT_V(2); PG8_BAR;
    PG8_STAGE(PG8_SB(1, 0), cB + kstep, voB); PG8_STAGE(PG8_SA(1, 0), cA + kstep, voA[0]); PG8_STAGE(PG8_SB(1, 1), cB + hstepB + kstep, voB);
    PG8_WAIT_V(6); PG8_BAR;
    for (;;) {
        const bool has_next = S.next(ui + 1, nxt);
        const char* nA = has_next ? P.a_base(nxt) : cA; const char* nB = has_next ? P.b_base(nxt) : cB;
        for (int t = 0; t < nt; t += 2) {
            const bool last = (t == nt - 2);
            const char* a1 = cA + (size_t)(t + 1) * kstep;
            const char* a2 = last ? nA : cA + (size_t)(t + 2) * kstep; const char* b2 = last ? nB : cB + (size_t)(t + 2) * kstep;
            const char* a3 = a2 + kstep; const char* b3 = b2 + kstep;
            PG8_LDB(B0, 0, 0); PG8_LDB(B1, 0, 1); PG8_SCHED; PG8_LDA(At, 0, 0); PG8_STAGE(PG8_SA(1, 1), a1, voA[1]);
            PG8_WAIT_V(8); PG8_WAIT_L(0); PG8_BAR; PG8_MMA(0, 0, At, B0); PG8_MMA(0, 1, At, B1); PG8_BAR; PG8_SCHED;
            if (GATHER) { if (last && has_next) { PG8_SETVOA(ui + 1); } }
            PG8_LDA(At, 0, 1); PG8_STAGE(PG8_SB(0, 0), b2, voB); PG8_STAGE(PG8_SB(0, 1), b2 + hstepB, voB); PG8_STAGE(PG8_SA(0, 0), a2, voA[0]);
            PG8_WAIT_V(8); PG8_WAIT_L(0); PG8_BAR; PG8_MMA(1, 0, At, B0); PG8_MMA(1, 1, At, B1); PG8_BAR; PG8_SCHED;
            PG8_LDB(B0, 1, 0); PG8_LDB(B1, 1, 1); PG8_SCHED; PG8_LDA(At, 1, 0); PG8_STAGE(PG8_SA(0, 1), a2, voA[1]);
            PG8_WAIT_V(8); PG8_WAIT_L(0); PG8_BAR; PG8_MMA(0, 0, At, B0); PG8_MMA(0, 1, At, B1); PG8_BAR; PG8_SCHED;
            PG8_LDA(At, 1, 1); PG8_STAGE(PG8_SB(1, 0), b3, voB); PG8_STAGE(PG8_SB(1, 1), b3 + hstepB, voB); PG8_STAGE(PG8_SA(1, 0), a3, voA[0]);
            PG8_WAIT_V(8); PG8_WAIT_L(0); PG8_BAR; PG8_MMA(1, 0, At, B0); PG8_MMA(1, 1, At, B1); PG8_BAR; PG8_SCHED;
        }
        if constexpr (ALIGN_EPI) { if (wr == 0) PG8_BAR; }
        E(acc, cur, ui, wr, wc, fr, fq);
        if (!has_next) break;
#pragma unroll
        for (int a = 0; a < 2; ++a)
#pragma unroll
            for (int b = 0; b < 2; ++b)
#pragma unroll
                for (int m = 0; m < 4; ++m)
#pragma unroll
                    for (int n = 0; n < 2; ++n) acc[a][b][m][n] = (f32x4){0.f, 0.f, 0.f, 0.f};
        cur = nxt; cA = nA; cB = nB; ++ui;
        if constexpr (ALIGN_EPI) { if (wr == 1) PG8_BAR; }
    }
    PG8_WAIT_V(0);
    if constexpr (!ALIGN_EPI) { if (wr == 0) PG8_BAR; }
    PG8_BAR;
#undef PG8_SETVOA
#undef PG8_SA
#undef PG8_SB
#undef PG8_STAGE
#undef PG8_LDA
#undef PG8_LDB
#undef PG8_MMA
#undef PG8_WAIT_V
#undef PG8_WAIT_L
#undef PG8_BAR
#undef PG8_SCHED
}

struct EpiG1 {
    static constexpr bool PERM = true;
    bf16_t* U; const PG8_LAS float* rope;
    __device__ __forceinline__ void operator()(const f32x4 (&acc)[2][2][4][2], const Unit& u, int ui, int wr, int wc, int fr, int fq) const {
        const int row0 = u.pm * BM + wr * 64 + fr, colt = u.pn * BM, col0 = colt + wc * 32 + 8 * fq;
        const bool latent = u.pm < 32;
        const int axis = wc & 1; const float sgn = fq < 2 ? -1.f : 1.f;
#pragma unroll
        for (int ai = 0; ai < 2; ++ai)
#pragma unroll
            for (int m = 0; m < 4; ++m) {
                const int row = row0 + ai * HALF + m * 16;
                bf16_t* rowp = U + (size_t)row * IN_DIM + col0;
                const int t = row & (SEQ - 1); const int pos = axis ? (t & 63) : (t >> 6);
                const PG8_LAS f32x4* tp = (const PG8_LAS f32x4*)(rope + (pos * 16 + 8 * (fq & 1)) * 2);
#pragma unroll
                for (int bj = 0; bj < 2; ++bj) {
                    const int cb = colt + bj * HALF;
                    f32x4 v0 = acc[ai][bj][m][0], v1 = acc[ai][bj][m][1];
                    if (cb < 640) {
                        if (latent) {
                            const f32x4 t0 = tp[0], t1 = tp[1], t2 = tp[2], t3 = tp[3];
                            f32x4 p0, p1;
                            p0[0] = __shfl_xor(v0[0], 32); p0[1] = __shfl_xor(v0[1], 32); p0[2] = __shfl_xor(v0[2], 32); p0[3] = __shfl_xor(v0[3], 32);
                            p1[0] = __shfl_xor(v1[0], 32); p1[1] = __shfl_xor(v1[1], 32); p1[2] = __shfl_xor(v1[2], 32); p1[3] = __shfl_xor(v1[3], 32);
                            v0[0] = v0[0] * t0[0] + sgn * p0[0] * t0[1]; v0[1] = v0[1] * t0[2] + sgn * p0[1] * t0[3];
                            v0[2] = v0[2] * t1[0] + sgn * p0[2] * t1[1]; v0[3] = v0[3] * t1[2] + sgn * p0[3] * t1[3];
                            v1[0] = v1[0] * t2[0] + sgn * p1[0] * t2[1]; v1[1] = v1[1] * t2[2] + sgn * p1[1] * t2[3];
                            v1[2] = v1[2] * t3[0] + sgn * p1[2] * t3[1]; v1[3] = v1[3] * t3[2] + sgn * p1[3] * t3[3];
                        }
                        if (cb < 512) { float qs = QSCALE; asm volatile("" : "+v"(qs)); v0 = v0 * qs; v1 = v1 * qs; }
                    }
                    u32x4 w; w.x = cvt_pk_bf16(v0[0], v0[1]); w.y = cvt_pk_bf16(v0[2], v0[3]); w.z = cvt_pk_bf16(v1[0], v1[1]); w.w = cvt_pk_bf16(v1[2], v1[3]);
                    *(u32x4*)(rowp + bj * HALF) = w;
                }
            }
    }
};
struct EpiG2 {
    static constexpr bool PERM = false;
    float* X; const float* base_lat; const float* base_ctx; const float* modv_l;
    __device__ __forceinline__ void operator()(const f32x4 (&acc)[2][2][4][2], const Unit& u, int ui, int wr, int wc, int fr, int fq) const {
        const int s = u.pm < 16 ? 0 : (u.pm < 32 ? 1 : 2);
        const float* ga = modv_l + (size_t)s * (NMOD * D) + 2 * D;
        const int col0 = u.pn * BM + wc * 32 + 4 * fq;
        f32x4 gv[2][2];
#pragma unroll
        for (int bj = 0; bj < 2; ++bj)
#pragma unroll
            for (int n = 0; n < 2; ++n) gv[bj][n] = *(const f32x4*)(ga + col0 + bj * HALF + n * 16);
#pragma unroll
        for (int ai = 0; ai < 2; ++ai) {
            f32x4 bv[4][2][2];
#pragma unroll
            for (int m = 0; m < 4; ++m) {
                const int row = u.pm * BM + ai * HALF + wr * 64 + m * 16 + fr;
                const float* bp = (u.pm < 32 ? base_lat + (size_t)row * D : base_ctx + (size_t)(row - MLAT) * D) + col0;
#pragma unroll
                for (int bj = 0; bj < 2; ++bj)
#pragma unroll
                    for (int n = 0; n < 2; ++n) bv[m][bj][n] = *(const f32x4*)(bp + bj * HALF + n * 16);
            }
            asm volatile("" ::: "memory");
#pragma unroll
            for (int m = 0; m < 4; ++m) {
                const int row = u.pm * BM + ai * HALF + wr * 64 + m * 16 + fr;
                float* xp = X + (size_t)row * D + col0;
#pragma unroll
                for (int bj = 0; bj < 2; ++bj)
#pragma unroll
                    for (int n = 0; n < 2; ++n) *(f32x4*)(xp + bj * HALF + n * 16) = bv[m][bj][n] + gv[bj][n] * acc[ai][bj][m][n];
            }
            asm volatile("" ::: "memory");
        }
    }
};
struct EpiMoeUp {
    static constexpr bool PERM = true;
    bf16_t* Hid; const float* tok_w; const PG8_LAS unsigned* rows_lds;
    __device__ __forceinline__ void operator()(const f32x4 (&acc)[2][2][4][2], const Unit& u, int ui, int wr, int wc, int fr, int fq) const {
        const int col0 = u.pn * HALF + wc * 32 + 8 * fq;
        float wv[2][4];
#pragma unroll
        for (int ai = 0; ai < 2; ++ai)
#pragma unroll
            for (int m = 0; m < 4; ++m) { const unsigned ent = rows_lds[ui * 256 + ai * HALF + wr * 64 + m * 16 + fr]; wv[ai][m] = (ent == 0xFFFFFFFFu) ? 0.f : tok_w[ent]; }
        asm volatile("" ::: "memory");
#pragma unroll
        for (int ai = 0; ai < 2; ++ai)
#pragma unroll
            for (int m = 0; m < 4; ++m) {
                const int r = ai * HALF + wr * 64 + m * 16 + fr;
                const float w = wv[ai][m];
                const f32x4 g0 = acc[ai][0][m][0], g1 = acc[ai][0][m][1], u0 = acc[ai][1][m][0], u1 = acc[ai][1][m][1];
                float h[8];
#pragma unroll
                for (int j = 0; j < 4; ++j) { h[j] = silu_f(g0[j]) * u0[j] * w; h[4 + j] = silu_f(g1[j]) * u1[j] * w; }
                u32x4 o; o.x = cvt_pk_bf16(h[0], h[1]); o.y = cvt_pk_bf16(h[2], h[3]); o.z = cvt_pk_bf16(h[4], h[5]); o.w = cvt_pk_bf16(h[6], h[7]);
                *(u32x4*)(Hid + (size_t)(u.pm * BM + r) * DEXP + col0) = o;
            }
    }
};
struct EpiMoeDown {
    static constexpr bool PERM = true;
    bf16_t* Y2; const PG8_LAS unsigned* rows_lds;
    __device__ __forceinline__ void operator()(const f32x4 (&acc)[2][2][4][2], const Unit& u, int ui, int wr, int wc, int fr, int fq) const {
        const int col0 = u.pn * BM + wc * 32 + 8 * fq;
#pragma unroll
        for (int ai = 0; ai < 2; ++ai)
#pragma unroll
            for (int m = 0; m < 4; ++m) {
                const int r = ai * HALF + wr * 64 + m * 16 + fr;
                const unsigned ent = rows_lds[ui * 256 + r];
                if (ent != 0xFFFFFFFFu) {
                    bf16_t* yp = Y2 + (size_t)ent * D + col0;
#pragma unroll
                    for (int bj = 0; bj < 2; ++bj) { const f32x4 v0 = acc[ai][bj][m][0], v1 = acc[ai][bj][m][1];
                        u32x4 o; o.x = cvt_pk_bf16(v0[0], v0[1]); o.y = cvt_pk_bf16(v0[2], v0[3]); o.z = cvt_pk_bf16(v1[0], v1[1]); o.w = cvt_pk_bf16(v1[2], v1[3]);
                        *(u32x4*)(yp + bj * HALF) = o; }
                }
            }
    }
};
struct EpiDftA {
    static constexpr bool PERM = false;
    bf16_t* PQt; bf16_t* PQtc;
    __device__ __forceinline__ void operator()(const f32x4 (&acc)[2][2][4][2], const Unit& u, int ui, int wr, int wc, int fr, int fq) const {
        const int g = u.grp;
#pragma unroll
        for (int ai = 0; ai < 2; ++ai)
#pragma unroll
            for (int m = 0; m < 4; ++m) {
                const int cq = wr * 64 + m * 16 + fr;
                bf16_t* dst;
                if (u.pn < 32) { const int b = u.pn >> 4; dst = PQt + ((size_t)(b * 512 + g * 128 + cq) * (2 * SEQ) + (size_t)ai * SEQ + (size_t)(u.pn & 15) * BM); }
                else { const int b = u.pn - 32; dst = PQtc + ((size_t)(b * 512 + g * 128 + cq) * (2 * CTXL) + (size_t)ai * CTXL); }
#pragma unroll
                for (int bj = 0; bj < 2; ++bj)
#pragma unroll
                    for (int n = 0; n < 2; ++n) { const f32x4 v = acc[ai][bj][m][n]; u32x2 o; o.x = cvt_pk_bf16(v[0], v[1]); o.y = cvt_pk_bf16(v[2], v[3]);
                        *(u32x2*)(dst + bj * HALF + wc * 32 + n * 16 + 4 * fq) = o; }
            }
    }
};
struct EpiDftB {
    static constexpr bool PERM = false;
    float* PART; int row_base; int pad;
    long long seq_rows;
    __device__ __forceinline__ void operator()(const f32x4 (&acc)[2][2][4][2], const Unit& u, int ui, int wr, int wc, int fr, int fq) const {
        const int col0 = u.pn * BM + wc * 32 + 4 * fq;
#pragma unroll
        for (int ai = 0; ai < 2; ++ai)
#pragma unroll
            for (int m = 0; m < 4; ++m) {
                const int row = row_base + u.grp * (int)seq_rows + u.pm * BM + ai * HALF + wr * 64 + m * 16 + fr;
                float* pp = PART + ((size_t)u.aux * MROWS + row) * 512 + col0;
#pragma unroll
                for (int bj = 0; bj < 2; ++bj)
#pragma unroll
                    for (int n = 0; n < 2; ++n) *(f32x4*)(pp + bj * HALF + n * 16) = acc[ai][bj][m][n];
            }
    }
};
}


namespace att {
typedef short bf16x8 __attribute__((ext_vector_type(8)));
typedef short s16x4 __attribute__((ext_vector_type(4)));
typedef float f32x16 __attribute__((ext_vector_type(16)));
typedef unsigned u32x4 __attribute__((ext_vector_type(4)));
typedef unsigned u32x2 __attribute__((ext_vector_type(2)));
typedef short v4i16_t __attribute__((ext_vector_type(4)));
typedef __attribute__((address_space(3))) const unsigned char* lds_cptr;
__device__ __forceinline__ int crow(int r, int hi) { return (r & 3) + 8 * (r >> 2) + 4 * hi; }
__device__ __forceinline__ s16x4 vtr(lds_cptr p) { return __builtin_bit_cast(s16x4, __builtin_amdgcn_ds_read_tr16_b64_v4i16((__attribute__((address_space(3))) v4i16_t*)p)); }
__device__ __forceinline__ unsigned cvtpk(float lo, float hi) { unsigned r; asm volatile("v_cvt_pk_bf16_f32 %0, %1, %2" : "=v"(r) : "v"(lo), "v"(hi)); return r; }

__device__ __forceinline__ void attn_unit(__attribute__((address_space(3))) unsigned char* lds, const bf16_t* __restrict__ Ub, bf16_t* __restrict__ MIXb, const float* __restrict__ sink, int unit, int tid_in) {
    int tid = tid_in; asm volatile("" : "+v"(tid));
    const int lane = tid & 63, r32 = lane & 31, hi = lane >> 5; const int wid = __builtin_amdgcn_readfirstlane(tid >> 6);
    const bool latent = unit < 256;
    int b, kvh, p0;
    if (latent) { b = unit >> 7; kvh = (unit >> 6) & 1; p0 = (unit & 63) * 64; } else { const int u2 = unit - 256; b = u2 >> 3; kvh = (u2 >> 2) & 1; p0 = (u2 & 3) * 64; }
    const int g = wid >> 1, ph = wid & 1, head = kvh * 4 + g;
    const int qrow = (latent ? b * SEQ + p0 : MLAT + b * CTXL + p0) + 32 * ph + r32;
    bf16x8 qr[4];
#pragma unroll
    for (int d0 = 0; d0 < 4; ++d0) qr[d0] = *(const bf16x8*)(Ub + (size_t)qrow * IN_DIM + UQ + head * 64 + 16 * d0 + 8 * hi);
    const int jlo = latent ? (p0 >= 128 ? 0 : (p0 == 64 ? 1 : 2)) : 0;
    const int jhi = latent ? min(4, (4160 - p0) >> 6) : -1;
    const int nloc = latent ? (jhi - jlo + 1) : 0, ntl = nloc + 4;
    const int kkey = lane, kc = wid;
    const int vkey = 16 * (wid & 3) + (lane >> 2), vd = 32 * (wid >> 2) + 8 * (lane & 3);
    const bf16_t* kcol = Ub + UK + kvh * 64 + 8 * kc; const bf16_t* vcol = Ub + UV + kvh * 64 + vd;
#define ATT_KROW0(t) (((t) < nloc) ? (b * SEQ + p0 - 128 + 64 * (jlo + (t))) : (MLAT + b * CTXL + 64 * ((t) - nloc)))
    u32x4 kreg, vreg;
    { const int kr0 = ATT_KROW0(0); kreg = *(const u32x4*)(kcol + (size_t)(kr0 + kkey) * IN_DIM); vreg = *(const u32x4*)(vcol + (size_t)(kr0 + vkey) * IN_DIM); }
    *(__attribute__((address_space(3))) u32x4*)(lds + tid * 16) = kreg; *(__attribute__((address_space(3))) u32x4*)(lds + 16384 + tid * 16) = vreg;
    const float sk2 = sink[head] * LOG2E;
    float m = sk2, l = (hi == 0) ? 1.f : 0.f;
    f32x16 o[2]; o[0] = f32x16{}; o[1] = f32x16{};
    __syncthreads();
    for (int t = 0; t < ntl; ++t) {
        const int slot = (t & 1) * 8192;
        const bool more = (t + 1 < ntl);
        if (more) { const int kr0 = ATT_KROW0(t + 1); kreg = *(const u32x4*)(kcol + (size_t)(kr0 + kkey) * IN_DIM); vreg = *(const u32x4*)(vcol + (size_t)(kr0 + vkey) * IN_DIM); }
        f32x16 s0 = f32x16{}, s1 = f32x16{};
        { const lds_cptr kb = (lds_cptr)lds + slot + hi * 1024 + r32 * 16;
#pragma unroll
          for (int d0 = 0; d0 < 4; ++d0) { const bf16x8 b0 = *(const __attribute__((address_space(3))) bf16x8*)(kb + d0 * 2048); const bf16x8 b1 = *(const __attribute__((address_space(3))) bf16x8*)(kb + d0 * 2048 + 512);
              s0 = __builtin_amdgcn_mfma_f32_32x32x16_bf16(b0, qr[d0], s0, 0, 0, 0); s1 = __builtin_amdgcn_mfma_f32_32x32x16_bf16(b1, qr[d0], s1, 0, 0, 0); } }
        if (t < nloc) {
            const int rel0 = 64 * (jlo + t) - 128 - 32 * ph - r32 + 4 * hi;
#pragma unroll
            for (int r = 0; r < 16; ++r) { const int rel = rel0 + (r & 3) + 8 * (r >> 2); if (rel < -128 || rel > 128) s0[r] = -1e30f; if (rel + 32 < -128 || rel + 32 > 128) s1[r] = -1e30f; }
        }
        float tm = fmaxf(s0[0], s1[0]);
#pragma unroll
        for (int r = 1; r < 16; ++r) tm = fmaxf(tm, fmaxf(s0[r], s1[r]));
        tm = fmaxf(tm, __shfl_xor(tm, 32));
        const float mn = fmaxf(m, tm), alpha = exp2f(m - mn); m = mn;
        float ps = 0.f;
#pragma unroll
        for (int r = 0; r < 16; ++r) { s0[r] = exp2f(s0[r] - mn); s1[r] = exp2f(s1[r] - mn); ps += s0[r] + s1[r]; }
        l = l * alpha + ps;
#pragma unroll
        for (int r = 0; r < 16; ++r) { o[0][r] *= alpha; o[1][r] *= alpha; }
        u32x4 pw[4];
#pragma unroll
        for (int q = 0; q < 4; ++q) { pw[0][q] = cvtpk(s0[2 * q], s0[2 * q + 1]); pw[1][q] = cvtpk(s0[8 + 2 * q], s0[8 + 2 * q + 1]); pw[2][q] = cvtpk(s1[2 * q], s1[2 * q + 1]); pw[3][q] = cvtpk(s1[8 + 2 * q], s1[8 + 2 * q + 1]); }
        { const lds_cptr vp = (lds_cptr)lds + 16384 + slot + ((lane >> 4) & 1) * 32 + (lane & 3) * 8 + (4 * hi + ((lane & 15) >> 2)) * 64;
#pragma unroll
          for (int d0 = 0; d0 < 2; ++d0)
#pragma unroll
            for (int ks = 0; ks < 4; ++ks) { const s16x4 lo = vtr(vp + d0 * 4096 + ks * 1024), hh = vtr(vp + d0 * 4096 + ks * 1024 + 512);
                const bf16x8 vf = (bf16x8){lo[0], lo[1], lo[2], lo[3], hh[0], hh[1], hh[2], hh[3]};
                o[d0] = __builtin_amdgcn_mfma_f32_32x32x16_bf16(vf, __builtin_bit_cast(bf16x8, pw[ks]), o[d0], 0, 0, 0); } }
        if (more) { const int ns = ((t + 1) & 1) * 8192; *(__attribute__((address_space(3))) u32x4*)(lds + ns + tid * 16) = kreg; *(__attribute__((address_space(3))) u32x4*)(lds + 16384 + ns + tid * 16) = vreg; }
        __syncthreads();
    }
#undef ATT_KROW0
    l += __shfl_xor(l, 32);
    const float inv = 1.f / l;
    bf16_t* op = MIXb + (size_t)qrow * D + head * 64 + 4 * hi;
#pragma unroll
    for (int d0 = 0; d0 < 2; ++d0)
#pragma unroll
        for (int g4 = 0; g4 < 4; ++g4) { u32x2 w; w.x = cvtpk(o[d0][4 * g4] * inv, o[d0][4 * g4 + 1] * inv); w.y = cvtpk(o[d0][4 * g4 + 2] * inv, o[d0][4 * g4 + 3] * inv);
            *(u32x2*)(op + 32 * d0 + 8 * g4) = w; }
}
}

constexpr int CONV_W_OFF = 65536;
using pg8::f32x4;
__device__ __forceinline__ void unpack8(const pg8::u32x4 p, float (&f)[8]) {
#pragma unroll
    for (int q = 0; q < 4; ++q) { f[2 * q] = __uint_as_float(p[q] << 16); f[2 * q + 1] = __uint_as_float(p[q] & 0xffff0000u); }
}
__device__ __forceinline__ void conv_fill_w(__attribute__((address_space(3))) unsigned char* lds, const float* __restrict__ cw, int tid) {
    __attribute__((address_space(3))) f32x4* wl = (__attribute__((address_space(3))) f32x4*)(lds + CONV_W_OFF);
    for (int e = tid; e < 31 * 128; e += 512) wl[e] = *(const f32x4*)(cw + (size_t)e * 4);
}
__device__ __forceinline__ void conv_tile(__attribute__((address_space(3))) unsigned char* lds, const bf16_t* __restrict__ Ub, bf16_t* __restrict__ MIXb, const float* __restrict__ sw,
                                          const float* __restrict__ cb, const float* __restrict__ ng, const float* __restrict__ nb, int tile, int tid_in) {
    typedef pg8::u32x4 u32x4;
    int tid = tid_in; asm volatile("" : "+v"(tid));
    const int lane = tid & 63, w = tid >> 6, c8 = 8 * lane;
    int base, t0, len;
    if (tile < 256) { base = (tile >> 7) * SEQ; t0 = (tile & 127) * 32; len = SEQ; } else { const int u2 = tile - 256; base = MLAT + (u2 >> 3) * CTXL; t0 = (u2 & 7) * 32; len = CTXL; }
#pragma unroll 2
    for (int q = 0; q < 8; ++q) {
        const int it = tid + 512 * q;
        if (it < 62 * 64) {
            const int tok = it >> 6, cg = (it & 63) * 8; const int tt = t0 - 15 + tok;
            u32x4 o = (u32x4){0u, 0u, 0u, 0u};
            if (tt >= 0 && tt < len) {
                const bf16_t* u = Ub + (size_t)(base + tt) * IN_DIM;
                const u32x4 a = *(const u32x4*)(u + UDA + cg), g = *(const u32x4*)(u + UDG + cg);
                float fa[8], fg[8]; unpack8(a, fa); unpack8(g, fg);
#pragma unroll
                for (int e = 0; e < 4; ++e) o[e] = pg8::cvt_pk_bf16(fa[2 * e] * sigmoid_f(fg[2 * e]), fa[2 * e + 1] * sigmoid_f(fg[2 * e + 1]));
            }
            *(__attribute__((address_space(3))) u32x4*)(lds + (size_t)(tok * 512 + cg) * 2) = o;
        }
    }
    asm volatile("" ::: "memory"); __builtin_amdgcn_sched_barrier(0);
    {
        float v[6][8];
#pragma unroll
        for (int k = 0; k < 6; ++k) { const int tt = t0 + 4 * w - 1 + k;
            if (tt >= 0 && tt < len) { const bf16_t* u = Ub + (size_t)(base + tt) * IN_DIM; float a[8], b[8]; unpack8(*(const u32x4*)(u + USC + c8), a); unpack8(*(const u32x4*)(u + USV + c8), b);
#pragma unroll
                for (int e = 0; e < 8; ++e) v[k][e] = a[e] * b[e]; }
            else {
#pragma unroll
                for (int e = 0; e < 8; ++e) v[k][e] = 0.f; } }
        float w0[8], w1[8], w2[8];
#pragma unroll
        for (int h2 = 0; h2 < 2; ++h2) { const f32x4 a = *(const f32x4*)(sw + c8 + 4 * h2), b = *(const f32x4*)(sw + 512 + c8 + 4 * h2), cc = *(const f32x4*)(sw + 1024 + c8 + 4 * h2);
#pragma unroll
            for (int e = 0; e < 4; ++e) { w0[4 * h2 + e] = a[e]; w1[4 * h2 + e] = b[e]; w2[4 * h2 + e] = cc[e]; } }
#pragma unroll
        for (int i = 0; i < 4; ++i) { const size_t row = (size_t)(base + t0 + 4 * w + i); float sb[8]; unpack8(*(const u32x4*)(Ub + row * IN_DIM + USB + c8), sb);
            u32x4 o;
#pragma unroll
            for (int e = 0; e < 4; ++e) o[e] = pg8::cvt_pk_bf16(sb[2 * e] * (w0[2 * e] * v[i][2 * e] + w1[2 * e] * v[i + 1][2 * e] + w2[2 * e] * v[i + 2][2 * e]),
                                                          sb[2 * e + 1] * (w0[2 * e + 1] * v[i][2 * e + 1] + w1[2 * e + 1] * v[i + 1][2 * e + 1] + w2[2 * e + 1] * v[i + 2][2 * e + 1]));
            *(u32x4*)(MIXb + row * D + 1024 + c8) = o; }
    }
    asm volatile("" ::: "memory"); __builtin_amdgcn_sched_barrier(0);
    __syncthreads();
    float z[4][8];
    {
        const f32x4 b0 = *(const f32x4*)(cb + c8), b1 = *(const f32x4*)(cb + c8 + 4);
#pragma unroll
        for (int i = 0; i < 4; ++i)
#pragma unroll
            for (int e = 0; e < 4; ++e) { z[i][e] = b0[e]; z[i][4 + e] = b1[e]; }
        float wq[4][8];
        const __attribute__((address_space(3))) f32x4* wl = (const __attribute__((address_space(3))) f32x4*)(lds + CONV_W_OFF);
#pragma unroll 1
        for (int ko = 0; ko < 9; ++ko) {
#pragma unroll
            for (int ki = 0; ki < 4; ++ki) {
                const int k = 4 * ko + ki;
                if (k < 34) {
                    if (k < 31) { const f32x4 a = wl[k * 128 + 2 * lane], b = wl[k * 128 + 2 * lane + 1];
#pragma unroll
                        for (int e = 0; e < 4; ++e) { wq[ki][e] = a[e]; wq[ki][4 + e] = b[e]; } }
                    float g[8]; unpack8(*(const __attribute__((address_space(3))) u32x4*)(lds + (size_t)((4 * w + k) * 512 + c8) * 2), g);
#pragma unroll
                    for (int i = 0; i < 4; ++i) { const int j = k - i; if (j >= 0 && j < 31) {
#pragma unroll
                        for (int e = 0; e < 8; ++e) z[i][e] += wq[(ki - i) & 3][e] * g[e]; } }
                }
            }
        }
    }
    {
        float gg[8], bb[8];
        { const f32x4 a = *(const f32x4*)(ng + c8), b = *(const f32x4*)(ng + c8 + 4), cc = *(const f32x4*)(nb + c8), d = *(const f32x4*)(nb + c8 + 4);
#pragma unroll
          for (int e = 0; e < 4; ++e) { gg[e] = a[e]; gg[4 + e] = b[e]; bb[e] = cc[e]; bb[4 + e] = d[e]; } }
#pragma unroll
        for (int i = 0; i < 4; ++i) {
            float s = 0.f;
#pragma unroll
            for (int e = 0; e < 8; ++e) s += z[i][e];
            const float mu = wave_sum(s) * (1.f / 512.f);
            float s2 = 0.f;
#pragma unroll
            for (int e = 0; e < 8; ++e) { const float d = z[i][e] - mu; s2 += d * d; }
            const float rstd = rsqrtf(wave_sum(s2) * (1.f / 512.f) + 1e-6f);
            u32x4 o;
#pragma unroll
            for (int e = 0; e < 4; ++e) { const float y0 = (z[i][2 * e] - mu) * rstd * gg[2 * e] + bb[2 * e], y1 = (z[i][2 * e + 1] - mu) * rstd * gg[2 * e + 1] + bb[2 * e + 1]; o[e] = pg8::cvt_pk_bf16(silu_f(y0), silu_f(y1)); }
            *(u32x4*)(MIXb + (size_t)(base + t0 + 4 * w + i) * D + 1536 + c8) = o;
        }
    }
    __syncthreads();
}

constexpr int NWAVES = 8;
constexpr int RING_OFF = 0, RING_BYTES = 131072;
constexpr int ROWS_OFF = 131072;
constexpr int ULIST_OFF = ROWS_OFF + 4096;
constexpr int ROPE_OFF = ULIST_OFF + 256;
constexpr int LDSCTL_OFF = ROPE_OFF + 8192, MISC_OFF = LDSCTL_OFF + 320;
constexpr int LDS_BYTES = 147456;
static_assert(MISC_OFF + 256 <= LDS_BYTES, "LDS map");

#define GAS __attribute__((address_space(1)))
#define LAS __attribute__((address_space(3)))
typedef unsigned v4u __attribute__((ext_vector_type(4)));
typedef GAS unsigned gu32;
#define RLX_AGENT __ATOMIC_RELAXED, __HIP_MEMORY_SCOPE_AGENT
#define LDS_WAIT() asm volatile("s_waitcnt lgkmcnt(0)" ::: "memory")
#define VM_WAIT() asm volatile("s_waitcnt vmcnt(0)" ::: "memory")
__device__ __forceinline__ unsigned pk2(float lo, float hi) { return (unsigned)f2bf(lo) | ((unsigned)f2bf(hi) << 16); }

#define XB_TMO      128
#define XB_XCNT(j)  (256  + 64 * (j))
#define XB_XSUB(j)  (1280 + 64 * (j))
#define XB_XGEN(j)  (2304 + 64 * (j))
#define XB_TOP      3328
#define XB_TOPGEN   3392
#define XCD_BAR_WORDS 3456
#define XB_SPIN_CAP (1u << 20)
__device__ __forceinline__ unsigned xb_ld(unsigned* p)              { return __hip_atomic_load(p, __ATOMIC_RELAXED, __HIP_MEMORY_SCOPE_AGENT); }
__device__ __forceinline__ unsigned xb_add(unsigned* p, unsigned v) { return __hip_atomic_fetch_add(p, v, __ATOMIC_RELAXED, __HIP_MEMORY_SCOPE_AGENT); }
__device__ __forceinline__ unsigned xb_xcc_id() { return (unsigned)__builtin_amdgcn_s_getreg((3 << 11) | 20) & 0xFu; }
#define XB_SPIN(cond, bar) do { unsigned _sp = 0; while (cond) { __builtin_amdgcn_s_sleep(1); \
    if ((++_sp & 255u) == 0u) { if (xb_ld(&(bar)[XB_TMO])) break; if (_sp > XB_SPIN_CAP) { atomicAdd(&(bar)[XB_TMO], 1u); break; } } } } while (0)
struct XcdBarrier { unsigned* bar; unsigned x; volatile LAS unsigned* st; };
__device__ __forceinline__ XcdBarrier xcd_barrier_post(unsigned* bar, volatile LAS unsigned* st) {
    XcdBarrier b; b.bar = bar; b.x = xb_xcc_id(); b.st = st;
    if (threadIdx.x == 0) (void)xb_add(&bar[XB_XCNT(b.x)], 1u);
    return b;
}
__device__ __forceinline__ void xcd_barrier_complete(unsigned* bar, unsigned x, unsigned& nloc, unsigned& nx) {
    const unsigned G = gridDim.x * gridDim.y * gridDim.z;
    unsigned sum, cnt, mine, sp = 0u;
    for (;;) {
        sum = 0u; cnt = 0u; mine = 0u;
#pragma unroll
        for (unsigned j = 0; j < 16; ++j) { const unsigned c = xb_ld(&bar[XB_XCNT(j)]); sum += c; cnt += (c > 0u) ? 1u : 0u; mine = (j == x) ? c : mine; }
        if (sum == G) break;
        __builtin_amdgcn_s_sleep(1);
        if ((++sp & 255u) == 0u) { if (xb_ld(&bar[XB_TMO])) break; if (sp > XB_SPIN_CAP) { atomicAdd(&bar[XB_TMO], 1u); break; } }
    }
    nloc = mine > 0u ? mine : 1u; nx = cnt > 0u ? cnt : 1u;
}
__device__ __forceinline__ void xcd_barrier(const XcdBarrier& b) {
    asm volatile("s_waitcnt vmcnt(0)" ::: "memory");
    __syncthreads();
    if (threadIdx.x == 0) {
        unsigned* bar = b.bar;
        __builtin_amdgcn_s_waitcnt(0);
        unsigned nloc = b.st[0], nx = b.st[1];
        if (nloc == 0u) { xcd_barrier_complete(bar, b.x, nloc, nx); b.st[0] = nloc; b.st[1] = nx; }
        const unsigned old = xb_add(&bar[XB_XSUB(b.x)], 1u);
        const unsigned gen = old / nloc;
        if (old + 1u == (gen + 1u) * nloc) {
            __builtin_amdgcn_fence(__ATOMIC_RELEASE, "agent");
            asm volatile("s_waitcnt vmcnt(0)" ::: "memory");
            const unsigned og = xb_add(&bar[XB_TOP], 1u);
            const unsigned tg = og / nx;
            if (og + 1u == (tg + 1u) * nx) xb_add(&bar[XB_TOPGEN], 1u);
            else XB_SPIN(xb_ld(&bar[XB_TOPGEN]) == tg, bar);
            __builtin_amdgcn_fence(__ATOMIC_ACQUIRE, "agent");
            xb_add(&bar[XB_XGEN(b.x)], 1u);
            asm volatile("s_waitcnt vmcnt(0)" ::: "memory");
        } else {
            XB_SPIN(xb_ld(&bar[XB_XGEN(b.x)]) == gen, bar);
            __builtin_amdgcn_fence(__ATOMIC_ACQUIRE, "agent");
            asm volatile("s_waitcnt vmcnt(0)" ::: "memory");
        }
    }
    __syncthreads();
}

constexpr size_t WM_CTL = 0;
constexpr int CW_BAR = 4096;
constexpr size_t WM_WIN = 352 * MiB;
constexpr size_t WM_WOUT = 384 * MiB;
constexpr size_t WM_WGU = 400 * MiB;
constexpr size_t WM_WDN = 528 * MiB;
constexpr size_t WM_CS = 592 * MiB;
constexpr size_t WM_CSC = 656 * MiB;
constexpr size_t WM_WC = 657 * MiB;
constexpr size_t WM_PQT = 658 * MiB;
constexpr size_t WM_PQTC = 674 * MiB;
constexpr size_t WM_PART = 676 * MiB;
constexpr size_t WM_HIDB = 744 * MiB;
constexpr size_t WM_END = 768 * MiB;

struct MArgs { const float* in[24]; float* out; unsigned char* ws; int ph_lo, ph_hi, layer, use_bar; };

struct Frame {
    LAS unsigned char* lds; volatile LAS unsigned* MISC; unsigned* ctl;
    int tid, lane, wave, vcu, G;
};

__device__ __forceinline__ void p0_transpose_item(const float* W, int K, int N, bf16_t* WT, int n_row_base, LAS float* scr, int item, int lane) {
    const int nblk = N / 32, kb = item / nblk, nb = item % nblk, k0 = 64 * kb, n0 = 32 * nb;
    float tv[32];
    { const float* wp = W + (size_t)(k0 + (lane >> 5)) * N + n0 + (lane & 31);
#pragma unroll
      for (int i = 0; i < 32; ++i) tv[i] = __builtin_nontemporal_load(wp + (size_t)(2 * i) * N); }
#pragma unroll
    for (int i = 0; i < 32; ++i) scr[(2 * i + (lane >> 5)) * 33 + (lane & 31)] = tv[i];
    LDS_WAIT(); asm volatile("" ::: "memory");
    const int c = lane & 7;
#pragma unroll
    for (int j = 0; j < 4; ++j) { const int n = (lane >> 3) + 8 * j; const LAS float* s = scr + (8 * c) * 33 + n;
        v4u o; o.x = pk2(s[0 * 33], s[1 * 33]); o.y = pk2(s[2 * 33], s[3 * 33]); o.z = pk2(s[4 * 33], s[5 * 33]); o.w = pk2(s[6 * 33], s[7 * 33]);
        *(v4u*)(WT + (size_t)(n_row_base + n) * K + k0 + 8 * c) = o; }
    LDS_WAIT(); asm volatile("" ::: "memory");
}

__device__ __forceinline__ unsigned char* opq(unsigned char* p) { unsigned lo = (unsigned)(uintptr_t)p, hi = (unsigned)((uintptr_t)p >> 32); asm volatile("" : "+v"(lo), "+v"(hi)); lo = __builtin_amdgcn_readfirstlane(lo); hi = __builtin_amdgcn_readfirstlane(hi); return (unsigned char*)(((uintptr_t)hi << 32) | (uintptr_t)lo); }
__device__ __forceinline__ const char* opqc(const char* p) { return (const char*)opq((unsigned char*)p); }
__device__ __forceinline__ int opqv(int v) { asm volatile("" : "+v"(v)); return v; }
#define PHASE_PROLOG unsigned char* ws = opq(args.ws); const char* ka = opqc((const char*)__builtin_amdgcn_kernarg_segment_ptr()); const int lane = opqv(F.lane), tid = opqv(F.tid); (void)ws; (void)ka; (void)lane; (void)tid
#define INP(k) (*(const float* const*)(ka + (k) * 8))

struct N2Ctx { const float* X; bf16_t* H; const float* g2; const float* modl; const float* wg; const float* we; const float* bg; const float* be; int* tok_e; float* tok_w; unsigned* cnt; unsigned* list; };
template <int NR>
__device__ __forceinline__ void n2_group(const N2Ctx& C, LAS float* wt, const int (&rows)[NR], int mrows, int lane, int tid) {
    const int l4 = lane * 4;
    f32x4 h[NR][8]; float lg[NR][20];
#pragma unroll
    for (int i = 0; i < NR; ++i) {
        const int row = rows[i]; const bool ok = row < mrows; const int rr = ok ? row : 0; const int s = modsel(rr);
        f32x4 v[8]; float ss = 0.f;
#pragma unroll
        for (int j = 0; j < 8; ++j) { v[j] = *(const f32x4*)(C.X + (size_t)rr * D + l4 + 256 * j); ss += v[j][0] * v[j][0] + v[j][1] * v[j][1] + v[j][2] * v[j][2] + v[j][3] * v[j][3]; }
        ss = wave_sum(ss);
        const float rstd = rsqrtf(ss * (1.f / D) + 1e-6f);
        const float* sh = C.modl + (size_t)s * (NMOD * D) + 3 * D; const float* sc = sh + D;
#pragma unroll
        for (int j = 0; j < 8; ++j) { const int col = l4 + 256 * j; const f32x4 g = *(const f32x4*)(C.g2 + col), a = *(const f32x4*)(sc + col), b = *(const f32x4*)(sh + col);
            h[i][j] = v[j] * rstd * g * (a + 1.f) + b;
            if (ok) { pg8::u32x2 o; o.x = pk2(h[i][j][0], h[i][j][1]); o.y = pk2(h[i][j][2], h[i][j][3]); *(pg8::u32x2*)(C.H + (size_t)row * D + col) = o; } }
#pragma unroll
        for (int q = 0; q < 20; ++q) lg[i][q] = 0.f;
    }
#pragma unroll
    for (int half = 0; half < 2; ++half) {
        __syncthreads();
#pragma unroll
        for (int cc = 0; cc < 2; ++cc) { const int c = tid + 512 * cc; const int col = 1024 * half + c;
            const f32x4 a = *(const f32x4*)(C.wg + (size_t)col * 4);
            wt[0 * 1024 + c] = a[0]; wt[1 * 1024 + c] = a[1]; wt[2 * 1024 + c] = a[2]; wt[3 * 1024 + c] = a[3];
#pragma unroll
            for (int q = 0; q < 4; ++q) { const f32x4 b = *(const f32x4*)(C.we + (size_t)col * 16 + q * 4);
                wt[(4 + 4 * q) * 1024 + c] = b[0]; wt[(5 + 4 * q) * 1024 + c] = b[1]; wt[(6 + 4 * q) * 1024 + c] = b[2]; wt[(7 + 4 * q) * 1024 + c] = b[3]; } }
        __syncthreads();
#pragma unroll
        for (int jj = 0; jj < 4; ++jj) {
#pragma unroll
            for (int q = 0; q < 20; ++q) { const f32x4 w = *(const LAS f32x4*)(wt + q * 1024 + l4 + 256 * jj);
#pragma unroll
                for (int i = 0; i < NR; ++i) { const f32x4 hv = h[i][4 * half + jj]; lg[i][q] += hv[0] * w[0] + hv[1] * w[1] + hv[2] * w[2] + hv[3] * w[3]; } }
        }
    }
#pragma unroll
    for (int i = 0; i < NR; ++i)
#pragma unroll
        for (int q = 0; q < 20; ++q) lg[i][q] = wave_sum(lg[i][q]);
    if (lane < NR) {
        int row = rows[0];
#pragma unroll
        for (int i = 1; i < NR; ++i) row = (lane == i) ? rows[i] : row;
        if (row < mrows) {
            float gl[4], el[16];
#pragma unroll
            for (int q = 0; q < 20; ++q) { float vq = lg[0][q];
#pragma unroll
                for (int i = 1; i < NR; ++i) vq = (lane == i) ? lg[i][q] : vq;
                if (q < 4) gl[q] = vq + C.bg[q]; else el[q - 4] = vq + C.be[q - 4]; }
            int gs = 0; float gm = gl[0];
#pragma unroll
            for (int q = 1; q < 4; ++q) if (gl[q] > gm) { gm = gl[q]; gs = q; }
            float den = 0.f;
#pragma unroll
            for (int q = 0; q < 4; ++q) den += __expf(gl[q] - gm);
            const float pg = 1.f / den;
            float eg[4];
#pragma unroll
            for (int q = 0; q < 4; ++q) eg[q] = gs == 0 ? el[q] : (gs == 1 ? el[4 + q] : (gs == 2 ? el[8 + q] : el[12 + q]));
            int i0 = 0; float m0 = eg[0];
#pragma unroll
            for (int q = 1; q < 4; ++q) if (eg[q] > m0) { m0 = eg[q]; i0 = q; }
            int i1 = -1; float m1 = -3.0e38f;
#pragma unroll
            for (int q = 0; q < 4; ++q) if (q != i0 && eg[q] > m1) { m1 = eg[q]; i1 = q; }
            const float w0 = 1.f / (1.f + __expf(m1 - m0)), w1 = 1.f - w0;
            const int e0 = gs * 4 + i0, e1 = gs * 4 + i1;
            C.tok_e[row * 2] = e0; C.tok_e[row * 2 + 1] = e1; C.tok_w[row * 2] = w0 * pg; C.tok_w[row * 2 + 1] = w1 * pg;
            const unsigned p0 = atomicAdd(C.cnt + e0, 1u); C.list[(size_t)e0 * (2 * MROWS) + p0] = row * 2;
            const unsigned p1 = atomicAdd(C.cnt + e1, 1u); C.list[(size_t)e1 * (2 * MROWS) + p1] = row * 2 + 1;
        }
    }
}

__global__ void __launch_bounds__(NWAVES * 64, 2) mega_fwd(MArgs args) {
    extern __shared__ __attribute__((aligned(16))) unsigned char lds_raw[];
    Frame F;
    F.lds = (LAS unsigned char*)lds_raw;
    F.MISC = (volatile LAS unsigned*)(F.lds + MISC_OFF);
    F.tid = threadIdx.x; F.lane = F.tid & 63; F.wave = __builtin_amdgcn_readfirstlane(F.tid >> 6);
    F.G = gridDim.x; { const int bx = blockIdx.x; F.vcu = (F.G % 8 == 0) ? (bx % 8) * (F.G / 8) + bx / 8 : bx; }
    F.ctl = (unsigned*)(args.ws + WM_CTL);
    for (int u = F.tid; u < (LDS_BYTES - LDSCTL_OFF) / 4; u += NWAVES * 64) ((LAS unsigned*)(F.lds + LDSCTL_OFF))[u] = 0u;
    __syncthreads();
    XcdBarrier bar; bar.bar = F.ctl + CW_BAR; bar.x = 0; bar.st = nullptr;
    if (args.use_bar) bar = xcd_barrier_post(F.ctl + CW_BAR, F.MISC + 8);
#define GRID_BAR() do { if (args.use_bar) xcd_barrier(bar); } while (0)
    const int lo = args.ph_lo, hi = args.ph_hi;
#ifdef PROBE_DUP
#define PC_OF(pi) ((pi) <= PROBE_DUP ? (pi) : (pi) - 1)
#else
#define PC_OF(pi) (pi)
#endif
    const int gw = F.vcu * NWAVES + F.wave, NGW = F.G * NWAVES;
  for (int pi = lo; pi < hi; ++pi) {
    const int pc = PC_OF(pi);
    const int l = (pc >= 10 && pc < 19) ? 1 : 0;
    const int kk = (pc == 0) ? -1 : (pc == 19 ? -2 : pc - 1 - 9 * l);
    const int mrows = (l == 1) ? MLAT : MROWS;


#define x_in INP(0)
#define c_in INP(1)
#define ctx_in INP(2)
#define c_ctx INP(3)
#define w_mod INP(4)
#define b_mod INP(5)
#define w_in INP(8)
#define w_out INP(9)
#define w_gate INP(20)
#define w_up INP(21)
#define w_down INP(22)
#define modv   ((float*)(ws + WS_MOD))
#define rope   ((float*)(ws + WS_ROPE))
#define tok_w  ((float*)(ws + WS_TOK + 128 * 1024))
#define tok_e  ((int*)(ws + WS_TOK))
#define list   ((unsigned*)(ws + WS_LIST))
#define X      ((float*)(ws + WS_X))
#define H      ((bf16_t*)(ws + WS_H))
#define U      ((bf16_t*)(ws + WS_U))
#define MIX    ((bf16_t*)(ws + WS_MIX))
#define Y2     ((bf16_t*)(ws + WS_Y2))
#define Win_t  ((bf16_t*)(ws + WM_WIN))
#define Wout_t ((bf16_t*)(ws + WM_WOUT))
#define Wgu_t  ((bf16_t*)(ws + WM_WGU))
#define Wdn_t  ((bf16_t*)(ws + WM_WDN))
#define CS     ((bf16_t*)(ws + WM_CS))
#define CSC    ((bf16_t*)(ws + WM_CSC))
#define WC     ((bf16_t*)(ws + WM_WC))
#define PQT    ((bf16_t*)(ws + WM_PQT))
#define PQTC   ((bf16_t*)(ws + WM_PQTC))
#define PART   ((float*)(ws + WM_PART))
#define HIDB   ((bf16_t*)(ws + WM_HIDB))
#define g_norm1 INP(6)
#define g_norm2 INP(7)
#define g_final INP(23)
#define w_rg INP(16)
#define b_rg INP(17)
#define w_re INP(18)
#define b_re INP(19)
    const PG8_LAS unsigned* rows_lds = (const PG8_LAS unsigned*)(F.lds + ROWS_OFF);
    LAS int* ulist = (LAS int*)(F.lds + ULIST_OFF);

    if (pc == 0) {
        PHASE_PROLOG;
        LAS float* ctab = (LAS float*)(F.lds + 67584); LAS float* stab = ctab + 4096;
        for (int i = tid; i < 4096; i += NWAVES * 64) { float s, c; sincospif((float)i * (1.f / 2048.f), &s, &c); ctab[i] = c; stab[i] = s; }
        __syncthreads();
#ifdef PROBE_P0
        for (int rep_ = 0; rep_ < (PROBE_P0 == 1 ? 2 : 1); ++rep_)
#endif
        for (int tp = F.vcu; tp < SEQ; tp += F.G) {
#pragma unroll
            for (int j = 0; j < 2; ++j) { const int k0 = (tid + 512 * j) * 8; const int part = k0 >> 12; const int kk0 = k0 & 4095;
                float v[8];
#pragma unroll
                for (int q = 0; q < 8; ++q) { const float rev = (float)((tp * (kk0 + q)) & 4095) * (1.f / 4096.f);
                    v[q] = part ? -__builtin_amdgcn_sinf(rev) : __builtin_amdgcn_cosf(rev); }
                v4u o; o.x = pk2(v[0], v[1]); o.y = pk2(v[2], v[3]); o.z = pk2(v[4], v[5]); o.w = pk2(v[6], v[7]);
                *(v4u*)(CS + (size_t)tp * (2 * SEQ) + k0) = o; }
        }
        if (F.vcu == 1 % F.G) {
            for (int e = tid; e < 256 * 256; e += NWAVES * 64) { const int r = e >> 8, c = e & 255; const int part = r >> 7, cq = r & 127; float v = 0.f;
                if (c < 128) { const int idx = ((c * cq) & 127) * 32; v = part ? stab[idx] : ctab[idx]; } WC[e] = f2bf(v); }
        }
        if (F.vcu == 2 % F.G) {
            for (int e = tid; e < 256 * 512; e += NWAVES * 64) { const int tp = e >> 9, k = e & 511; const int part = k >> 8; const int idx = ((tp * (k & 255)) & 255) * 16;
                CSC[e] = f2bf(part ? -stab[idx] : ctab[idx]); }
        }
        if (F.vcu == 3 % F.G) {
            for (int e = tid; e < 64 * 16; e += NWAVES * 64) { const int pos = e >> 4, i = e & 15; const float freq = powf(10000.f, -(float)(2 * i) / 32.f); const float ang = (float)pos * freq;
                rope[e * 2] = cosf(ang); rope[e * 2 + 1] = sinf(ang); }
        }
        __syncthreads();
        {
            LAS float* sl = (LAS float*)(F.lds + 67584 + 32768 + 9216);
            for (int e = tid; e < 3 * D; e += NWAVES * 64) { const int sidx = e / D, k = e % D; sl[e] = silu_f(sidx == 0 ? c_in[k] : (sidx == 1 ? c_in[D + k] : c_ctx[k])); }
            __syncthreads();
#ifdef PROBE_P0
            for (int rep_ = 0; rep_ < (PROBE_P0 == 2 ? 2 : 1); ++rep_)
#endif
            for (int it = blockIdx.x; it < 256; it += F.G) {
                const int l = it >> 7, j0 = (it & 127) * 96;
                LAS float* red = (LAS float*)(F.lds + 67584 + 32768);
                float a[3][2] = {{0.f, 0.f}, {0.f, 0.f}, {0.f, 0.f}};
                if (lane < 48) {
                    const float* w = w_mod + ((size_t)l * D + (size_t)F.wave * 256) * (NMOD * D) + j0 + 2 * lane;
#pragma unroll 16
                    for (int k0_ = 0; k0_ < 256; ++k0_) { const int k = (k0_ + 2 * it) & 255; const int kk = F.wave * 256 + k; const float2 wv = *(const float2*)(w + (size_t)k * (NMOD * D));
                        const float s0 = sl[kk], s1 = sl[D + kk], s2 = sl[2 * D + kk];
                        a[0][0] += s0 * wv.x; a[0][1] += s0 * wv.y; a[1][0] += s1 * wv.x; a[1][1] += s1 * wv.y; a[2][0] += s2 * wv.x; a[2][1] += s2 * wv.y; }
#pragma unroll
                    for (int s = 0; s < 3; ++s) { red[(F.wave * 3 + s) * 96 + 2 * lane] = a[s][0]; red[(F.wave * 3 + s) * 96 + 2 * lane + 1] = a[s][1]; }
                }
                __syncthreads();
                if (tid < 288) { const int s = tid / 96, j = tid % 96; float v = b_mod[l * NMOD * D + j0 + j];
#pragma unroll
                    for (int w = 0; w < 8; ++w) v += red[(w * 3 + s) * 96 + j];
                    modv[((size_t)l * 3 + s) * (NMOD * D) + j0 + j] = v; }
                __syncthreads();
            }
        }
        {
            LAS float* scr = (LAS float*)(F.lds + F.wave * 8448);
            const int gw = F.vcu * NWAVES + F.wave, NGW = F.G * NWAVES;
            constexpr int I_IN = (D / 64) * (IN_DIM / 32), I_OUT = (D / 64) * (D / 32), I_GU = (D / 64) * (DEXP / 32), I_DN = (DEXP / 64) * (D / 32);
            constexpr int PER_L = I_IN + I_OUT + NEXP * (2 * I_GU + I_DN);
#ifdef PROBE_P0
            for (int rep_ = 0; rep_ < (PROBE_P0 == 3 ? 2 : 1); ++rep_)
#endif
            for (int it = gw; it < 2 * PER_L; it += NGW) {
                const int l = it / PER_L; int r = it % PER_L;
                if (r < I_IN) { const int nb = r % (IN_DIM / 32); p0_transpose_item(w_in + (size_t)l * D * IN_DIM, D, IN_DIM, Win_t + (size_t)l * IN_DIM * D, nb * 32, scr, r, lane); continue; } r -= I_IN;
                if (r < I_OUT) { const int nb = r % (D / 32); p0_transpose_item(w_out + (size_t)l * D * D, D, D, Wout_t + (size_t)l * D * D, nb * 32, scr, r, lane); continue; } r -= I_OUT;
                const int e = r / (2 * I_GU + I_DN); r %= (2 * I_GU + I_DN);
                const size_t le = (size_t)l * NEXP + e;
                if (r < 2 * I_GU) { const int up = r >= I_GU; if (up) r -= I_GU; const int nb = r % (DEXP / 32); const int n0 = nb * 32;
                    const int rowb = (n0 >> 7) * 256 + (n0 & 127) + up * 128;
                    p0_transpose_item((up ? w_up : w_gate) + le * D * DEXP, D, DEXP, Wgu_t + le * (2 * DEXP) * D, rowb, scr, r, lane); continue; } r -= 2 * I_GU;
                { const int nb = r % (D / 32); p0_transpose_item(w_down + le * DEXP * D, DEXP, D, Wdn_t + le * D * DEXP, nb * 32, scr, r, lane); }
            }
        }
    }


    if (kk == 0) {
        PHASE_PROLOG; const float* modl = modv + (size_t)l * 3 * NMOD * D; (void)modl;
        const float* g1 = g_norm1 + l * D;
        const int l4 = lane * 4;
#define N1_SRC(row) ((l == 0) ? ((row) < MLAT ? x_in + (size_t)(row) * D : ctx_in + (size_t)((row) - MLAT) * D) : X + (size_t)(row) * D)
        f32x4 vn[8]; pg8::u32x2 yn0[8], yn1[8];
        int row = gw;
        { const int r0 = min(row, MROWS - 1); const float* src = N1_SRC(r0);
#pragma unroll
            for (int j = 0; j < 8; ++j) vn[j] = *(const f32x4*)(src + l4 + 256 * j);
#pragma unroll
            for (int j = 0; j < 8; ++j) { yn0[j] = (pg8::u32x2){0u, 0u}; yn1[j] = (pg8::u32x2){0u, 0u}; }
            if (l == 1) {
#pragma unroll
                for (int j = 0; j < 8; ++j) { yn0[j] = *(const pg8::u32x2*)(Y2 + (size_t)(2 * r0) * D + l4 + 256 * j); yn1[j] = *(const pg8::u32x2*)(Y2 + (size_t)(2 * r0 + 1) * D + l4 + 256 * j); } } }
#pragma unroll 1
        for (; row < MROWS; row += NGW) {
            const int l4 = opqv(lane * 4);
            const int s = modsel(row);
            f32x4 v[8]; pg8::u32x2 y0[8], y1[8];
#pragma unroll
            for (int j = 0; j < 8; ++j) { v[j] = vn[j]; y0[j] = yn0[j]; y1[j] = yn1[j]; }
            const int nrow = min(row + NGW, MROWS - 1);
            { const float* src = N1_SRC(nrow);
#pragma unroll
                for (int j = 0; j < 8; ++j) vn[j] = *(const f32x4*)(src + l4 + 256 * j);
                if (l == 1) {
#pragma unroll
                    for (int j = 0; j < 8; ++j) { yn0[j] = *(const pg8::u32x2*)(Y2 + (size_t)(2 * nrow) * D + l4 + 256 * j); yn1[j] = *(const pg8::u32x2*)(Y2 + (size_t)(2 * nrow + 1) * D + l4 + 256 * j); } } }
            if (l == 1) {
                const float* ga = modv + (size_t)s * (NMOD * D) + 5 * D;
#pragma unroll
                for (int j = 0; j < 8; ++j) { const int col = l4 + 256 * j; const f32x4 g = *(const f32x4*)(ga + col);
                    v[j][0] += g[0] * (__uint_as_float(y0[j].x << 16) + __uint_as_float(y1[j].x << 16)); v[j][1] += g[1] * (__uint_as_float(y0[j].x & 0xffff0000u) + __uint_as_float(y1[j].x & 0xffff0000u));
                    v[j][2] += g[2] * (__uint_as_float(y0[j].y << 16) + __uint_as_float(y1[j].y << 16)); v[j][3] += g[3] * (__uint_as_float(y0[j].y & 0xffff0000u) + __uint_as_float(y1[j].y & 0xffff0000u));
                    *(f32x4*)(X + (size_t)row * D + col) = v[j]; }
            }
            float ss = 0.f;
#pragma unroll
            for (int j = 0; j < 8; ++j) ss += v[j][0] * v[j][0] + v[j][1] * v[j][1] + v[j][2] * v[j][2] + v[j][3] * v[j][3];
            ss = wave_sum(ss);
            const float rstd = rsqrtf(ss * (1.f / D) + 1e-6f);
            const float* sh = modl + (size_t)s * (NMOD * D); const float* sc = sh + D;
#pragma unroll
            for (int j = 0; j < 8; ++j) { const int col = l4 + 256 * j; const f32x4 g = *(const f32x4*)(g1 + col), a = *(const f32x4*)(sc + col), b = *(const f32x4*)(sh + col);
                const f32x4 h = v[j] * rstd * g * (a + 1.f) + b; pg8::u32x2 o; o.x = pk2(h[0], h[1]); o.y = pk2(h[2], h[3]); *(pg8::u32x2*)(H + (size_t)row * D + col) = o; }
        }
#undef N1_SRC
    }
    if (kk == 1) {
        PHASE_PROLOG; const float* modl = modv + (size_t)l * 3 * NMOD * D; (void)modl;
        pg8::Prob P{H, Win_t + (size_t)l * IN_DIM * D, D, D, D, 0, (long long)256 * D, 0, 0, (long long)256 * D, 0, 0};
        pg8::StaticOrder S; S.init(MROWS / 256, IN_DIM / 256, F.G, (int)blockIdx.x);
        for (int e = tid; e < 2048; e += NWAVES * 64) ((LAS float*)(F.lds + ROPE_OFF))[e] = rope[e];
        __syncthreads();
        pg8::EpiG1 E{U, (const PG8_LAS float*)(F.lds + ROPE_OFF)};
        pg8::gemm_phase<pg8::EpiG1, pg8::StaticOrder, false, true>(F.lds + RING_OFF, P, S, E, rows_lds);
    }
    if (kk == 2) {
        PHASE_PROLOG; const float* modl = modv + (size_t)l * 3 * NMOD * D; (void)modl;
        const int NT = mrows / 256;
        pg8::Prob P{WC, U + UF, 256, IN_DIM, 256, 0, 0, 0, 0, (long long)256 * IN_DIM, 128, 0};
        pg8::DftASched S{4 * NT, F.G, (int)blockIdx.x, 0};
        pg8::EpiDftA E{PQT, PQTC};
#ifdef PROBE_SUB
        for (int rep_ = 0; rep_ < (PROBE_SUB == 3 ? 2 : 1); ++rep_)
#endif
        pg8::gemm_phase<pg8::EpiDftA, pg8::DftASched, false, true>(F.lds + RING_OFF, P, S, E, rows_lds);
        __syncthreads();
        {
            const int nun = (l == 0) ? 272 : 256;
#ifdef PROBE_SUB
            for (int rep_ = 0; rep_ < (PROBE_SUB == 1 ? 2 : 1); ++rep_)
#endif
            for (int un = blockIdx.x; un < nun; un += F.G) att::attn_unit(F.lds + RING_OFF, U, MIX, INP(10) + l * 8, un, tid);
        }

        {
            const int nti = (l == 0) ? 272 : 256;
            if ((int)blockIdx.x < nti) { __syncthreads(); conv_fill_w(F.lds + RING_OFF, INP(12) + l * 31 * 512, tid); }
#ifdef PROBE_SUB
            for (int rep_ = 0; rep_ < (PROBE_SUB == 2 ? 2 : 1); ++rep_)
#endif
            for (int ti = blockIdx.x; ti < nti; ti += F.G) conv_tile(F.lds + RING_OFF, U, MIX, INP(11) + l * 3 * 512, INP(13) + l * 512, INP(14) + l * 512, INP(15) + l * 512, ti, tid);
        }
    }
    if (kk == 3) {
        PHASE_PROLOG; const float* modl = modv + (size_t)l * 3 * NMOD * D; (void)modl;
        { pg8::Prob P{CS, PQT, 2 * SEQ, 2 * SEQ, 2048, 0, (long long)256 * 2 * SEQ, 0, 2048, (long long)256 * 2 * SEQ, (long long)512 * 2 * SEQ, 2048};
          pg8::DftBSched S{256, F.G, (int)blockIdx.x, 0};
          pg8::EpiDftB E{PART, 0, 0, SEQ};
          pg8::gemm_phase<pg8::EpiDftB, pg8::DftBSched, false, true>(F.lds + RING_OFF, P, S, E, rows_lds); }
        if (l == 0) {
          pg8::Prob P{CSC, PQTC, 2 * CTXL, 2 * CTXL, 2 * CTXL, 0, 0, 0, 0, (long long)256 * 2 * CTXL, (long long)512 * 2 * CTXL, 0};
          pg8::DftBSched S{4, F.G, (int)blockIdx.x, 1};
          pg8::EpiDftB E{PART, MLAT, 0, CTXL};
          pg8::gemm_phase<pg8::EpiDftB, pg8::DftBSched, false, true>(F.lds + RING_OFF, P, S, E, rows_lds); }
    }
    if (kk == 4) {
        PHASE_PROLOG; const float* modl = modv + (size_t)l * 3 * NMOD * D; (void)modl;
        float sc_lat = 0.001381067932f, sc_ctx = 0.005524271728f;
        asm volatile("" : "+v"(sc_lat), "+v"(sc_ctx));
        const int nitems = mrows * 128;
        for (int it = blockIdx.x * (NWAVES * 64) + tid; it < nitems; it += F.G * NWAVES * 64) {
            const int row = it >> 7, n = (it & 127) * 4;
            f32x4 a = *(const f32x4*)(PART + (size_t)row * 512 + n);
            if (row < MLAT) { a += *(const f32x4*)(PART + ((size_t)MROWS + row) * 512 + n); a += *(const f32x4*)(PART + ((size_t)2 * MROWS + row) * 512 + n); a += *(const f32x4*)(PART + ((size_t)3 * MROWS + row) * 512 + n); a = a * sc_lat; }
            else a = a * sc_ctx;
            pg8::u32x2 o; o.x = pk2(a[0], a[1]); o.y = pk2(a[2], a[3]); *(pg8::u32x2*)(MIX + (size_t)row * D + 512 + n) = o;
        }
    }
    if (kk == 5) {
        PHASE_PROLOG; const float* modl = modv + (size_t)l * 3 * NMOD * D; (void)modl;
        pg8::Prob P{MIX, Wout_t + (size_t)l * D * D, D, D, D, 0, (long long)256 * D, 0, 0, (long long)256 * D, 0, 0};
        pg8::StaticOrder S; S.init(mrows / 256, D / 256, F.G, (int)blockIdx.x);
        pg8::EpiG2 E{X, l == 0 ? x_in : X, l == 0 ? ctx_in : X + (size_t)MLAT * D, modl};
        pg8::gemm_phase<pg8::EpiG2, pg8::StaticOrder, false, true>(F.lds + RING_OFF, P, S, E, rows_lds);
    }
    if (kk == 6) {
        PHASE_PROLOG; const float* modl = modv + (size_t)l * 3 * NMOD * D; (void)modl;
        N2Ctx C{X, H, g_norm2 + l * D, modl, w_rg + (size_t)l * D * 4, w_re + (size_t)l * D * 16, b_rg + l * 4, b_re + l * 16, tok_e, tok_w, F.ctl + 64 * l, list};
        LAS float* wt = (LAS float*)(F.lds + RING_OFF);
        const int nr = (mrows + F.G - 1) / F.G;
        const int rbeg = F.vcu * nr, rend = min(mrows, rbeg + nr);
        for (int rb = rbeg; rb < rend; rb += 40) {
            const int lim = min(rend, rb + 40);
#pragma unroll 1
            for (int gi = 0; gi < 3; ++gi) {
                int ra[2];
#pragma unroll
                for (int i = 0; i < 2; ++i) { const int r = rb + F.wave + 8 * (2 * gi + i); ra[i] = (r < lim && 2 * gi + i < 5) ? r : 0x7fffffff; }
                n2_group<2>(C, wt, ra, mrows, lane, tid);
            }
        }
        __syncthreads();
    }
    if (kk == 7 || kk == 8) {
        PHASE_PROLOG;
        const unsigned* cnt = F.ctl + 64 * l;
        { const int ph = kk;
            const int NPN = (ph == 7) ? 4 : 8;
            __syncthreads();
            if (tid == 0) {
                LAS int* pre = ulist + 40; pre[0] = 0;
                for (int e = 0; e < NEXP; ++e) pre[e + 1] = pre[e] + (int)((__hip_atomic_load(cnt + e, RLX_AGENT) + 255u) >> 8);
                int n = 0;
                for (int i = 0; i < 4; ++i) { const int L = i * F.G + (int)blockIdx.x; if (L >= pre[NEXP] * NPN) break; const int tau = L / NPN; int e = 0; while (pre[e + 1] <= tau) ++e;
                    ulist[n * 4] = tau; ulist[n * 4 + 1] = L % NPN; ulist[n * 4 + 2] = e; ulist[n * 4 + 3] = tau - pre[e]; ++n; }
                ulist[32] = n;
            }
            __syncthreads();
            const int nu = __builtin_amdgcn_readfirstlane(ulist[32]);
            for (int i = 0; i < nu; ++i) { const int e = ulist[i * 4 + 2], rt = ulist[i * 4 + 3]; const unsigned ce = __hip_atomic_load(cnt + e, RLX_AGENT);
                for (int r = tid; r < 256; r += NWAVES * 64) { const unsigned idx = (unsigned)rt * 256u + (unsigned)r; ((LAS unsigned*)(F.lds + ROWS_OFF))[i * 256 + r] = idx < ce ? list[(size_t)e * (2 * MROWS) + idx] : 0xFFFFFFFFu; } }
            __syncthreads();
            pg8::ListSched S{(const PG8_LAS int*)ulist, nu};
            if (ph == 7) {
                pg8::Prob P{H, Wgu_t + (size_t)l * NEXP * (2 * DEXP) * D, D, D, D, 0, 0, 0, 0, (long long)256 * D, (long long)(2 * DEXP) * D, 0};
                pg8::EpiMoeUp E{HIDB, tok_w, rows_lds};
                pg8::gemm_phase<pg8::EpiMoeUp, pg8::ListSched, true, true>(F.lds + RING_OFF, P, S, E, rows_lds);
            } else {
                pg8::Prob P{HIDB, Wdn_t + (size_t)l * NEXP * D * DEXP, DEXP, DEXP, DEXP, 0, (long long)256 * DEXP, 0, 0, (long long)256 * DEXP, (long long)D * DEXP, 0};
                pg8::EpiMoeDown E{Y2, rows_lds};
                pg8::gemm_phase<pg8::EpiMoeDown, pg8::ListSched, false, true>(F.lds + RING_OFF, P, S, E, rows_lds);
            }
        }
    }
    if (kk == -2) {
        PHASE_PROLOG;
        const float* modl1 = modv + (size_t)3 * NMOD * D;
        const int l4 = lane * 4;
        f32x4 vn[8]; pg8::u32x2 yn0[8], yn1[8];
        int row = gw;
        { const int r0 = min(row, MLAT - 1);
#pragma unroll
            for (int j = 0; j < 8; ++j) { vn[j] = *(const f32x4*)(X + (size_t)r0 * D + l4 + 256 * j); yn0[j] = *(const pg8::u32x2*)(Y2 + (size_t)(2 * r0) * D + l4 + 256 * j); yn1[j] = *(const pg8::u32x2*)(Y2 + (size_t)(2 * r0 + 1) * D + l4 + 256 * j); } }
#pragma unroll 1
        for (; row < MLAT; row += NGW) {
            const int l4 = opqv(lane * 4);
            const int s = modsel(row);
            const float* ga = modl1 + (size_t)s * (NMOD * D) + 5 * D;
            f32x4 v[8]; pg8::u32x2 y0[8], y1[8];
#pragma unroll
            for (int j = 0; j < 8; ++j) { v[j] = vn[j]; y0[j] = yn0[j]; y1[j] = yn1[j]; }
            const int nrow = min(row + NGW, MLAT - 1);
            {
#pragma unroll
                for (int j = 0; j < 8; ++j) { vn[j] = *(const f32x4*)(X + (size_t)nrow * D + l4 + 256 * j); yn0[j] = *(const pg8::u32x2*)(Y2 + (size_t)(2 * nrow) * D + l4 + 256 * j); yn1[j] = *(const pg8::u32x2*)(Y2 + (size_t)(2 * nrow + 1) * D + l4 + 256 * j); } }
            float ss = 0.f;
#pragma unroll
            for (int j = 0; j < 8; ++j) { const int col = l4 + 256 * j; const f32x4 g = *(const f32x4*)(ga + col);
                v[j][0] += g[0] * (__uint_as_float(y0[j].x << 16) + __uint_as_float(y1[j].x << 16)); v[j][1] += g[1] * (__uint_as_float(y0[j].x & 0xffff0000u) + __uint_as_float(y1[j].x & 0xffff0000u));
                v[j][2] += g[2] * (__uint_as_float(y0[j].y << 16) + __uint_as_float(y1[j].y << 16)); v[j][3] += g[3] * (__uint_as_float(y0[j].y & 0xffff0000u) + __uint_as_float(y1[j].y & 0xffff0000u));
                ss += v[j][0] * v[j][0] + v[j][1] * v[j][1] + v[j][2] * v[j][2] + v[j][3] * v[j][3]; }
            ss = wave_sum(ss);
            const float rstd = rsqrtf(ss * (1.f / D) + 1e-6f);
#pragma unroll
            for (int j = 0; j < 8; ++j) { const int col = l4 + 256 * j; const f32x4 g = *(const f32x4*)(g_final + col); *(f32x4*)(args.out + (size_t)row * D + col) = v[j] * rstd * g; }
        }
    }
    if (pi + 1 < hi) GRID_BAR();
  }
#undef x_in
#undef c_in
#undef ctx_in
#undef c_ctx
#undef w_mod
#undef b_mod
#undef w_in
#undef w_out
#undef w_gate
#undef w_up
#undef w_down
#undef modv
#undef rope
#undef tok_w
#undef tok_e
#undef list
#undef X
#undef H
#undef U
#undef MIX
#undef Y2
#undef Win_t
#undef Wout_t
#undef Wgu_t
#undef Wdn_t
#undef CS
#undef CSC
#undef WC
#undef PQT
#undef PQTC
#undef PART
#undef HIDB
#undef g_norm1
#undef g_norm2
#undef g_final
#undef w_rg
#undef b_rg
#undef w_re
#undef b_re
#undef PC_OF
#undef GRID_BAR
}

static int g_grid = 0;
static void mega_launch(MArgs a, int lo, int hi, int layer, int use_bar, hipStream_t stream) {
    a.ph_lo = lo; a.ph_hi = hi; a.layer = layer; a.use_bar = use_bar;
    hipLaunchKernelGGL(mega_fwd, dim3(g_grid), dim3(NWAVES * 64), LDS_BYTES, stream, a);
}
extern "C" void kernel_launch(void* const* d_in, const int* in_sizes, int n_in, void* d_out, int out_size, void* d_ws, size_t ws_size, hipStream_t stream) {
    if (g_grid == 0) {
        int dev = 0, cus = 0;
        (void)hipGetDevice(&dev); (void)hipDeviceGetAttribute(&cus, hipDeviceAttributeMultiprocessorCount, dev);
        (void)hipFuncSetAttribute((const void*)mega_fwd, hipFuncAttributeMaxDynamicSharedMemorySize, LDS_BYTES);
        g_grid = cus > 0 ? cus : 256;
    }
    const float* x_in = (const float*)d_in[0]; const float* ctx = (const float*)d_in[2];
    const float* g_norm1 = (const float*)d_in[6]; const float* g_norm2 = (const float*)d_in[7];
    const float* attn_sink = (const float*)d_in[10]; const float* sconv_w = (const float*)d_in[11];
    const float* cconv_w = (const float*)d_in[12]; const float* cconv_b = (const float*)d_in[13]; const float* cnorm_g = (const float*)d_in[14]; const float* cnorm_b = (const float*)d_in[15];
    const float* w_rg = (const float*)d_in[16]; const float* b_rg = (const float*)d_in[17]; const float* w_re = (const float*)d_in[18]; const float* b_re = (const float*)d_in[19];
    const float* g_final = (const float*)d_in[23];
    unsigned char* ws = (unsigned char*)d_ws;
    unsigned* ctl = (unsigned*)(ws + WS_CTL);
    float* modv = (float*)(ws + WS_MOD);
    int* tok_e = (int*)(ws + WS_TOK); float* tok_w = (float*)(ws + WS_TOK + 128 * 1024); unsigned* list = (unsigned*)(ws + WS_LIST);
    float* X = (float*)(ws + WS_X); bf16_t* H = (bf16_t*)(ws + WS_H); bf16_t* U = (bf16_t*)(ws + WS_U); bf16_t* MIX = (bf16_t*)(ws + WS_MIX);
    float* P = (float*)(ws + WS_P); float* Q = (float*)(ws + WS_Q); bf16_t* Y2 = (bf16_t*)(ws + WS_Y2);
    float* out = (float*)d_out;
    MArgs a{};
    for (int i = 0; i < 24; ++i) a.in[i] = (const float*)d_in[i];
    a.out = out; a.ws = ws;
    (void)hipMemsetAsync(ctl, 0, 65536, stream);
#ifdef PROBE_DUP
    mega_launch(a, 0, 21, 0, 1, stream);
#else
    mega_launch(a, 0, 20, 0, 1, stream);
#endif
}
```

```cpp
#include <hip/hip_runtime.h>
#include <stdint.h>
#include <math.h>

typedef unsigned short bf16_t;
__device__ __forceinline__ float bf2f(bf16_t v) { return __uint_as_float(((unsigned)v) << 16); }
__device__ __forceinline__ bf16_t f2bf(float f) { unsigned u = __float_as_uint(f); return (bf16_t)((u + 0x7fffu + ((u >> 16) & 1u)) >> 16); }

constexpr int D = 2048, SEQ = 4096, CTXL = 256, NBATCH = 2;
constexpr int MLAT = NBATCH * SEQ, MCTX = NBATCH * CTXL, MROWS = MLAT + MCTX;
constexpr int IN_DIM = 3840, NMOD = 6;
constexpr int NEXP = 16, DEXP = 512;
constexpr float QSCALE = 0.125f * 1.4426950408889634f;
constexpr float LOG2E = 1.4426950408889634f;
constexpr int UQ = 0, UK = 512, UV = 640, UF = 768, USB = 1280, USC = 1792, USV = 2304, UDA = 2816, UDG = 3328;

__device__ __forceinline__ int modsel(int row) { return row < SEQ ? 0 : (row < MLAT ? 1 : 2); }
__device__ __forceinline__ void seqinfo(int row, int& base, int& t, int& len) {
    if (row < MLAT) { base = row & ~(SEQ - 1); t = row & (SEQ - 1); len = SEQ; }
    else { int r = row - MLAT; base = MLAT + (r & ~(CTXL - 1)); t = r & (CTXL - 1); len = CTXL; }
}
__device__ __forceinline__ float silu_f(float v) { return v / (1.f + __expf(-v)); }
__device__ __forceinline__ float sigmoid_f(float v) { return 1.f / (1.f + __expf(-v)); }

constexpr size_t MiB = 1u << 20;
constexpr size_t WS_CTL = 0;
constexpr size_t WS_MODP = 1 * MiB;
constexpr size_t WS_MOD = 6 * MiB;
constexpr size_t WS_ROPE = 7 * MiB;
constexpr size_t WS_TOK = 8 * MiB;
constexpr size_t WS_LIST = 9 * MiB;
constexpr size_t WS_X = 16 * MiB;
constexpr size_t WS_H = 88 * MiB;
constexpr size_t WS_U = 124 * MiB;
constexpr size_t WS_MIX = 190 * MiB;
constexpr size_t WS_P = 226 * MiB;
constexpr size_t WS_Q = 244 * MiB;
constexpr size_t WS_HID = 262 * MiB;
constexpr size_t WS_Y2 = 280 * MiB;
constexpr size_t WS_END = 350 * MiB;

__global__ void k_mod_partial(const float* __restrict__ c, const float* __restrict__ c_ctx, const float* __restrict__ w_mod, float* __restrict__ part) {
    const int j = blockIdx.x * 256 + threadIdx.x, l = blockIdx.y, kc = blockIdx.z;
    __shared__ float sc[3][128];
    if (threadIdx.x < 128) {
        const int k = kc * 128 + threadIdx.x;
        sc[0][threadIdx.x] = silu_f(c[k]); sc[1][threadIdx.x] = silu_f(c[D + k]); sc[2][threadIdx.x] = silu_f(c_ctx[k]);
    }
    __syncthreads();
    const float* w = w_mod + ((size_t)l * D + (size_t)kc * 128) * (NMOD * D) + j;
    float a0 = 0.f, a1 = 0.f, a2 = 0.f;
#pragma unroll 8
    for (int k = 0; k < 128; ++k) { const float wv = w[(size_t)k * (NMOD * D)]; a0 += sc[0][k] * wv; a1 += sc[1][k] * wv; a2 += sc[2][k] * wv; }
    float* p = part + (((size_t)kc * 2 + l) * 3) * (NMOD * D) + j;
    p[0] = a0; p[NMOD * D] = a1; p[2 * NMOD * D] = a2;
}
__global__ void k_mod_reduce(const float* __restrict__ part, const float* __restrict__ b_mod, float* __restrict__ modv) {
    const int idx = blockIdx.x * 256 + threadIdx.x;
    if (idx >= 2 * 3 * NMOD * D) return;
    const int j = idx % (NMOD * D), l = idx / (3 * NMOD * D);
    float a = b_mod[l * NMOD * D + j];
    for (int kc = 0; kc < 16; ++kc) a += part[(size_t)kc * (2 * 3 * NMOD * D) + idx];
    modv[idx] = a;
}
__global__ void k_rope_table(float* __restrict__ tab) {
    const int idx = blockIdx.x * 256 + threadIdx.x; if (idx >= 64 * 16) return;
    const int pos = idx >> 4, i = idx & 15;
    const float freq = powf(10000.f, -(float)(2 * i) / 32.f);
    const float ang = (float)pos * freq;
    tab[idx * 2] = cosf(ang); tab[idx * 2 + 1] = sinf(ang);
}
__global__ void k_init_x(const float* __restrict__ x, const float* __restrict__ ctx, float* __restrict__ X) {
    const size_t i = (size_t)blockIdx.x * 256 + threadIdx.x;
    const size_t nlat = (size_t)MLAT * D / 4, ntot = (size_t)MROWS * D / 4;
    if (i >= ntot) return;
    ((float4*)X)[i] = i < nlat ? ((const float4*)x)[i] : ((const float4*)ctx)[i - nlat];
}

__device__ __forceinline__ float wave_sum(float v) {
#pragma unroll
    for (int o = 32; o > 0; o >>= 1) v += __shfl_xor(v, o);
    return v;
}
template <int NW> __device__ __forceinline__ float block_sum(float v, float* red) {
    v = wave_sum(v);
    const int w = threadIdx.x >> 6;
    __syncthreads();
    if ((threadIdx.x & 63) == 0) red[w] = v;
    __syncthreads();
    float s = 0.f;
#pragma unroll
    for (int i = 0; i < NW; ++i) s += red[i];
    return s;
}

struct RouteW { const float* wg; const float* bg; const float* we; const float* be; int* tok_e; float* tok_w; unsigned* cnt; unsigned* list; };
template <bool ROUTE, bool COMBINE>
__global__ void __launch_bounds__(256) k_norm(float* __restrict__ X, const float* __restrict__ g, const float* __restrict__ modv_l, long long sh_idx, bf16_t* __restrict__ H,
                                              const bf16_t* __restrict__ Y2, const float* __restrict__ modv_prev, RouteW R) {
    __shared__ float red[4];
    __shared__ float rl[20][4];
    const int row = blockIdx.x, tid = threadIdx.x, s = modsel(row);
    float v[8];
    float* xr = X + (size_t)row * D;
#pragma unroll
    for (int i = 0; i < 2; ++i) { const float4 t = *(const float4*)(xr + i * 1024 + tid * 4); v[i * 4] = t.x; v[i * 4 + 1] = t.y; v[i * 4 + 2] = t.z; v[i * 4 + 3] = t.w; }
    if (COMBINE) {
        const float* ga = modv_prev + (size_t)s * (NMOD * D) + 5 * D;
#pragma unroll
        for (int i = 0; i < 2; ++i)
#pragma unroll
            for (int j = 0; j < 4; ++j) { const int col = i * 1024 + tid * 4 + j; v[i * 4 + j] += ga[col] * (bf2f(Y2[(size_t)(2 * row) * D + col]) + bf2f(Y2[(size_t)(2 * row + 1) * D + col])); }
#pragma unroll
        for (int i = 0; i < 2; ++i) *(float4*)(xr + i * 1024 + tid * 4) = make_float4(v[i * 4], v[i * 4 + 1], v[i * 4 + 2], v[i * 4 + 3]);
    }
    float ss = 0.f;
#pragma unroll
    for (int i = 0; i < 8; ++i) ss += v[i] * v[i];
    ss = block_sum<4>(ss, red);
    const float rstd = rsqrtf(ss * (1.f / D) + 1e-6f);
    const float* sh = modv_l + (size_t)s * (NMOD * D) + (size_t)sh_idx * D;
    const float* sc = sh + D;
    float hv[8];
#pragma unroll
    for (int i = 0; i < 2; ++i)
#pragma unroll
        for (int j = 0; j < 4; ++j) { const int col = i * 1024 + tid * 4 + j; hv[i * 4 + j] = v[i * 4 + j] * rstd * g[col] * (1.f + sc[col]) + sh[col]; }
#pragma unroll
    for (int i = 0; i < 2; ++i) {
        ushort4 o; o.x = f2bf(hv[i * 4]); o.y = f2bf(hv[i * 4 + 1]); o.z = f2bf(hv[i * 4 + 2]); o.w = f2bf(hv[i * 4 + 3]);
        *(ushort4*)(H + (size_t)row * D + i * 1024 + tid * 4) = o;
    }
    if (ROUTE) {
        float acc[20];
#pragma unroll
        for (int q = 0; q < 20; ++q) acc[q] = 0.f;
#pragma unroll
        for (int i = 0; i < 2; ++i)
#pragma unroll
            for (int j = 0; j < 4; ++j) {
                const int col = i * 1024 + tid * 4 + j; const float hvv = hv[i * 4 + j];
                const float4 wgv = *(const float4*)(R.wg + (size_t)col * 4);
                acc[0] += hvv * wgv.x; acc[1] += hvv * wgv.y; acc[2] += hvv * wgv.z; acc[3] += hvv * wgv.w;
#pragma unroll
                for (int q = 0; q < 4; ++q) { const float4 wv = *(const float4*)(R.we + (size_t)col * 16 + q * 4); acc[4 + q * 4] += hvv * wv.x; acc[5 + q * 4] += hvv * wv.y; acc[6 + q * 4] += hvv * wv.z; acc[7 + q * 4] += hvv * wv.w; }
            }
#pragma unroll
        for (int q = 0; q < 20; ++q) { const float t = wave_sum(acc[q]); if ((tid & 63) == 0) rl[q][tid >> 6] = t; }
        __syncthreads();
        if (tid == 0) {
            float gl[4], el[16];
            for (int q = 0; q < 4; ++q) gl[q] = rl[q][0] + rl[q][1] + rl[q][2] + rl[q][3] + R.bg[q];
            for (int q = 0; q < 16; ++q) el[q] = rl[4 + q][0] + rl[4 + q][1] + rl[4 + q][2] + rl[4 + q][3] + R.be[q];
            int gs = 0; for (int q = 1; q < 4; ++q) if (gl[q] > gl[gs]) gs = q;
            float den = 0.f; for (int q = 0; q < 4; ++q) den += __expf(gl[q] - gl[gs]);
            const float pg = 1.f / den;
            const float* eg = el + gs * 4;
            int i0 = 0; for (int q = 1; q < 4; ++q) if (eg[q] > eg[i0]) i0 = q;
            int i1 = -1; for (int q = 0; q < 4; ++q) if (q != i0 && (i1 < 0 || eg[q] > eg[i1])) i1 = q;
            const float w0 = 1.f / (1.f + __expf(eg[i1] - eg[i0])), w1 = 1.f - w0;
            const int e0 = gs * 4 + i0, e1 = gs * 4 + i1;
            R.tok_e[row * 2] = e0; R.tok_e[row * 2 + 1] = e1; R.tok_w[row * 2] = w0 * pg; R.tok_w[row * 2 + 1] = w1 * pg;
            const unsigned p0 = atomicAdd(R.cnt + e0, 1u); R.list[(size_t)e0 * (2 * MROWS) + p0] = row * 2;
            const unsigned p1 = atomicAdd(R.cnt + e1, 1u); R.list[(size_t)e1 * (2 * MROWS) + p1] = row * 2 + 1;
        }
    }
}

struct ARowsPlain { const bf16_t* A; long long lda; __device__ __forceinline__ const bf16_t* row(int m) const { return A + (size_t)m * lda; } __device__ __forceinline__ int nrows(int M) const { return M; } };
struct ARowsList { const bf16_t* A; long long lda; const unsigned* list; long long shift; const unsigned* cnt; __device__ __forceinline__ const bf16_t* row(int m) const { return A + (size_t)(list[m] >> shift) * lda; } __device__ __forceinline__ int nrows(int) const { return (int)*cnt; } };
template <class AR, class Epi, int NB>
__global__ void __launch_bounds__(256) k_gemm(AR ar, const float* __restrict__ W0, const float* __restrict__ W1, int ldw, int M, int N, int K, Epi epi) {
    __shared__ float As[16][65];
    __shared__ float Bs[NB][16][64];
    const int Mr = ar.nrows(M);
    const int m0 = blockIdx.y * 64, n0 = blockIdx.x * 64;
    if (m0 >= Mr) return;
    const int tid = threadIdx.x, tx = tid & 15, ty = tid >> 4;
    float acc[NB][4][4];
#pragma unroll
    for (int b = 0; b < NB; ++b)
#pragma unroll
        for (int i = 0; i < 4; ++i)
#pragma unroll
            for (int j = 0; j < 4; ++j) acc[b][i][j] = 0.f;
    const int ar_m = tid >> 2, ar_k = (tid & 3) * 4;
    const bool a_ok = (m0 + ar_m) < Mr;
    const bf16_t* arow = a_ok ? ar.row(m0 + ar_m) : nullptr;
    const int br_k = tid >> 4, br_n = (tid & 15) * 4;
    for (int k0 = 0; k0 < K; k0 += 16) {
        ushort4 av = make_ushort4(0, 0, 0, 0);
        if (a_ok) av = *(const ushort4*)(arow + k0 + ar_k);
        As[ar_k][ar_m] = bf2f(av.x); As[ar_k + 1][ar_m] = bf2f(av.y); As[ar_k + 2][ar_m] = bf2f(av.z); As[ar_k + 3][ar_m] = bf2f(av.w);
        { const float4 bv = *(const float4*)(W0 + (size_t)(k0 + br_k) * ldw + n0 + br_n); *(float4*)&Bs[0][br_k][br_n] = bv; }
        if (NB == 2) { const float4 bv = *(const float4*)(W1 + (size_t)(k0 + br_k) * ldw + n0 + br_n); *(float4*)&Bs[NB - 1][br_k][br_n] = bv; }
        __syncthreads();
#pragma unroll
        for (int k = 0; k < 16; ++k) {
            float a[4];
#pragma unroll
            for (int i = 0; i < 4; ++i) a[i] = As[k][ty * 4 + i];
#pragma unroll
            for (int b = 0; b < NB; ++b) {
                const float4 bv = *(const float4*)&Bs[b][k][tx * 4];
#pragma unroll
                for (int i = 0; i < 4; ++i) { acc[b][i][0] += a[i] * bv.x; acc[b][i][1] += a[i] * bv.y; acc[b][i][2] += a[i] * bv.z; acc[b][i][3] += a[i] * bv.w; }
            }
        }
        __syncthreads();
    }
#pragma unroll
    for (int i = 0; i < 4; ++i) { const int m = m0 + ty * 4 + i; if (m < Mr) epi(m, n0 + tx * 4, acc, i); }
}
struct EpiStoreBf16 { bf16_t* C; long long ldc;
    __device__ __forceinline__ void operator()(int m, int n, const float (&acc)[1][4][4], int i) const {
        ushort4 o; o.x = f2bf(acc[0][i][0]); o.y = f2bf(acc[0][i][1]); o.z = f2bf(acc[0][i][2]); o.w = f2bf(acc[0][i][3]); *(ushort4*)(C + (size_t)m * ldc + n) = o; } };
struct EpiResid { float* X; const float* modv_l; long long ga_idx;
    __device__ __forceinline__ void operator()(int m, int n, const float (&acc)[1][4][4], int i) const {
        const float* ga = modv_l + (size_t)modsel(m) * (NMOD * D) + (size_t)ga_idx * D + n; float4* p = (float4*)(X + (size_t)m * D + n); float4 x = *p;
        x.x += ga[0] * acc[0][i][0]; x.y += ga[1] * acc[0][i][1]; x.z += ga[2] * acc[0][i][2]; x.w += ga[3] * acc[0][i][3]; *p = x; } };
struct EpiMoeUp { bf16_t* Hid; const unsigned* list; const float* tok_w;
    __device__ __forceinline__ void operator()(int m, int n, const float (&acc)[2][4][4], int i) const {
        const unsigned ent = list[m]; const float w = tok_w[ent]; ushort4 o;
        o.x = f2bf(silu_f(acc[0][i][0]) * acc[1][i][0] * w); o.y = f2bf(silu_f(acc[0][i][1]) * acc[1][i][1] * w); o.z = f2bf(silu_f(acc[0][i][2]) * acc[1][i][2] * w); o.w = f2bf(silu_f(acc[0][i][3]) * acc[1][i][3] * w);
        *(ushort4*)(Hid + (size_t)ent * DEXP + n) = o; } };
struct EpiMoeDown { bf16_t* Y2; const unsigned* list;
    __device__ __forceinline__ void operator()(int m, int n, const float (&acc)[1][4][4], int i) const {
        const unsigned ent = list[m]; ushort4 o; o.x = f2bf(acc[0][i][0]); o.y = f2bf(acc[0][i][1]); o.z = f2bf(acc[0][i][2]); o.w = f2bf(acc[0][i][3]); *(ushort4*)(Y2 + (size_t)ent * D + n) = o; } };

__global__ void k_rope(bf16_t* __restrict__ U, const float* __restrict__ tab, long long nrows_) {
    const int idx = blockIdx.x * 256 + threadIdx.x;
    const int nrows = (int)nrows_; if (idx >= nrows * 320) return;
    const int row = idx / 320, r = idx % 320, hs = r >> 5, i = r & 31;
    const int axis = i >> 4, fi = i & 15;
    const int col0 = hs * 64 + axis * 32 + fi;
    bf16_t* p = U + (size_t)row * IN_DIM + col0;
    float z1 = bf2f(p[0]), z2 = bf2f(p[16]);
    const float sc = hs < 8 ? QSCALE : 1.f;
    if (row < MLAT) {
        const int t = row & (SEQ - 1); const int pos = axis ? (t & 63) : (t >> 6);
        const float c = tab[(pos * 16 + fi) * 2], s = tab[(pos * 16 + fi) * 2 + 1];
        const float o1 = z1 * c - z2 * s, o2 = z1 * s + z2 * c; z1 = o1; z2 = o2;
    }
    p[0] = f2bf(z1 * sc); p[16] = f2bf(z2 * sc);
}

__global__ void __launch_bounds__(64) k_attn(const bf16_t* __restrict__ U, const float* __restrict__ sink, bf16_t* __restrict__ MIX) {
    __shared__ float qs[64];
    __shared__ float ps[576];
    const int row = blockIdx.x, h = blockIdx.y, kvh = h >> 2, lane = threadIdx.x;
    int base, t, len; seqinfo(row, base, t, len);
    const int b = row < MLAT ? (row >> 12) : ((row - MLAT) >> 8);
    qs[lane] = bf2f(U[(size_t)row * IN_DIM + UQ + h * 64 + lane]);
    __syncthreads();
    int lo = 0, nloc = 0;
    if (row < MLAT) { lo = max(0, t - 128); const int hi = min(SEQ - 1, t + 128); nloc = hi - lo + 1; }
    const int nk = nloc + CTXL;
    const int cbase = MLAT + b * CTXL;
    float mx = sink[h] * LOG2E;
    for (int j = lane; j < nk; j += 64) {
        const int krow = j < nloc ? (base + lo + j) : (cbase + j - nloc);
        const bf16_t* kp = U + (size_t)krow * IN_DIM + UK + kvh * 64;
        float s = 0.f;
#pragma unroll 8
        for (int d = 0; d < 64; ++d) s += qs[d] * bf2f(kp[d]);
        ps[j] = s; mx = fmaxf(mx, s);
    }
#pragma unroll
    for (int o = 32; o > 0; o >>= 1) mx = fmaxf(mx, __shfl_xor(mx, o));
    float sum = 0.f;
    for (int j = lane; j < nk; j += 64) { const float p = exp2f(ps[j] - mx); ps[j] = p; sum += p; }
    sum = wave_sum(sum) + exp2f(sink[h] * LOG2E - mx);
    __syncthreads();
    float o = 0.f;
    for (int j = 0; j < nk; ++j) {
        const int krow = j < nloc ? (base + lo + j) : (cbase + j - nloc);
        o += ps[j] * bf2f(U[(size_t)krow * IN_DIM + UV + kvh * 64 + lane]);
    }
    MIX[(size_t)row * D + h * 64 + lane] = f2bf(o / sum);
}

__global__ void k_dftA(const bf16_t* __restrict__ U, float* __restrict__ P, float* __restrict__ Q) {
    __shared__ float ct[128], st[128];
    __shared__ float f[512];
    const int row = blockIdx.x, tid = threadIdx.x;
    if (tid < 128) { const float a = 6.283185307179586f * (float)tid / 128.f; ct[tid] = cosf(a); st[tid] = sinf(a); }
    f[tid] = bf2f(U[(size_t)row * IN_DIM + UF + tid]);
    __syncthreads();
    const int g = tid >> 7, cp = tid & 127;
    float p = 0.f, q = 0.f;
    for (int c = 0; c < 128; ++c) { const int k = (c * cp) & 127; const float fv = f[g * 128 + c]; p += fv * ct[k]; q += fv * st[k]; }
    P[(size_t)row * 512 + tid] = p; Q[(size_t)row * 512 + tid] = q;
}
__global__ void __launch_bounds__(256) k_dftB(const float* __restrict__ P, const float* __restrict__ Q, bf16_t* __restrict__ MIX, int T, int row0, int tabstep, int pad_) {
    __shared__ float ct[4096], st[4096];
    __shared__ float Ps[16][64], Qs[16][64];
    const int tid = threadIdx.x, tx = tid & 15, ty = tid >> 4;
    for (int i = tid; i < 4096; i += 256) { const float a = 6.283185307179586f * (float)i / 4096.f; ct[i] = cosf(a); st[i] = sinf(a); }
    const int n0 = blockIdx.x * 64, tp0 = blockIdx.y * 64, sbase = row0 + blockIdx.z * T;
    float acc[4][4];
#pragma unroll
    for (int i = 0; i < 4; ++i)
#pragma unroll
        for (int j = 0; j < 4; ++j) acc[i][j] = 0.f;
    const int lk = tid >> 4, ln = (tid & 15) * 4;
    for (int t0 = 0; t0 < T; t0 += 16) {
        __syncthreads();
        *(float4*)&Ps[lk][ln] = *(const float4*)(P + (size_t)(sbase + t0 + lk) * 512 + n0 + ln);
        *(float4*)&Qs[lk][ln] = *(const float4*)(Q + (size_t)(sbase + t0 + lk) * 512 + n0 + ln);
        __syncthreads();
#pragma unroll 4
        for (int k = 0; k < 16; ++k) {
            const float4 pv = *(const float4*)&Ps[k][tx * 4], qv = *(const float4*)&Qs[k][tx * 4];
#pragma unroll
            for (int i = 0; i < 4; ++i) {
                const int tp = tp0 + ty * 4 + i; const int idx = (((t0 + k) * tp) & (T - 1)) * tabstep;
                const float c = ct[idx], s = st[idx];
                acc[i][0] += c * pv.x - s * qv.x; acc[i][1] += c * pv.y - s * qv.y; acc[i][2] += c * pv.z - s * qv.z; acc[i][3] += c * pv.w - s * qv.w;
            }
        }
    }
    const float scale = rsqrtf((float)T * 128.f);
#pragma unroll
    for (int i = 0; i < 4; ++i) {
        const int tp = tp0 + ty * 4 + i; ushort4 o; o.x = f2bf(acc[i][0] * scale); o.y = f2bf(acc[i][1] * scale); o.z = f2bf(acc[i][2] * scale); o.w = f2bf(acc[i][3] * scale);
        *(ushort4*)(MIX + (size_t)(sbase + tp) * D + 512 + n0 + tx * 4) = o;
    }
}

__global__ void __launch_bounds__(512) k_convs(const bf16_t* __restrict__ U, const float* __restrict__ sw, const float* __restrict__ cw, const float* __restrict__ cb,
                                               const float* __restrict__ ng, const float* __restrict__ nb, bf16_t* __restrict__ MIX) {
    __shared__ float red[8];
    const int row = blockIdx.x, c = threadIdx.x;
    int base, t, len; seqinfo(row, base, t, len);
    float a = 0.f;
#pragma unroll
    for (int j = 0; j < 3; ++j) { const int tt = t + j - 1; if (tt >= 0 && tt < len) { const bf16_t* u = U + (size_t)(base + tt) * IN_DIM; a += sw[j * 512 + c] * bf2f(u[USC + c]) * bf2f(u[USV + c]); } }
    a *= bf2f(U[(size_t)row * IN_DIM + USB + c]);
    MIX[(size_t)row * D + 1024 + c] = f2bf(a);
    float z = cb[c];
    for (int j = 0; j < 31; ++j) { const int tt = t + j - 15; if (tt >= 0 && tt < len) { const bf16_t* u = U + (size_t)(base + tt) * IN_DIM; z += cw[j * 512 + c] * bf2f(u[UDA + c]) * sigmoid_f(bf2f(u[UDG + c])); } }
    const float mu = block_sum<8>(z, red) * (1.f / 512.f);
    const float dz = z - mu;
    const float var = block_sum<8>(dz * dz, red) * (1.f / 512.f);
    const float y = dz * rsqrtf(var + 1e-6f) * ng[c] + nb[c];
    MIX[(size_t)row * D + 1536 + c] = f2bf(silu_f(y));
}

__global__ void __launch_bounds__(256) k_final(const float* __restrict__ X, const float* __restrict__ g, const bf16_t* __restrict__ Y2, const float* __restrict__ modv_prev, float* __restrict__ out) {
    __shared__ float red[4];
    const int row = blockIdx.x, tid = threadIdx.x, s = modsel(row);
    const float* ga = modv_prev + (size_t)s * (NMOD * D) + 5 * D;
    float v[8];
#pragma unroll
    for (int i = 0; i < 2; ++i)
#pragma unroll
        for (int j = 0; j < 4; ++j) { const int col = i * 1024 + tid * 4 + j; v[i * 4 + j] = X[(size_t)row * D + col] + ga[col] * (bf2f(Y2[(size_t)(2 * row) * D + col]) + bf2f(Y2[(size_t)(2 * row + 1) * D + col])); }
    float ss = 0.f;
#pragma unroll
    for (int i = 0; i < 8; ++i) ss += v[i] * v[i];
    ss = block_sum<4>(ss, red);
    const float rstd = rsqrtf(ss * (1.f / D) + 1e-6f);
#pragma unroll
    for (int i = 0; i < 2; ++i) { const int col = i * 1024 + tid * 4; *(float4*)(out + (size_t)row * D + col) = make_float4(v[i * 4] * rstd * g[col], v[i * 4 + 1] * rstd * g[col + 1], v[i * 4 + 2] * rstd * g[col + 2], v[i * 4 + 3] * rstd * g[col + 3]); }
}


namespace pg8 {
#define PG8_LAS __attribute__((address_space(3)))
typedef short bf16x8 __attribute__((ext_vector_type(8)));
typedef float f32x4 __attribute__((ext_vector_type(4)));
typedef unsigned u32x4 __attribute__((ext_vector_type(4)));
typedef unsigned u32x2 __attribute__((ext_vector_type(2)));
constexpr int BM = 256, BK = 64, HALF = 128, HTB = HALF * BK * 2, STAGE_BYTES = 8 * HTB, NXCD = 8, WGM = 8;
__host__ __device__ __forceinline__ int lds_byte(int r, int c) { const int st = (r >> 4) * 2 + (c >> 5), rr = r & 15, cc = c & 31, ob = rr * 64 + cc * 2; return st * 1024 + (ob ^ (((ob >> 9) & 1) << 5)); }
__host__ __device__ __forceinline__ void stage_rc(int b, int& R, int& C) { const int st = b / 1024, sb = b % 1024, swz = sb ^ (((sb >> 9) & 1) << 5); R = (st >> 1) * 16 + swz / 64; C = (st & 1) * 32 + (swz % 64) / 2; }
__host__ __device__ __forceinline__ int perm32(int rho) { const int n = rho >> 4, i = rho & 15; return 8 * (i >> 2) + 4 * n + (i & 3); }

struct Unit { int pm, pn, grp, aux; };
struct Prob {
    const bf16_t* A; const bf16_t* Bt; int lda, ldb, K, pad;
    long long a_pm, a_grp, a_aux, b_pn, b_grp, b_aux;
    __device__ __forceinline__ const char* a_base(const Unit& u) const { return (const char*)(A + (long long)u.pm * a_pm + (long long)u.grp * a_grp + (long long)u.aux * a_aux); }
    __device__ __forceinline__ const char* b_base(const Unit& u) const { return (const char*)(Bt + (long long)u.pn * b_pn + (long long)u.grp * b_grp + (long long)u.aux * b_aux); }
};
struct StaticOrder {
    int nM, nN, nwg, G, c;
    __device__ void init(int nM_, int nN_, int G_, int c_) { nM = nM_; nN = nN_; nwg = nM * nN; G = G_; c = c_; }
    __device__ bool next(int i, Unit& u) const {
        const long L = (long)i * G + c; if (L >= nwg) return false;
        int wgid = (int)L; { const int q = nwg / NXCD, r = nwg % NXCD, xcd = wgid % NXCD, off = wgid / NXCD; wgid = (xcd < r ? xcd * (q + 1) : r * (q + 1) + (xcd - r) * q) + off; }
        const int nig = WGM * nN, gid = wgid / nig, fm = gid * WGM, gsz = (nM - fm) < WGM ? (nM - fm) : WGM;
        u.pm = fm + ((wgid % nig) % gsz); u.pn = (wgid % nig) / gsz; u.grp = 0; u.aux = 0; return true;
    }
};
struct ListSched {
    const PG8_LAS int* ul; int n;
    __device__ bool next(int i, Unit& u) const {
        if (i >= n) return false;
        u.pm = __builtin_amdgcn_readfirstlane(ul[i * 4]); u.pn = __builtin_amdgcn_readfirstlane(ul[i * 4 + 1]); u.grp = __builtin_amdgcn_readfirstlane(ul[i * 4 + 2]); u.aux = __builtin_amdgcn_readfirstlane(ul[i * 4 + 3]); return true;
    }
};
struct DftASched { int n, G, c, pad;
    __device__ bool next(int i, Unit& u) const { const int L = i * G + c; if (L >= n) return false; u.pm = 0; u.pn = L >> 2; u.grp = L & 3; u.aux = 0; return true; } };
struct DftBSched { int n, G, c, mode;
    __device__ bool next(int i, Unit& u) const { const int L = i * G + c; if (L >= n) return false;
        if (mode == 0) { const int x = L & 7, idx = L >> 3; u.aux = x & 3; u.pm = (x >> 2) * 8 + (idx & 7); u.grp = (idx >> 3) & 1; u.pn = idx >> 4; }
        else { u.grp = L >> 1; u.pn = L & 1; u.pm = 0; u.aux = 0; } return true; } };
__device__ __forceinline__ unsigned cvt_pk_bf16(float lo, float hi) { unsigned r; asm volatile("v_cvt_pk_bf16_f32 %0, %1, %2" : "=v"(r) : "v"(lo), "v"(hi)); return r; }

template <class Epi, class Sched, bool GATHER, bool ALIGN_EPI>
__device__ __forceinline__ void gemm_phase(PG8_LAS unsigned char* lds, const Prob P, const Sched& S, const Epi& E, const PG8_LAS unsigned* rows_lds) {
    int tid_ = threadIdx.x; asm volatile("" : "+v"(tid_));
    const int tid = tid_, wid = __builtin_amdgcn_readfirstlane(tid >> 6), lane = tid & 63, wr = wid >> 2, wc = wid & 3, fr = lane & 15, fq = lane >> 4;
    const int K = P.K, nt = K / BK;
    int Rr[2], Cc[2];
    unsigned voB[2], voA[2][2];
#pragma unroll
    for (int i = 0; i < 2; ++i) { int R, C; stage_rc(tid * 16 + i * 8192, R, C); Rr[i] = R; Cc[i] = C; const int Rb = Epi::PERM ? ((R & ~31) + perm32(R & 31)) : R;
        voB[i] = (unsigned)(Rb * P.ldb + C) * 2u; }
#define PG8_SETVOA(slot) do { _Pragma("unroll") for (int _h = 0; _h < 2; ++_h) _Pragma("unroll") for (int _i = 0; _i < 2; ++_i) { \
        unsigned _row = (unsigned)(_h * HALF + Rr[_i]); if (GATHER) { const unsigned _e = rows_lds[(slot) * 256 + _h * HALF + Rr[_i]]; _row = (_e == 0xFFFFFFFFu) ? 0u : (_e >> 1); } \
        voA[_h][_i] = (_row * (unsigned)P.lda + (unsigned)Cc[_i]) * 2u; } } while (0)
    const size_t kstep = (size_t)(BK * 2);
    const size_t hstepB = (size_t)HALF * P.ldb * 2;
    const unsigned ldsw = (unsigned)wid * 1024u;
    const int aoff = lds_byte(wr * 64 + fr, fq * 8), boff = lds_byte(wc * 32 + fr, fq * 8);
#define PG8_SA(b, h) (((b) * 2 + (h)) * HTB)
#define PG8_SB(b, h) ((4 + (b) * 2 + (h)) * HTB)
#define PG8_STAGE(bufoff, gbase, voff) do { _Pragma("unroll") for (int _i = 0; _i < 2; ++_i) \
        __builtin_amdgcn_global_load_lds((const unsigned*)((const char*)(gbase) + (voff)[_i]), (PG8_LAS unsigned*)(lds + (bufoff) + ldsw + _i * 8192), 16, 0, 0); } while (0)
#define PG8_LDA(dst, b, h) do { _Pragma("unroll") for (int m = 0; m < 4; ++m) _Pragma("unroll") for (int k = 0; k < 2; ++k) dst[m][k] = *(const PG8_LAS bf16x8*)(lds + PG8_SA(b, h) + aoff + m * 2048 + k * 1024); } while (0)
#define PG8_LDB(dst, b, h) do { _Pragma("unroll") for (int n = 0; n < 2; ++n) _Pragma("unroll") for (int k = 0; k < 2; ++k) dst[n][k] = *(const PG8_LAS bf16x8*)(lds + PG8_SB(b, h) + boff + n * 2048 + k * 1024); } while (0)
#define PG8_MMA(ai, bj, At, Bt) do { __builtin_amdgcn_s_setprio(1); _Pragma("unroll") for (int m = 0; m < 4; ++m) _Pragma("unroll") for (int n = 0; n < 2; ++n) _Pragma("unroll") for (int k = 0; k < 2; ++k) \
        acc[ai][bj][m][n] = __builtin_amdgcn_mfma_f32_16x16x32_bf16(Bt[n][k], At[m][k], acc[ai][bj][m][n], 0, 0, 0); __builtin_amdgcn_s_setprio(0); } while (0)
#define PG8_WAIT_V(n) asm volatile("s_waitcnt vmcnt(" #n ")" ::: "memory")
#define PG8_WAIT_L(n) asm volatile("s_waitcnt lgkmcnt(" #n ")" ::: "memory")
#define PG8_BAR __builtin_amdgcn_s_barrier()
#define PG8_SCHED __builtin_amdgcn_sched_barrier(0)
    Unit cur, nxt; int ui = 0;
    if (!S.next(0, cur)) return;
    f32x4 acc[2][2][4][2];
#pragma unroll
    for (int a = 0; a < 2; ++a)
#pragma unroll
        for (int b = 0; b < 2; ++b)
#pragma unroll
            for (int m = 0; m < 4; ++m)
#pragma unroll
                for (int n = 0; n < 2; ++n) acc[a][b][m][n] = (f32x4){0.f, 0.f, 0.f, 0.f};
    bf16x8 At[4][2], B0[2][2], B1[2][2];
    const char* cA = P.a_base(cur); const char* cB = P.b_base(cur);
    PG8_SETVOA(0);
    PG8_STAGE(PG8_SB(0, 0), cB, voB); PG8_STAGE(PG8_SB(0, 1), cB + hstepB, voB); PG8_STAGE(PG8_SA(0, 0), cA, voA[0]); PG8_STAGE(PG8_SA(0, 1), cA, voA[1]);
    if (wr == 1) PG8_BAR;
    PG8_WAIT_V(2); PG8_BAR;
    PG8_STAGE(PG8_SB(1, 0), cB + kstep, voB); PG8_STAGE(PG8_SA(1, 0), cA + kstep, voA[0]); PG8_STAGE(PG8_SB(1, 1), cB + hstepB + kstep, voB);
    PG8_WAIT_V(6); PG8_BAR;
    for (;;) {
        const bool has_next = S.next(ui + 1, nxt);
        const char* nA = has_next ? P.a_base(nxt) : cA; const char* nB = has_next ? P.b_base(nxt) : cB;
        for (int t = 0; t < nt; t += 2) {
            const bool last = (t == nt - 2);
            const char* a1 = cA + (size_t)(t + 1) * kstep;
            const char* a2 = last ? nA : cA + (size_t)(t + 2) * kstep; const char* b2 = last ? nB : cB + (size_t)(t + 2) * kstep;
            const char* a3 = a2 + kstep; const char* b3 = b2 + kstep;
            PG8_LDB(B0, 0, 0); PG8_LDB(B1, 0, 1); PG8_SCHED; PG8_LDA(At, 0, 0); PG8_STAGE(PG8_SA(1, 1), a1, voA[1]);
            PG8_WAIT_V(8); PG8_WAIT_L(0); PG8_BAR; PG8_MMA(0, 0, At, B0); PG8_MMA(0, 1, At, B1); PG8_BAR; PG8_SCHED;
            if (GATHER) { if (last && has_next) { PG8_SETVOA(ui + 1); } }
            PG8_LDA(At, 0, 1); PG8_STAGE(PG8_SB(0, 0), b2, voB); PG8_STAGE(PG8_SB(0, 1), b2 + hstepB, voB); PG8_STAGE(PG8_SA(0, 0), a2, voA[0]);
            PG8_WAIT_V(8); PG8_WAIT_L(0); PG8_BAR; PG8_MMA(1, 0, At, B0); PG8_MMA(1, 1, At, B1); PG8_BAR; PG8_SCHED;
            PG8_LDB(B0, 1, 0); PG8_LDB(B1, 1, 1); PG8_SCHED; PG8_LDA(At, 1, 0); PG8_STAGE(PG8_SA(0, 1), a2, voA[1]);
            PG8_WAIT_V(8); PG8_WAIT_L(0); PG8_BAR; PG8_MMA(0, 0, At, B0); PG8_MMA(0, 1, At, B1); PG8_BAR; PG8_SCHED;
            PG8_LDA(At, 1, 1); PG8_STAGE(PG8_SB(1, 0), b3, voB); PG8_STAGE(PG8_SB(1, 1), b3 + hstepB, voB); PG8_STAGE(PG8_SA(1, 0), a3, voA[0]);
            PG8_WAIT_V(8); PG8_WAIT_L(0); PG8_BAR; PG8_MMA(1, 0, At, B0); PG8_MMA(1, 1, At, B1); PG8_BAR; PG8_SCHED;
        }
        if constexpr (ALIGN_EPI) { if (wr == 0) PG8_BAR; }
        E(acc, cur, ui, wr, wc, fr, fq);
        if (!has_next) break;
#pragma unroll
        for (int a = 0; a < 2; ++a)
#pragma unroll
            for (int b = 0; b < 2; ++b)
#pragma unroll
                for (int m = 0; m < 4; ++m)
#pragma unroll
                    for (int n = 0; n < 2; ++n) acc[a][b][m][n] = (f32x4){0.f, 0.f, 0.f, 0.f};
        cur = nxt; cA = nA; cB = nB; ++ui;
        if constexpr (ALIGN_EPI) { if (wr == 1) PG8_BAR; }
    }
    PG8_WAIT_V(0);
    if constexpr (!ALIGN_EPI) { if (wr == 0) PG8_BAR; }
    PG8_BAR;
#undef PG8_SETVOA
#undef PG8_SA
#undef PG8_SB
#undef PG8_STAGE
#undef PG8_LDA
#undef PG8_LDB
#undef PG8_MMA
#undef PG8_WAIT_V
#undef PG8_WAIT_L
#undef PG8_BAR
#undef PG8_SCHED
}

struct EpiG1 {
    static constexpr bool PERM = true;
    bf16_t* U; const PG8_LAS float* rope;
    __device__ __forceinline__ void operator()(const f32x4 (&acc)[2][2][4][2], const Unit& u, int ui, int wr, int wc, int fr, int fq) const {
        const int row0 = u.pm * BM + wr * 64 + fr, colt = u.pn * BM, col0 = colt + wc * 32 + 8 * fq;
        const bool latent = u.pm < 32;
        const int axis = wc & 1; const float sgn = fq < 2 ? -1.f : 1.f;
#pragma unroll
        for (int ai = 0; ai < 2; ++ai)
#pragma unroll
            for (int m = 0; m < 4; ++m) {
                const int row = row0 + ai * HALF + m * 16;
                bf16_t* rowp = U + (size_t)row * IN_DIM + col0;
                const int t = row & (SEQ - 1); const int pos = axis ? (t & 63) : (t >> 6);
                const PG8_LAS f32x4* tp = (const PG8_LAS f32x4*)(rope + (pos * 16 + 8 * (fq & 1)) * 2);
#pragma unroll
                for (int bj = 0; bj < 2; ++bj) {
                    const int cb = colt + bj * HALF;
                    f32x4 v0 = acc[ai][bj][m][0], v1 = acc[ai][bj][m][1];
                    if (cb < 640) {
                        if (latent) {
                            const f32x4 t0 = tp[0], t1 = tp[1], t2 = tp[2], t3 = tp[3];
                            f32x4 p0, p1;
                            p0[0] = __shfl_xor(v0[0], 32); p0[1] = __shfl_xor(v0[1], 32); p0[2] = __shfl_xor(v0[2], 32); p0[3] = __shfl_xor(v0[3], 32);
                            p1[0] = __shfl_xor(v1[0], 32); p1[1] = __shfl_xor(v1[1], 32); p1[2] = __shfl_xor(v1[2], 32); p1[3] = __shfl_xor(v1[3], 32);
                            v0[0] = v0[0] * t0[0] + sgn * p0[0] * t0[1]; v0[1] = v0[1] * t0[2] + sgn * p0[1] * t0[3];
                            v0[2] = v0[2] * t1[0] + sgn * p0[2] * t1[1]; v0[3] = v0[3] * t1[2] + sgn * p0[3] * t1[3];
                            v1[0] = v1[0] * t2[0] + sgn * p1[0] * t2[1]; v1[1] = v1[1] * t2[2] + sgn * p1[1] * t2[3];
                            v1[2] = v1[2] * t3[0] + sgn * p1[2] * t3[1]; v1[3] = v1[3] * t3[2] + sgn * p1[3] * t3[3];
                        }
                        if (cb < 512) { float qs = QSCALE; asm volatile("" : "+v"(qs)); v0 = v0 * qs; v1 = v1 * qs; }
                    }
                    u32x4 w; w.x = cvt_pk_bf16(v0[0], v0[1]); w.y = cvt_pk_bf16(v0[2], v0[3]); w.z = cvt_pk_bf16(v1[0], v1[1]); w.w = cvt_pk_bf16(v1[2], v1[3]);
                    *(u32x4*)(rowp + bj * HALF) = w;
                }
            }
    }
};
struct EpiG2 {
    static constexpr bool PERM = false;
    float* X; const float* base_lat; const float* base_ctx; const float* modv_l;
    __device__ __forceinline__ void operator()(const f32x4 (&acc)[2][2][4][2], const Unit& u, int ui, int wr, int wc, int fr, int fq) const {
        const int s = u.pm < 16 ? 0 : (u.pm < 32 ? 1 : 2);
        const float* ga = modv_l + (size_t)s * (NMOD * D) + 2 * D;
        const int col0 = u.pn * BM + wc * 32 + 4 * fq;
        f32x4 gv[2][2];
#pragma unroll
        for (int bj = 0; bj < 2; ++bj)
#pragma unroll
            for (int n = 0; n < 2; ++n) gv[bj][n] = *(const f32x4*)(ga + col0 + bj * HALF + n * 16);
#pragma unroll
        for (int ai = 0; ai < 2; ++ai) {
            f32x4 bv[4][2][2];
#pragma unroll
            for (int m = 0; m < 4; ++m) {
                const int row = u.pm * BM + ai * HALF + wr * 64 + m * 16 + fr;
                const float* bp = (u.pm < 32 ? base_lat + (size_t)row * D : base_ctx + (size_t)(row - MLAT) * D) + col0;
#pragma unroll
                for (int bj = 0; bj < 2; ++bj)
#pragma unroll
                    for (int n = 0; n < 2; ++n) bv[m][bj][n] = *(const f32x4*)(bp + bj * HALF + n * 16);
            }
            asm volatile("" ::: "memory");
#pragma unroll
            for (int m = 0; m < 4; ++m) {
                const int row = u.pm * BM + ai * HALF + wr * 64 + m * 16 + fr;
                float* xp = X + (size_t)row * D + col0;
#pragma unroll
                for (int bj = 0; bj < 2; ++bj)
#pragma unroll
                    for (int n = 0; n < 2; ++n) *(f32x4*)(xp + bj * HALF + n * 16) = bv[m][bj][n] + gv[bj][n] * acc[ai][bj][m][n];
            }
            asm volatile("" ::: "memory");
        }
    }
};
struct EpiMoeUp {
    static constexpr bool PERM = true;
    bf16_t* Hid; const float* tok_w; const PG8_LAS unsigned* rows_lds;
    __device__ __forceinline__ void operator()(const f32x4 (&acc)[2][2][4][2], const Unit& u, int ui, int wr, int wc, int fr, int fq) const {
        const int col0 = u.pn * HALF + wc * 32 + 8 * fq;
        float wv[2][4];
#pragma unroll
        for (int ai = 0; ai < 2; ++ai)
#pragma unroll
            for (int m = 0; m < 4; ++m) { const unsigned ent = rows_lds[ui * 256 + ai * HALF + wr * 64 + m * 16 + fr]; wv[ai][m] = (ent == 0xFFFFFFFFu) ? 0.f : tok_w[ent]; }
        asm volatile("" ::: "memory");
#pragma unroll
        for (int ai = 0; ai < 2; ++ai)
#pragma unroll
            for (int m = 0; m < 4; ++m) {
                const int r = ai * HALF + wr * 64 + m * 16 + fr;
                const float w = wv[ai][m];
                const f32x4 g0 = acc[ai][0][m][0], g1 = acc[ai][0][m][1], u0 = acc[ai][1][m][0], u1 = acc[ai][1][m][1];
                float h[8];
#pragma unroll
                for (int j = 0; j < 4; ++j) { h[j] = silu_f(g0[j]) * u0[j] * w; h[4 + j] = silu_f(g1[j]) * u1[j] * w; }
                u32x4 o; o.x = cvt_pk_bf16(h[0], h[1]); o.y = cvt_pk_bf16(h[2], h[3]); o.z = cvt_pk_bf16(h[4], h[5]); o.w = cvt_pk_bf16(h[6], h[7]);
                *(u32x4*)(Hid + (size_t)(u.pm * BM + r) * DEXP + col0) = o;
            }
    }
};
struct EpiMoeDown {
    static constexpr bool PERM = true;
    bf16_t* Y2; const PG8_LAS unsigned* rows_lds;
    __device__ __forceinline__ void operator()(const f32x4 (&acc)[2][2][4][2], const Unit& u, int ui, int wr, int wc, int fr, int fq) const {
        const int col0 = u.pn * BM + wc * 32 + 8 * fq;
#pragma unroll
        for (int ai = 0; ai < 2; ++ai)
#pragma unroll
            for (int m = 0; m < 4; ++m) {
                const int r = ai * HALF + wr * 64 + m * 16 + fr;
                const unsigned ent = rows_lds[ui * 256 + r];
                if (ent != 0xFFFFFFFFu) {
                    bf16_t* yp = Y2 + (size_t)ent * D + col0;
#pragma unroll
                    for (int bj = 0; bj < 2; ++bj) { const f32x4 v0 = acc[ai][bj][m][0], v1 = acc[ai][bj][m][1];
                        u32x4 o; o.x = cvt_pk_bf16(v0[0], v0[1]); o.y = cvt_pk_bf16(v0[2], v0[3]); o.z = cvt_pk_bf16(v1[0], v1[1]); o.w = cvt_pk_bf16(v1[2], v1[3]);
                        *(u32x4*)(yp + bj * HALF) = o; }
                }
            }
    }
};
struct EpiDftA {
    static constexpr bool PERM = false;
    bf16_t* PQt; bf16_t* PQtc;
    __device__ __forceinline__ void operator()(const f32x4 (&acc)[2][2][4][2], const Unit& u, int ui, int wr, int wc, int fr, int fq) const {
        const int g = u.grp;
#pragma unroll
        for (int ai = 0; ai < 2; ++ai)
#pragma unroll
            for (int m = 0; m < 4; ++m) {
                const int cq = wr * 64 + m * 16 + fr;
                bf16_t* dst;
                if (u.pn < 32) { const int b = u.pn >> 4; dst = PQt + ((size_t)(b * 512 + g * 128 + cq) * (2 * SEQ) + (size_t)ai * SEQ + (size_t)(u.pn & 15) * BM); }
                else { const int b = u.pn - 32; dst = PQtc + ((size_t)(b * 512 + g * 128 + cq) * (2 * CTXL) + (size_t)ai * CTXL); }
#pragma unroll
                for (int bj = 0; bj < 2; ++bj)
#pragma unroll
                    for (int n = 0; n < 2; ++n) { const f32x4 v = acc[ai][bj][m][n]; u32x2 o; o.x = cvt_pk_bf16(v[0], v[1]); o.y = cvt_pk_bf16(v[2], v[3]);
                        *(u32x2*)(dst + bj * HALF + wc * 32 + n * 16 + 4 * fq) = o; }
            }
    }
};
struct EpiDftB {
    static constexpr bool PERM = false;
    float* PART; int row_base; int pad;
    long long seq_rows;
    __device__ __forceinline__ void operator()(const f32x4 (&acc)[2][2][4][2], const Unit& u, int ui, int wr, int wc, int fr, int fq) const {
        const int col0 = u.pn * BM + wc * 32 + 4 * fq;
#pragma unroll
        for (int ai = 0; ai < 2; ++ai)
#pragma unroll
            for (int m = 0; m < 4; ++m) {
                const int row = row_base + u.grp * (int)seq_rows + u.pm * BM + ai * HALF + wr * 64 + m * 16 + fr;
                float* pp = PART + ((size_t)u.aux * MROWS + row) * 512 + col0;
#pragma unroll
                for (int bj = 0; bj < 2; ++bj)
#pragma unroll
                    for (int n = 0; n < 2; ++n) *(f32x4*)(pp + bj * HALF + n * 16) = acc[ai][bj][m][n];
            }
    }
};
}


namespace att {
typedef short bf16x8 __attribute__((ext_vector_type(8)));
typedef short s16x4 __attribute__((ext_vector_type(4)));
typedef float f32x16 __attribute__((ext_vector_type(16)));
typedef unsigned u32x4 __attribute__((ext_vector_type(4)));
typedef unsigned u32x2 __attribute__((ext_vector_type(2)));
typedef short v4i16_t __attribute__((ext_vector_type(4)));
typedef __attribute__((address_space(3))) const unsigned char* lds_cptr;
__device__ __forceinline__ int crow(int r, int hi) { return (r & 3) + 8 * (r >> 2) + 4 * hi; }
__device__ __forceinline__ s16x4 vtr(lds_cptr p) { return __builtin_bit_cast(s16x4, __builtin_amdgcn_ds_read_tr16_b64_v4i16((__attribute__((address_space(3))) v4i16_t*)p)); }
__device__ __forceinline__ unsigned cvtpk(float lo, float hi) { unsigned r; asm volatile("v_cvt_pk_bf16_f32 %0, %1, %2" : "=v"(r) : "v"(lo), "v"(hi)); return r; }

__device__ __forceinline__ void attn_unit(__attribute__((address_space(3))) unsigned char* lds, const bf16_t* __restrict__ Ub, bf16_t* __restrict__ MIXb, const float* __restrict__ sink, int unit, int tid_in) {
    int tid = tid_in; asm volatile("" : "+v"(tid));
    const int lane = tid & 63, r32 = lane & 31, hi = lane >> 5; const int wid = __builtin_amdgcn_readfirstlane(tid >> 6);
    const bool latent = unit < 256;
    int b, kvh, p0;
    if (latent) { b = unit >> 7; kvh = (unit >> 6) & 1; p0 = (unit & 63) * 64; } else { const int u2 = unit - 256; b = u2 >> 3; kvh = (u2 >> 2) & 1; p0 = (u2 & 3) * 64; }
    const int g = wid >> 1, ph = wid & 1, head = kvh * 4 + g;
    const int qrow = (latent ? b * SEQ + p0 : MLAT + b * CTXL + p0) + 32 * ph + r32;
    bf16x8 qr[4];
#pragma unroll
    for (int d0 = 0; d0 < 4; ++d0) qr[d0] = *(const bf16x8*)(Ub + (size_t)qrow * IN_DIM + UQ + head * 64 + 16 * d0 + 8 * hi);
    const int jlo = latent ? (p0 >= 128 ? 0 : (p0 == 64 ? 1 : 2)) : 0;
    const int jhi = latent ? min(4, (4160 - p0) >> 6) : -1;
    const int nloc = latent ? (jhi - jlo + 1) : 0, ntl = nloc + 4;
    const int kkey = lane, kc = wid;
    const int vkey = 16 * (wid & 3) + (lane >> 2), vd = 32 * (wid >> 2) + 8 * (lane & 3);
    const bf16_t* kcol = Ub + UK + kvh * 64 + 8 * kc; const bf16_t* vcol = Ub + UV + kvh * 64 + vd;
#define ATT_KROW0(t) (((t) < nloc) ? (b * SEQ + p0 - 128 + 64 * (jlo + (t))) : (MLAT + b * CTXL + 64 * ((t) - nloc)))
    u32x4 kreg, vreg;
    { const int kr0 = ATT_KROW0(0); kreg = *(const u32x4*)(kcol + (size_t)(kr0 + kkey) * IN_DIM); vreg = *(const u32x4*)(vcol + (size_t)(kr0 + vkey) * IN_DIM); }
    *(__attribute__((address_space(3))) u32x4*)(lds + tid * 16) = kreg; *(__attribute__((address_space(3))) u32x4*)(lds + 16384 + tid * 16) = vreg;
    const float sk2 = sink[head] * LOG2E;
    float m = sk2, l = (hi == 0) ? 1.f : 0.f;
    f32x16 o[2]; o[0] = f32x16{}; o[1] = f32x16{};
    __syncthreads();
    for (int t = 0; t < ntl; ++t) {
        const int slot = (t & 1) * 8192;
        const bool more = (t + 1 < ntl);
        if (more) { const int kr0 = ATT_KROW0(t + 1); kreg = *(const u32x4*)(kcol + (size_t)(kr0 + kkey) * IN_DIM); vreg = *(const u32x4*)(vcol + (size_t)(kr0 + vkey) * IN_DIM); }
        f32x16 s0 = f32x16{}, s1 = f32x16{};
        { const lds_cptr kb = (lds_cptr)lds + slot + hi * 1024 + r32 * 16;
#pragma unroll
          for (int d0 = 0; d0 < 4; ++d0) { const bf16x8 b0 = *(const __attribute__((address_space(3))) bf16x8*)(kb + d0 * 2048); const bf16x8 b1 = *(const __attribute__((address_space(3))) bf16x8*)(kb + d0 * 2048 + 512);
              s0 = __builtin_amdgcn_mfma_f32_32x32x16_bf16(b0, qr[d0], s0, 0, 0, 0); s1 = __builtin_amdgcn_mfma_f32_32x32x16_bf16(b1, qr[d0], s1, 0, 0, 0); } }
        if (t < nloc) {
            const int rel0 = 64 * (jlo + t) - 128 - 32 * ph - r32 + 4 * hi;
#pragma unroll
            for (int r = 0; r < 16; ++r) { const int rel = rel0 + (r & 3) + 8 * (r >> 2); if (rel < -128 || rel > 128) s0[r] = -1e30f; if (rel + 32 < -128 || rel + 32 > 128) s1[r] = -1e30f; }
        }
        float tm = fmaxf(s0[0], s1[0]);
#pragma unroll
        for (int r = 1; r < 16; ++r) tm = fmaxf(tm, fmaxf(s0[r], s1[r]));
        tm = fmaxf(tm, __shfl_xor(tm, 32));
        const float mn = fmaxf(m, tm), alpha = exp2f(m - mn); m = mn;
        float ps = 0.f;
#pragma unroll
        for (int r = 0; r < 16; ++r) { s0[r] = exp2f(s0[r] - mn); s1[r] = exp2f(s1[r] - mn); ps += s0[r] + s1[r]; }
        l = l * alpha + ps;
#pragma unroll
        for (int r = 0; r < 16; ++r) { o[0][r] *= alpha; o[1][r] *= alpha; }
        u32x4 pw[4];
#pragma unroll
        for (int q = 0; q < 4; ++q) { pw[0][q] = cvtpk(s0[2 * q], s0[2 * q + 1]); pw[1][q] = cvtpk(s0[8 + 2 * q], s0[8 + 2 * q + 1]); pw[2][q] = cvtpk(s1[2 * q], s1[2 * q + 1]); pw[3][q] = cvtpk(s1[8 + 2 * q], s1[8 + 2 * q + 1]); }
        { const lds_cptr vp = (lds_cptr)lds + 16384 + slot + ((lane >> 4) & 1) * 32 + (lane & 3) * 8 + (4 * hi + ((lane & 15) >> 2)) * 64;
#pragma unroll
          for (int d0 = 0; d0 < 2; ++d0)
#pragma unroll
            for (int ks = 0; ks < 4; ++ks) { const s16x4 lo = vtr(vp + d0 * 4096 + ks * 1024), hh = vtr(vp + d0 * 4096 + ks * 1024 + 512);
                const bf16x8 vf = (bf16x8){lo[0], lo[1], lo[2], lo[3], hh[0], hh[1], hh[2], hh[3]};
                o[d0] = __builtin_amdgcn_mfma_f32_32x32x16_bf16(vf, __builtin_bit_cast(bf16x8, pw[ks]), o[d0], 0, 0, 0); } }
        if (more) { const int ns = ((t + 1) & 1) * 8192; *(__attribute__((address_space(3))) u32x4*)(lds + ns + tid * 16) = kreg; *(__attribute__((address_space(3))) u32x4*)(lds + 16384 + ns + tid * 16) = vreg; }
        __syncthreads();
    }
#undef ATT_KROW0
    l += __shfl_xor(l, 32);
    const float inv = 1.f / l;
    bf16_t* op = MIXb + (size_t)qrow * D + head * 64 + 4 * hi;
#pragma unroll
    for (int d0 = 0; d0 < 2; ++d0)
#pragma unroll
        for (int g4 = 0; g4 < 4; ++g4) { u32x2 w; w.x = cvtpk(o[d0][4 * g4] * inv, o[d0][4 * g4 + 1] * inv); w.y = cvtpk(o[d0][4 * g4 + 2] * inv, o[d0][4 * g4 + 3] * inv);
            *(u32x2*)(op + 32 * d0 + 8 * g4) = w; }
}
}

constexpr int CONV_W_OFF = 65536;
using pg8::f32x4;
__device__ __forceinline__ void unpack8(const pg8::u32x4 p, float (&f)[8]) {
#pragma unroll
    for (int q = 0; q < 4; ++q) { f[2 * q] = __uint_as_float(p[q] << 16); f[2 * q + 1] = __uint_as_float(p[q] & 0xffff0000u); }
}
__device__ __forceinline__ void conv_fill_w(__attribute__((address_space(3))) unsigned char* lds, const float* __restrict__ cw, int tid) {
    __attribute__((address_space(3))) f32x4* wl = (__attribute__((address_space(3))) f32x4*)(lds + CONV_W_OFF);
    for (int e = tid; e < 31 * 128; e += 512) wl[e] = *(const f32x4*)(cw + (size_t)e * 4);
}
__device__ __forceinline__ void conv_tile(__attribute__((address_space(3))) unsigned char* lds, const bf16_t* __restrict__ Ub, bf16_t* __restrict__ MIXb, const float* __restrict__ sw,
                                          const float* __restrict__ cb, const float* __restrict__ ng, const float* __restrict__ nb, int tile, int tid_in) {
    typedef pg8::u32x4 u32x4;
    int tid = tid_in; asm volatile("" : "+v"(tid));
    const int lane = tid & 63, w = tid >> 6, c8 = 8 * lane;
    int base, t0, len;
    if (tile < 256) { base = (tile >> 7) * SEQ; t0 = (tile & 127) * 32; len = SEQ; } else { const int u2 = tile - 256; base = MLAT + (u2 >> 3) * CTXL; t0 = (u2 & 7) * 32; len = CTXL; }
#pragma unroll 2
    for (int q = 0; q < 8; ++q) {
        const int it = tid + 512 * q;
        if (it < 62 * 64) {
            const int tok = it >> 6, cg = (it & 63) * 8; const int tt = t0 - 15 + tok;
            u32x4 o = (u32x4){0u, 0u, 0u, 0u};
            if (tt >= 0 && tt < len) {
                const bf16_t* u = Ub + (size_t)(base + tt) * IN_DIM;
                const u32x4 a = *(const u32x4*)(u + UDA + cg), g = *(const u32x4*)(u + UDG + cg);
                float fa[8], fg[8]; unpack8(a, fa); unpack8(g, fg);
#pragma unroll
                for (int e = 0; e < 4; ++e) o[e] = pg8::cvt_pk_bf16(fa[2 * e] * sigmoid_f(fg[2 * e]), fa[2 * e + 1] * sigmoid_f(fg[2 * e + 1]));
            }
            *(__attribute__((address_space(3))) u32x4*)(lds + (size_t)(tok * 512 + cg) * 2) = o;
        }
    }
    asm volatile("" ::: "memory"); __builtin_amdgcn_sched_barrier(0);
    {
        float v[6][8];
#pragma unroll
        for (int k = 0; k < 6; ++k) { const int tt = t0 + 4 * w - 1 + k;
            if (tt >= 0 && tt < len) { const bf16_t* u = Ub + (size_t)(base + tt) * IN_DIM; float a[8], b[8]; unpack8(*(const u32x4*)(u + USC + c8), a); unpack8(*(const u32x4*)(u + USV + c8), b);
#pragma unroll
                for (int e = 0; e < 8; ++e) v[k][e] = a[e] * b[e]; }
            else {
#pragma unroll
                for (int e = 0; e < 8; ++e) v[k][e] = 0.f; } }
        float w0[8], w1[8], w2[8];
#pragma unroll
        for (int h2 = 0; h2 < 2; ++h2) { const f32x4 a = *(const f32x4*)(sw + c8 + 4 * h2), b = *(const f32x4*)(sw + 512 + c8 + 4 * h2), cc = *(const f32x4*)(sw + 1024 + c8 + 4 * h2);
#pragma unroll
            for (int e = 0; e < 4; ++e) { w0[4 * h2 + e] = a[e]; w1[4 * h2 + e] = b[e]; w2[4 * h2 + e] = cc[e]; } }
#pragma unroll
        for (int i = 0; i < 4; ++i) { const size_t row = (size_t)(base + t0 + 4 * w + i); float sb[8]; unpack8(*(const u32x4*)(Ub + row * IN_DIM + USB + c8), sb);
            u32x4 o;
#pragma unroll
            for (int e = 0; e < 4; ++e) o[e] = pg8::cvt_pk_bf16(sb[2 * e] * (w0[2 * e] * v[i][2 * e] + w1[2 * e] * v[i + 1][2 * e] + w2[2 * e] * v[i + 2][2 * e]),
                                                          sb[2 * e + 1] * (w0[2 * e + 1] * v[i][2 * e + 1] + w1[2 * e + 1] * v[i + 1][2 * e + 1] + w2[2 * e + 1] * v[i + 2][2 * e + 1]));
            *(u32x4*)(MIXb + row * D + 1024 + c8) = o; }
    }
    asm volatile("" ::: "memory"); __builtin_amdgcn_sched_barrier(0);
    __syncthreads();
    float z[4][8];
    {
        const f32x4 b0 = *(const f32x4*)(cb + c8), b1 = *(const f32x4*)(cb + c8 + 4);
#pragma unroll
        for (int i = 0; i < 4; ++i)
#pragma unroll
            for (int e = 0; e < 4; ++e) { z[i][e] = b0[e]; z[i][4 + e] = b1[e]; }
        float wq[4][8];
        const __attribute__((address_space(3))) f32x4* wl = (const __attribute__((address_space(3))) f32x4*)(lds + CONV_W_OFF);
#pragma unroll 1
        for (int ko = 0; ko < 9; ++ko) {
#pragma unroll
            for (int ki = 0; ki < 4; ++ki) {
                const int k = 4 * ko + ki;
                if (k < 34) {
                    if (k < 31) { const f32x4 a = wl[k * 128 + 2 * lane], b = wl[k * 128 + 2 * lane + 1];
#pragma unroll
                        for (int e = 0; e < 4; ++e) { wq[ki][e] = a[e]; wq[ki][4 + e] = b[e]; } }
                    float g[8]; unpack8(*(const __attribute__((address_space(3))) u32x4*)(lds + (size_t)((4 * w + k) * 512 + c8) * 2), g);
#pragma unroll
                    for (int i = 0; i < 4; ++i) { const int j = k - i; if (j >= 0 && j < 31) {
#pragma unroll
                        for (int e = 0; e < 8; ++e) z[i][e] += wq[(ki - i) & 3][e] * g[e]; } }
                }
            }
        }
    }
    {
        float gg[8], bb[8];
        { const f32x4 a = *(const f32x4*)(ng + c8), b = *(const f32x4*)(ng + c8 + 4), cc = *(const f32x4*)(nb + c8), d = *(const f32x4*)(nb + c8 + 4);
#pragma unroll
          for (int e = 0; e < 4; ++e) { gg[e] = a[e]; gg[4 + e] = b[e]; bb[e] = cc[e]; bb[4 + e] = d[e]; } }
#pragma unroll
        for (int i = 0; i < 4; ++i) {
            float s = 0.f;
#pragma unroll
            for (int e = 0; e < 8; ++e) s += z[i][e];
            const float mu = wave_sum(s) * (1.f / 512.f);
            float s2 = 0.f;
#pragma unroll
            for (int e = 0; e < 8; ++e) { const float d = z[i][e] - mu; s2 += d * d; }
            const float rstd = rsqrtf(wave_sum(s2) * (1.f / 512.f) + 1e-6f);
            u32x4 o;
#pragma unroll
            for (int e = 0; e < 4; ++e) { const float y0 = (z[i][2 * e] - mu) * rstd * gg[2 * e] + bb[2 * e], y1 = (z[i][2 * e + 1] - mu) * rstd * gg[2 * e + 1] + bb[2 * e + 1]; o[e] = pg8::cvt_pk_bf16(silu_f(y0), silu_f(y1)); }
            *(u32x4*)(MIXb + (size_t)(base + t0 + 4 * w + i) * D + 1536 + c8) = o;
        }
    }
    __syncthreads();
}

constexpr int NWAVES = 8;
constexpr int RING_OFF = 0, RING_BYTES = 131072;
constexpr int ROWS_OFF = 131072;
constexpr int ULIST_OFF = ROWS_OFF + 4096;
constexpr int ROPE_OFF = ULIST_OFF + 256;
constexpr int LDSCTL_OFF = ROPE_OFF + 8192, MISC_OFF = LDSCTL_OFF + 320;
constexpr int LDS_BYTES = 147456;
static_assert(MISC_OFF + 256 <= LDS_BYTES, "LDS map");

#define GAS __attribute__((address_space(1)))
#define LAS __attribute__((address_space(3)))
typedef unsigned v4u __attribute__((ext_vector_type(4)));
typedef GAS unsigned gu32;
#define RLX_AGENT __ATOMIC_RELAXED, __HIP_MEMORY_SCOPE_AGENT
#define LDS_WAIT() asm volatile("s_waitcnt lgkmcnt(0)" ::: "memory")
#define VM_WAIT() asm volatile("s_waitcnt vmcnt(0)" ::: "memory")
__device__ __forceinline__ unsigned pk2(float lo, float hi) { return (unsigned)f2bf(lo) | ((unsigned)f2bf(hi) << 16); }

#define XB_TMO      128
#define XB_XCNT(j)  (256  + 64 * (j))
#define XB_XSUB(j)  (1280 + 64 * (j))
#define XB_XGEN(j)  (2304 + 64 * (j))
#define XB_TOP      3328
#define XB_TOPGEN   3392
#define XCD_BAR_WORDS 3456
#define XB_SPIN_CAP (1u << 20)
__device__ __forceinline__ unsigned xb_ld(unsigned* p)              { return __hip_atomic_load(p, __ATOMIC_RELAXED, __HIP_MEMORY_SCOPE_AGENT); }
__device__ __forceinline__ unsigned xb_add(unsigned* p, unsigned v) { return __hip_atomic_fetch_add(p, v, __ATOMIC_RELAXED, __HIP_MEMORY_SCOPE_AGENT); }
__device__ __forceinline__ unsigned xb_xcc_id() { return (unsigned)__builtin_amdgcn_s_getreg((3 << 11) | 20) & 0xFu; }
#define XB_SPIN(cond, bar) do { unsigned _sp = 0; while (cond) { __builtin_amdgcn_s_sleep(1); \
    if ((++_sp & 255u) == 0u) { if (xb_ld(&(bar)[XB_TMO])) break; if (_sp > XB_SPIN_CAP) { atomicAdd(&(bar)[XB_TMO], 1u); break; } } } } while (0)
struct XcdBarrier { unsigned* bar; unsigned x; volatile LAS unsigned* st; };
__device__ __forceinline__ XcdBarrier xcd_barrier_post(unsigned* bar, volatile LAS unsigned* st) {
    XcdBarrier b; b.bar = bar; b.x = xb_xcc_id(); b.st = st;
    if (threadIdx.x == 0) (void)xb_add(&bar[XB_XCNT(b.x)], 1u);
    return b;
}
__device__ __forceinline__ void xcd_barrier_complete(unsigned* bar, unsigned x, unsigned& nloc, unsigned& nx) {
    const unsigned G = gridDim.x * gridDim.y * gridDim.z;
    unsigned sum, cnt, mine, sp = 0u;
    for (;;) {
        sum = 0u; cnt = 0u; mine = 0u;
#pragma unroll
        for (unsigned j = 0; j < 16; ++j) { const unsigned c = xb_ld(&bar[XB_XCNT(j)]); sum += c; cnt += (c > 0u) ? 1u : 0u; mine = (j == x) ? c : mine; }
        if (sum == G) break;
        __builtin_amdgcn_s_sleep(1);
        if ((++sp & 255u) == 0u) { if (xb_ld(&bar[XB_TMO])) break; if (sp > XB_SPIN_CAP) { atomicAdd(&bar[XB_TMO], 1u); break; } }
    }
    nloc = mine > 0u ? mine : 1u; nx = cnt > 0u ? cnt : 1u;
}
__device__ __forceinline__ void xcd_barrier(const XcdBarrier& b) {
    asm volatile("s_waitcnt vmcnt(0)" ::: "memory");
    __syncthreads();
    if (threadIdx.x == 0) {
        unsigned* bar = b.bar;
        __builtin_amdgcn_s_waitcnt(0);
        unsigned nloc = b.st[0], nx = b.st[1];
        if (nloc == 0u) { xcd_barrier_complete(bar, b.x, nloc, nx); b.st[0] = nloc; b.st[1] = nx; }
        const unsigned old = xb_add(&bar[XB_XSUB(b.x)], 1u);
        const unsigned gen = old / nloc;
        if (old + 1u == (gen + 1u) * nloc) {
            __builtin_amdgcn_fence(__ATOMIC_RELEASE, "agent");
            asm volatile("s_waitcnt vmcnt(0)" ::: "memory");
            const unsigned og = xb_add(&bar[XB_TOP], 1u);
            const unsigned tg = og / nx;
            if (og + 1u == (tg + 1u) * nx) xb_add(&bar[XB_TOPGEN], 1u);
            else XB_SPIN(xb_ld(&bar[XB_TOPGEN]) == tg, bar);
            __builtin_amdgcn_fence(__ATOMIC_ACQUIRE, "agent");
            xb_add(&bar[XB_XGEN(b.x)], 1u);
            asm volatile("s_waitcnt vmcnt(0)" ::: "memory");
        } else {
            XB_SPIN(xb_ld(&bar[XB_XGEN(b.x)]) == gen, bar);
            __builtin_amdgcn_fence(__ATOMIC_ACQUIRE, "agent");
            asm volatile("s_waitcnt vmcnt(0)" ::: "memory");
        }
    }
    __syncthreads();
}

constexpr size_t WM_CTL = 0;
constexpr int CW_BAR = 4096;
constexpr size_t WM_WIN = 352 * MiB;
constexpr size_t WM_WOUT = 384 * MiB;
constexpr size_t WM_WGU = 400 * MiB;
constexpr size_t WM_WDN = 528 * MiB;
constexpr size_t WM_CS = 592 * MiB;
constexpr size_t WM_CSC = 656 * MiB;
constexpr size_t WM_WC = 657 * MiB;
constexpr size_t WM_PQT = 658 * MiB;
constexpr size_t WM_PQTC = 674 * MiB;
constexpr size_t WM_PART = 676 * MiB;
constexpr size_t WM_HIDB = 744 * MiB;
constexpr size_t WM_END = 768 * MiB;

struct MArgs { const float* in[24]; float* out; unsigned char* ws; int ph_lo, ph_hi, layer, use_bar; };

struct Frame {
    LAS unsigned char* lds; volatile LAS unsigned* MISC; unsigned* ctl;
    int tid, lane, wave, vcu, G;
};

__device__ __forceinline__ void p0_transpose_item(const float* W, int K, int N, bf16_t* WT, int n_row_base, LAS float* scr, int item, int lane) {
    const int nblk = N / 32, kb = item / nblk, nb = item % nblk, k0 = 64 * kb, n0 = 32 * nb;
    float tv[32];
    { const float* wp = W + (size_t)(k0 + (lane >> 5)) * N + n0 + (lane & 31);
#pragma unroll
      for (int i = 0; i < 32; ++i) tv[i] = __builtin_nontemporal_load(wp + (size_t)(2 * i) * N); }
#pragma unroll
    for (int i = 0; i < 32; ++i) scr[(2 * i + (lane >> 5)) * 33 + (lane & 31)] = tv[i];
    LDS_WAIT(); asm volatile("" ::: "memory");
    const int c = lane & 7;
#pragma unroll
    for (int j = 0; j < 4; ++j) { const int n = (lane >> 3) + 8 * j; const LAS float* s = scr + (8 * c) * 33 + n;
        v4u o; o.x = pk2(s[0 * 33], s[1 * 33]); o.y = pk2(s[2 * 33], s[3 * 33]); o.z = pk2(s[4 * 33], s[5 * 33]); o.w = pk2(s[6 * 33], s[7 * 33]);
        *(v4u*)(WT + (size_t)(n_row_base + n) * K + k0 + 8 * c) = o; }
    LDS_WAIT(); asm volatile("" ::: "memory");
}

__device__ __forceinline__ unsigned char* opq(unsigned char* p) { unsigned lo = (unsigned)(uintptr_t)p, hi = (unsigned)((uintptr_t)p >> 32); asm volatile("" : "+v"(lo), "+v"(hi)); lo = __builtin_amdgcn_readfirstlane(lo); hi = __builtin_amdgcn_readfirstlane(hi); return (unsigned char*)(((uintptr_t)hi << 32) | (uintptr_t)lo); }
__device__ __forceinline__ const char* opqc(const char* p) { return (const char*)opq((unsigned char*)p); }
__device__ __forceinline__ int opqv(int v) { asm volatile("" : "+v"(v)); return v; }
#define PHASE_PROLOG unsigned char* ws = opq(args.ws); const char* ka = opqc((const char*)__builtin_amdgcn_kernarg_segment_ptr()); const int lane = opqv(F.lane), tid = opqv(F.tid); (void)ws; (void)ka; (void)lane; (void)tid
#define INP(k) (*(const float* const*)(ka + (k) * 8))

struct N2Ctx { const float* X; bf16_t* H; const float* g2; const float* modl; const float* wg; const float* we; const float* bg; const float* be; int* tok_e; float* tok_w; unsigned* cnt; unsigned* list; };
template <int NR>
__device__ __forceinline__ void n2_group(const N2Ctx& C, LAS float* wt, const int (&rows)[NR], int mrows, int lane, int tid) {
    const int l4 = lane * 4;
    f32x4 h[NR][8]; float lg[NR][20];
#pragma unroll
    for (int i = 0; i < NR; ++i) {
        const int row = rows[i]; const bool ok = row < mrows; const int rr = ok ? row : 0; const int s = modsel(rr);
        f32x4 v[8]; float ss = 0.f;
#pragma unroll
        for (int j = 0; j < 8; ++j) { v[j] = *(const f32x4*)(C.X + (size_t)rr * D + l4 + 256 * j); ss += v[j][0] * v[j][0] + v[j][1] * v[j][1] + v[j][2] * v[j][2] + v[j][3] * v[j][3]; }
        ss = wave_sum(ss);
        const float rstd = rsqrtf(ss * (1.f / D) + 1e-6f);
        const float* sh = C.modl + (size_t)s * (NMOD * D) + 3 * D; const float* sc = sh + D;
#pragma unroll
        for (int j = 0; j < 8; ++j) { const int col = l4 + 256 * j; const f32x4 g = *(const f32x4*)(C.g2 + col), a = *(const f32x4*)(sc + col), b = *(const f32x4*)(sh + col);
            h[i][j] = v[j] * rstd * g * (a + 1.f) + b;
            if (ok) { pg8::u32x2 o; o.x = pk2(h[i][j][0], h[i][j][1]); o.y = pk2(h[i][j][2], h[i][j][3]); *(pg8::u32x2*)(C.H + (size_t)row * D + col) = o; } }
#pragma unroll
        for (int q = 0; q < 20; ++q) lg[i][q] = 0.f;
    }
#pragma unroll
    for (int half = 0; half < 2; ++half) {
        __syncthreads();
#pragma unroll
        for (int cc = 0; cc < 2; ++cc) { const int c = tid + 512 * cc; const int col = 1024 * half + c;
            const f32x4 a = *(const f32x4*)(C.wg + (size_t)col * 4);
            wt[0 * 1024 + c] = a[0]; wt[1 * 1024 + c] = a[1]; wt[2 * 1024 + c] = a[2]; wt[3 * 1024 + c] = a[3];
#pragma unroll
            for (int q = 0; q < 4; ++q) { const f32x4 b = *(const f32x4*)(C.we + (size_t)col * 16 + q * 4);
                wt[(4 + 4 * q) * 1024 + c] = b[0]; wt[(5 + 4 * q) * 1024 + c] = b[1]; wt[(6 + 4 * q) * 1024 + c] = b[2]; wt[(7 + 4 * q) * 1024 + c] = b[3]; } }
        __syncthreads();
#pragma unroll
        for (int jj = 0; jj < 4; ++jj) {
#pragma unroll
            for (int q = 0; q < 20; ++q) { const f32x4 w = *(const LAS f32x4*)(wt + q * 1024 + l4 + 256 * jj);
#pragma unroll
                for (int i = 0; i < NR; ++i) { const f32x4 hv = h[i][4 * half + jj]; lg[i][q] += hv[0] * w[0] + hv[1] * w[1] + hv[2] * w[2] + hv[3] * w[3]; } }
        }
    }
#pragma unroll
    for (int i = 0; i < NR; ++i)
#pragma unroll
        for (int q = 0; q < 20; ++q) lg[i][q] = wave_sum(lg[i][q]);
    if (lane < NR) {
        int row = rows[0];
#pragma unroll
        for (int i = 1; i < NR; ++i) row = (lane == i) ? rows[i] : row;
        if (row < mrows) {
            float gl[4], el[16];
#pragma unroll
            for (int q = 0; q < 20; ++q) { float vq = lg[0][q];
#pragma unroll
                for (int i = 1; i < NR; ++i) vq = (lane == i) ? lg[i][q] : vq;
                if (q < 4) gl[q] = vq + C.bg[q]; else el[q - 4] = vq + C.be[q - 4]; }
            int gs = 0; float gm = gl[0];
#pragma unroll
            for (int q = 1; q < 4; ++q) if (gl[q] > gm) { gm = gl[q]; gs = q; }
            float den = 0.f;
#pragma unroll
            for (int q = 0; q < 4; ++q) den += __expf(gl[q] - gm);
            const float pg = 1.f / den;
            float eg[4];
#pragma unroll
            for (int q = 0; q < 4; ++q) eg[q] = gs == 0 ? el[q] : (gs == 1 ? el[4 + q] : (gs == 2 ? el[8 + q] : el[12 + q]));
            int i0 = 0; float m0 = eg[0];
#pragma unroll
            for (int q = 1; q < 4; ++q) if (eg[q] > m0) { m0 = eg[q]; i0 = q; }
            int i1 = -1; float m1 = -3.0e38f;
#pragma unroll
            for (int q = 0; q < 4; ++q) if (q != i0 && eg[q] > m1) { m1 = eg[q]; i1 = q; }
            const float w0 = 1.f / (1.f + __expf(m1 - m0)), w1 = 1.f - w0;
            const int e0 = gs * 4 + i0, e1 = gs * 4 + i1;
            C.tok_e[row * 2] = e0; C.tok_e[row * 2 + 1] = e1; C.tok_w[row * 2] = w0 * pg; C.tok_w[row * 2 + 1] = w1 * pg;
            const unsigned p0 = atomicAdd(C.cnt + e0, 1u); C.list[(size_t)e0 * (2 * MROWS) + p0] = row * 2;
            const unsigned p1 = atomicAdd(C.cnt + e1, 1u); C.list[(size_t)e1 * (2 * MROWS) + p1] = row * 2 + 1;
        }
    }
}

__global__ void __launch_bounds__(NWAVES * 64, 2) mega_fwd(MArgs args) {
    extern __shared__ __attribute__((aligned(16))) unsigned char lds_raw[];
    Frame F;
    F.lds = (LAS unsigned char*)lds_raw;
    F.MISC = (volatile LAS unsigned*)(F.lds + MISC_OFF);
    F.tid = threadIdx.x; F.lane = F.tid & 63; F.wave = __builtin_amdgcn_readfirstlane(F.tid >> 6);
    F.G = gridDim.x; { const int bx = blockIdx.x; F.vcu = (F.G % 8 == 0) ? (bx % 8) * (F.G / 8) + bx / 8 : bx; }
    F.ctl = (unsigned*)(args.ws + WM_CTL);
    for (int u = F.tid; u < (LDS_BYTES - LDSCTL_OFF) / 4; u += NWAVES * 64) ((LAS unsigned*)(F.lds + LDSCTL_OFF))[u] = 0u;
    __syncthreads();
    XcdBarrier bar; bar.bar = F.ctl + CW_BAR; bar.x = 0; bar.st = nullptr;
    if (args.use_bar) bar = xcd_barrier_post(F.ctl + CW_BAR, F.MISC + 8);
#define GRID_BAR() do { if (args.use_bar) xcd_barrier(bar); } while (0)
    const int lo = args.ph_lo, hi = args.ph_hi;
#ifdef PROBE_DUP
#define PC_OF(pi) ((pi) <= PROBE_DUP ? (pi) : (pi) - 1)
#else
#define PC_OF(pi) (pi)
#endif
    const int gw = F.vcu * NWAVES + F.wave, NGW = F.G * NWAVES;
  for (int pi = lo; pi < hi; ++pi) {
    const int pc = PC_OF(pi);
    const int l = (pc >= 11 && pc < 21) ? 1 : 0;
    const int kk = (pc == 0) ? -1 : (pc == 21 ? -2 : pc - 1 - 10 * l);
    const int mrows = (l == 1) ? MLAT : MROWS;


#define x_in INP(0)
#define c_in INP(1)
#define ctx_in INP(2)
#define c_ctx INP(3)
#define w_mod INP(4)
#define b_mod INP(5)
#define w_in INP(8)
#define w_out INP(9)
#define w_gate INP(20)
#define w_up INP(21)
#define w_down INP(22)
#define modv   ((float*)(ws + WS_MOD))
#define rope   ((float*)(ws + WS_ROPE))
#define tok_w  ((float*)(ws + WS_TOK + 128 * 1024))
#define tok_e  ((int*)(ws + WS_TOK))
#define list   ((unsigned*)(ws + WS_LIST))
#define X      ((float*)(ws + WS_X))
#define H      ((bf16_t*)(ws + WS_H))
#define U      ((bf16_t*)(ws + WS_U))
#define MIX    ((bf16_t*)(ws + WS_MIX))
#define Y2     ((bf16_t*)(ws + WS_Y2))
#define Win_t  ((bf16_t*)(ws + WM_WIN))
#define Wout_t ((bf16_t*)(ws + WM_WOUT))
#define Wgu_t  ((bf16_t*)(ws + WM_WGU))
#define Wdn_t  ((bf16_t*)(ws + WM_WDN))
#define CS     ((bf16_t*)(ws + WM_CS))
#define CSC    ((bf16_t*)(ws + WM_CSC))
#define WC     ((bf16_t*)(ws + WM_WC))
#define PQT    ((bf16_t*)(ws + WM_PQT))
#define PQTC   ((bf16_t*)(ws + WM_PQTC))
#define PART   ((float*)(ws + WM_PART))
#define HIDB   ((bf16_t*)(ws + WM_HIDB))
#define g_norm1 INP(6)
#define g_norm2 INP(7)
#define g_final INP(23)
#define w_rg INP(16)
#define b_rg INP(17)
#define w_re INP(18)
#define b_re INP(19)
    const PG8_LAS unsigned* rows_lds = (const PG8_LAS unsigned*)(F.lds + ROWS_OFF);
    LAS int* ulist = (LAS int*)(F.lds + ULIST_OFF);

    if (pc == 0) {
        PHASE_PROLOG;
        LAS float* ctab = (LAS float*)(F.lds + 67584); LAS float* stab = ctab + 4096;
        for (int i = tid; i < 4096; i += NWAVES * 64) { float s, c; sincospif((float)i * (1.f / 2048.f), &s, &c); ctab[i] = c; stab[i] = s; }
        __syncthreads();
#ifdef PROBE_P0
        for (int rep_ = 0; rep_ < (PROBE_P0 == 1 ? 2 : 1); ++rep_)
#endif
        for (int tp = F.vcu; tp < SEQ; tp += F.G) {
#pragma unroll
            for (int j = 0; j < 2; ++j) { const int k0 = (tid + 512 * j) * 8; const int part = k0 >> 12; const int kk0 = k0 & 4095;
                float v[8];
#pragma unroll
                for (int q = 0; q < 8; ++q) { const float rev = (float)((tp * (kk0 + q)) & 4095) * (1.f / 4096.f);
                    v[q] = part ? -__builtin_amdgcn_sinf(rev) : __builtin_amdgcn_cosf(rev); }
                v4u o; o.x = pk2(v[0], v[1]); o.y = pk2(v[2], v[3]); o.z = pk2(v[4], v[5]); o.w = pk2(v[6], v[7]);
                *(v4u*)(CS + (size_t)tp * (2 * SEQ) + k0) = o; }
        }
        if (F.vcu == 1 % F.G) {
            for (int e = tid; e < 256 * 256; e += NWAVES * 64) { const int r = e >> 8, c = e & 255; const int part = r >> 7, cq = r & 127; float v = 0.f;
                if (c < 128) { const int idx = ((c * cq) & 127) * 32; v = part ? stab[idx] : ctab[idx]; } WC[e] = f2bf(v); }
        }
        if (F.vcu == 2 % F.G) {
            for (int e = tid; e < 256 * 512; e += NWAVES * 64) { const int tp = e >> 9, k = e & 511; const int part = k >> 8; const int idx = ((tp * (k & 255)) & 255) * 16;
                CSC[e] = f2bf(part ? -stab[idx] : ctab[idx]); }
        }
        if (F.vcu == 3 % F.G) {
            for (int e = tid; e < 64 * 16; e += NWAVES * 64) { const int pos = e >> 4, i = e & 15; const float freq = powf(10000.f, -(float)(2 * i) / 32.f); const float ang = (float)pos * freq;
                rope[e * 2] = cosf(ang); rope[e * 2 + 1] = sinf(ang); }
        }
        __syncthreads();
        {
            LAS float* sl = (LAS float*)(F.lds + 67584 + 32768 + 9216);
            for (int e = tid; e < 3 * D; e += NWAVES * 64) { const int sidx = e / D, k = e % D; sl[e] = silu_f(sidx == 0 ? c_in[k] : (sidx == 1 ? c_in[D + k] : c_ctx[k])); }
            __syncthreads();
#ifdef PROBE_P0
            for (int rep_ = 0; rep_ < (PROBE_P0 == 2 ? 2 : 1); ++rep_)
#endif
            for (int it = blockIdx.x; it < 256; it += F.G) {
                const int l = it >> 7, j0 = (it & 127) * 96;
                LAS float* red = (LAS float*)(F.lds + 67584 + 32768);
                float a[3][2] = {{0.f, 0.f}, {0.f, 0.f}, {0.f, 0.f}};
                if (lane < 48) {
                    const float* w = w_mod + ((size_t)l * D + (size_t)F.wave * 256) * (NMOD * D) + j0 + 2 * lane;
#pragma unroll 16
                    for (int k0_ = 0; k0_ < 256; ++k0_) { const int k = (k0_ + 2 * it) & 255; const int kk = F.wave * 256 + k; const float2 wv = *(const float2*)(w + (size_t)k * (NMOD * D));
                        const float s0 = sl[kk], s1 = sl[D + kk], s2 = sl[2 * D + kk];
                        a[0][0] += s0 * wv.x; a[0][1] += s0 * wv.y; a[1][0] += s1 * wv.x; a[1][1] += s1 * wv.y; a[2][0] += s2 * wv.x; a[2][1] += s2 * wv.y; }
#pragma unroll
                    for (int s = 0; s < 3; ++s) { red[(F.wave * 3 + s) * 96 + 2 * lane] = a[s][0]; red[(F.wave * 3 + s) * 96 + 2 * lane + 1] = a[s][1]; }
                }
                __syncthreads();
                if (tid < 288) { const int s = tid / 96, j = tid % 96; float v = b_mod[l * NMOD * D + j0 + j];
#pragma unroll
                    for (int w = 0; w < 8; ++w) v += red[(w * 3 + s) * 96 + j];
                    modv[((size_t)l * 3 + s) * (NMOD * D) + j0 + j] = v; }
                __syncthreads();
            }
        }
        {
            LAS float* scr = (LAS float*)(F.lds + F.wave * 8448);
            const int gw = F.vcu * NWAVES + F.wave, NGW = F.G * NWAVES;
            constexpr int I_IN = (D / 64) * (IN_DIM / 32), I_OUT = (D / 64) * (D / 32), I_GU = (D / 64) * (DEXP / 32), I_DN = (DEXP / 64) * (D / 32);
            constexpr int PER_L = I_IN + I_OUT + NEXP * (2 * I_GU + I_DN);
#ifdef PROBE_P0
            for (int rep_ = 0; rep_ < (PROBE_P0 == 3 ? 2 : 1); ++rep_)
#endif
            for (int it = gw; it < 2 * PER_L; it += NGW) {
                const int l = it / PER_L; int r = it % PER_L;
                if (r < I_IN) { const int nb = r % (IN_DIM / 32); p0_transpose_item(w_in + (size_t)l * D * IN_DIM, D, IN_DIM, Win_t + (size_t)l * IN_DIM * D, nb * 32, scr, r, lane); continue; } r -= I_IN;
                if (r < I_OUT) { const int nb = r % (D / 32); p0_transpose_item(w_out + (size_t)l * D * D, D, D, Wout_t + (size_t)l * D * D, nb * 32, scr, r, lane); continue; } r -= I_OUT;
                const int e = r / (2 * I_GU + I_DN); r %= (2 * I_GU + I_DN);
                const size_t le = (size_t)l * NEXP + e;
                if (r < 2 * I_GU) { const int up = r >= I_GU; if (up) r -= I_GU; const int nb = r % (DEXP / 32); const int n0 = nb * 32;
                    const int rowb = (n0 >> 7) * 256 + (n0 & 127) + up * 128;
                    p0_transpose_item((up ? w_up : w_gate) + le * D * DEXP, D, DEXP, Wgu_t + le * (2 * DEXP) * D, rowb, scr, r, lane); continue; } r -= 2 * I_GU;
                { const int nb = r % (D / 32); p0_transpose_item(w_down + le * DEXP * D, DEXP, D, Wdn_t + le * D * DEXP, nb * 32, scr, r, lane); }
            }
        }
    }


    if (kk == 0) {
        PHASE_PROLOG; const float* modl = modv + (size_t)l * 3 * NMOD * D; (void)modl;
        const float* g1 = g_norm1 + l * D;
        const int l4 = lane * 4;
#define N1_SRC(row) ((l == 0) ? ((row) < MLAT ? x_in + (size_t)(row) * D : ctx_in + (size_t)((row) - MLAT) * D) : X + (size_t)(row) * D)
        f32x4 vn[8]; pg8::u32x2 yn0[8], yn1[8];
        int row = gw;
        { const int r0 = min(row, MROWS - 1); const float* src = N1_SRC(r0);
#pragma unroll
            for (int j = 0; j < 8; ++j) vn[j] = *(const f32x4*)(src + l4 + 256 * j);
#pragma unroll
            for (int j = 0; j < 8; ++j) { yn0[j] = (pg8::u32x2){0u, 0u}; yn1[j] = (pg8::u32x2){0u, 0u}; }
            if (l == 1) {
#pragma unroll
                for (int j = 0; j < 8; ++j) { yn0[j] = *(const pg8::u32x2*)(Y2 + (size_t)(2 * r0) * D + l4 + 256 * j); yn1[j] = *(const pg8::u32x2*)(Y2 + (size_t)(2 * r0 + 1) * D + l4 + 256 * j); } } }
#pragma unroll 1
        for (; row < MROWS; row += NGW) {
            const int l4 = opqv(lane * 4);
            const int s = modsel(row);
            f32x4 v[8]; pg8::u32x2 y0[8], y1[8];
#pragma unroll
            for (int j = 0; j < 8; ++j) { v[j] = vn[j]; y0[j] = yn0[j]; y1[j] = yn1[j]; }
            const int nrow = min(row + NGW, MROWS - 1);
            { const float* src = N1_SRC(nrow);
#pragma unroll
                for (int j = 0; j < 8; ++j) vn[j] = *(const f32x4*)(src + l4 + 256 * j);
                if (l == 1) {
#pragma unroll
                    for (int j = 0; j < 8; ++j) { yn0[j] = *(const pg8::u32x2*)(Y2 + (size_t)(2 * nrow) * D + l4 + 256 * j); yn1[j] = *(const pg8::u32x2*)(Y2 + (size_t)(2 * nrow + 1) * D + l4 + 256 * j); } } }
            if (l == 1) {
                const float* ga = modv + (size_t)s * (NMOD * D) + 5 * D;
#pragma unroll
                for (int j = 0; j < 8; ++j) { const int col = l4 + 256 * j; const f32x4 g = *(const f32x4*)(ga + col);
                    v[j][0] += g[0] * (__uint_as_float(y0[j].x << 16) + __uint_as_float(y1[j].x << 16)); v[j][1] += g[1] * (__uint_as_float(y0[j].x & 0xffff0000u) + __uint_as_float(y1[j].x & 0xffff0000u));
                    v[j][2] += g[2] * (__uint_as_float(y0[j].y << 16) + __uint_as_float(y1[j].y << 16)); v[j][3] += g[3] * (__uint_as_float(y0[j].y & 0xffff0000u) + __uint_as_float(y1[j].y & 0xffff0000u));
                    *(f32x4*)(X + (size_t)row * D + col) = v[j]; }
            }
            float ss = 0.f;
#pragma unroll
            for (int j = 0; j < 8; ++j) ss += v[j][0] * v[j][0] + v[j][1] * v[j][1] + v[j][2] * v[j][2] + v[j][3] * v[j][3];
            ss = wave_sum(ss);
            const float rstd = rsqrtf(ss * (1.f / D) + 1e-6f);
            const float* sh = modl + (size_t)s * (NMOD * D); const float* sc = sh + D;
#pragma unroll
            for (int j = 0; j < 8; ++j) { const int col = l4 + 256 * j; const f32x4 g = *(const f32x4*)(g1 + col), a = *(const f32x4*)(sc + col), b = *(const f32x4*)(sh + col);
                const f32x4 h = v[j] * rstd * g * (a + 1.f) + b; pg8::u32x2 o; o.x = pk2(h[0], h[1]); o.y = pk2(h[2], h[3]); *(pg8::u32x2*)(H + (size_t)row * D + col) = o; }
        }
#undef N1_SRC
    }
    if (kk == 1) {
        PHASE_PROLOG; const float* modl = modv + (size_t)l * 3 * NMOD * D; (void)modl;
        pg8::Prob P{H, Win_t + (size_t)l * IN_DIM * D, D, D, D, 0, (long long)256 * D, 0, 0, (long long)256 * D, 0, 0};
        pg8::StaticOrder S; S.init(MROWS / 256, IN_DIM / 256, F.G, (int)blockIdx.x);
        for (int e = tid; e < 2048; e += NWAVES * 64) ((LAS float*)(F.lds + ROPE_OFF))[e] = rope[e];
        __syncthreads();
        pg8::EpiG1 E{U, (const PG8_LAS float*)(F.lds + ROPE_OFF)};
        pg8::gemm_phase<pg8::EpiG1, pg8::StaticOrder, false, true>(F.lds + RING_OFF, P, S, E, rows_lds);
    }
    if (kk == 2) {
        PHASE_PROLOG; const float* modl = modv + (size_t)l * 3 * NMOD * D; (void)modl;
        const int NT = mrows / 256;
        pg8::Prob P{WC, U + UF, 256, IN_DIM, 256, 0, 0, 0, 0, (long long)256 * IN_DIM, 128, 0};
        pg8::DftASched S{4 * NT, F.G, (int)blockIdx.x, 0};
        pg8::EpiDftA E{PQT, PQTC};
#ifdef PROBE_SUB
        for (int rep_ = 0; rep_ < (PROBE_SUB == 3 ? 2 : 1); ++rep_)
#endif
        pg8::gemm_phase<pg8::EpiDftA, pg8::DftASched, false, true>(F.lds + RING_OFF, P, S, E, rows_lds);
        __syncthreads();
        {
            const int nun = (l == 0) ? 272 : 256;
#ifdef PROBE_SUB
            for (int rep_ = 0; rep_ < (PROBE_SUB == 1 ? 2 : 1); ++rep_)
#endif
            for (int un = blockIdx.x; un < nun; un += F.G) att::attn_unit(F.lds + RING_OFF, U, MIX, INP(10) + l * 8, un, tid);
        }

        {
            const int nti = (l == 0) ? 272 : 256;
            if ((int)blockIdx.x < nti) { __syncthreads(); conv_fill_w(F.lds + RING_OFF, INP(12) + l * 31 * 512, tid); }
#ifdef PROBE_SUB
            for (int rep_ = 0; rep_ < (PROBE_SUB == 2 ? 2 : 1); ++rep_)
#endif
            for (int ti = blockIdx.x; ti < nti; ti += F.G) conv_tile(F.lds + RING_OFF, U, MIX, INP(11) + l * 3 * 512, INP(13) + l * 512, INP(14) + l * 512, INP(15) + l * 512, ti, tid);
        }
    }
    if (kk == 3) {
        PHASE_PROLOG; const float* modl = modv + (size_t)l * 3 * NMOD * D; (void)modl;
        { pg8::Prob P{CS, PQT, 2 * SEQ, 2 * SEQ, 2048, 0, (long long)256 * 2 * SEQ, 0, 2048, (long long)256 * 2 * SEQ, (long long)512 * 2 * SEQ, 2048};
          pg8::DftBSched S{256, F.G, (int)blockIdx.x, 0};
          pg8::EpiDftB E{PART, 0, 0, SEQ};
          pg8::gemm_phase<pg8::EpiDftB, pg8::DftBSched, false, true>(F.lds + RING_OFF, P, S, E, rows_lds); }
        if (l == 0) {
          pg8::Prob P{CSC, PQTC, 2 * CTXL, 2 * CTXL, 2 * CTXL, 0, 0, 0, 0, (long long)256 * 2 * CTXL, (long long)512 * 2 * CTXL, 0};
          pg8::DftBSched S{4, F.G, (int)blockIdx.x, 1};
          pg8::EpiDftB E{PART, MLAT, 0, CTXL};
          pg8::gemm_phase<pg8::EpiDftB, pg8::DftBSched, false, true>(F.lds + RING_OFF, P, S, E, rows_lds); }
    }
    if (kk == 4) {
        PHASE_PROLOG; const float* modl = modv + (size_t)l * 3 * NMOD * D; (void)modl;
        float sc_lat = 0.001381067932f, sc_ctx = 0.005524271728f;
        asm volatile("" : "+v"(sc_lat), "+v"(sc_ctx));
        const int nitems = mrows * 128;
        for (int it = blockIdx.x * (NWAVES * 64) + tid; it < nitems; it += F.G * NWAVES * 64) {
            const int row = it >> 7, n = (it & 127) * 4;
            f32x4 a = *(const f32x4*)(PART + (size_t)row * 512 + n);
            if (row < MLAT) { a += *(const f32x4*)(PART + ((size_t)MROWS + row) * 512 + n); a += *(const f32x4*)(PART + ((size_t)2 * MROWS + row) * 512 + n); a += *(const f32x4*)(PART + ((size_t)3 * MROWS + row) * 512 + n); a = a * sc_lat; }
            else a = a * sc_ctx;
            pg8::u32x2 o; o.x = pk2(a[0], a[1]); o.y = pk2(a[2], a[3]); *(pg8::u32x2*)(MIX + (size_t)row * D + 512 + n) = o;
        }
    }
    if (kk == 5) {
        PHASE_PROLOG; const float* modl = modv + (size_t)l * 3 * NMOD * D; (void)modl;
        pg8::Prob P{MIX, Wout_t + (size_t)l * D * D, D, D, D, 0, (long long)256 * D, 0, 0, (long long)256 * D, 0, 0};
        pg8::StaticOrder S; S.init(mrows / 256, D / 256, F.G, (int)blockIdx.x);
        pg8::EpiG2 E{X, l == 0 ? x_in : X, l == 0 ? ctx_in : X + (size_t)MLAT * D, modl};
        pg8::gemm_phase<pg8::EpiG2, pg8::StaticOrder, false, true>(F.lds + RING_OFF, P, S, E, rows_lds);
    }
    if (kk == 6) {
        PHASE_PROLOG; const float* modl = modv + (size_t)l * 3 * NMOD * D; (void)modl;
        N2Ctx C{X, H, g_norm2 + l * D, modl, w_rg + (size_t)l * D * 4, w_re + (size_t)l * D * 16, b_rg + l * 4, b_re + l * 16, tok_e, tok_w, F.ctl + 64 * l, list};
        LAS float* wt = (LAS float*)(F.lds + RING_OFF);
        const int nr = (mrows + F.G - 1) / F.G;
        const int rbeg = F.vcu * nr, rend = min(mrows, rbeg + nr);
        for (int rb = rbeg; rb < rend; rb += 40) {
            const int lim = min(rend, rb + 40);
#pragma unroll 1
            for (int gi = 0; gi < 3; ++gi) {
                int ra[2];
#pragma unroll
                for (int i = 0; i < 2; ++i) { const int r = rb + F.wave + 8 * (2 * gi + i); ra[i] = (r < lim && 2 * gi + i < 5) ? r : 0x7fffffff; }
                n2_group<2>(C, wt, ra, mrows, lane, tid);
            }
        }
        __syncthreads();
    }
    if (kk == 7 || kk == 8 || kk == 9) {
        PHASE_PROLOG;
        const unsigned* cnt = F.ctl + 64 * l;
        __syncthreads();
        if (tid == 0) { LAS int* pre = ulist + 40; pre[0] = 0;
            for (int e = 0; e < NEXP; ++e) pre[e + 1] = pre[e] + (int)((__hip_atomic_load(cnt + e, RLX_AGENT) + 255u) >> 8); }
        __syncthreads();
        const int T = __builtin_amdgcn_readfirstlane(ulist[40 + NEXP]);
        const int G = F.G, bid = (int)blockIdx.x;
        const int NU = 4 * T, ND = 8 * T;
        const int nheavy = min(G, max(0, NU - G)), nlight = G - nheavy;
        const bool lightB = nlight >= G / 4;
        const int Te = lightB ? min(T, G / 4) : 0;
        int ufirst = 0, ustride = 1, ulimit = 0, kind = 0;
        if (kk == 7) { kind = 0; ufirst = bid; ustride = G; ulimit = min(NU, G); }
        else if (kk == 8) { if (bid < nheavy) { kind = 0; ufirst = bid + G; ustride = G; ulimit = NU; }
                            else if (lightB) { kind = 1; ufirst = bid - nheavy; ustride = nlight; ulimit = 8 * Te; } }
        else { kind = 1; ufirst = 8 * Te + bid; ustride = G; ulimit = ND; }
        const int NPN = kind ? 8 : 4;
        for (int u0 = ufirst; u0 < ulimit; u0 += 4 * ustride) {
            __syncthreads();
            if (tid == 0) { const LAS int* pre = ulist + 40; int n = 0;
                for (int i = 0; i < 4; ++i) { const int L = u0 + i * ustride; if (L >= ulimit) break; const int tau = L / NPN; int e = 0; while (pre[e + 1] <= tau) ++e;
                    ulist[n * 4] = tau; ulist[n * 4 + 1] = L % NPN; ulist[n * 4 + 2] = e; ulist[n * 4 + 3] = tau - pre[e]; ++n; }
                ulist[32] = n; }
            __syncthreads();
            const int nu = __builtin_amdgcn_readfirstlane(ulist[32]);
            for (int i = 0; i < nu; ++i) { const int e = ulist[i * 4 + 2], rt = ulist[i * 4 + 3]; const unsigned ce = __hip_atomic_load(cnt + e, RLX_AGENT);
                for (int r = tid; r < 256; r += NWAVES * 64) { const unsigned idx = (unsigned)rt * 256u + (unsigned)r; ((LAS unsigned*)(F.lds + ROWS_OFF))[i * 256 + r] = idx < ce ? list[(size_t)e * (2 * MROWS) + idx] : 0xFFFFFFFFu; } }
            __syncthreads();
            pg8::ListSched S{(const PG8_LAS int*)ulist, nu};
            if (kind == 0) {
                pg8::Prob P{H, Wgu_t + (size_t)l * NEXP * (2 * DEXP) * D, D, D, D, 0, 0, 0, 0, (long long)256 * D, (long long)(2 * DEXP) * D, 0};
                pg8::EpiMoeUp E{HIDB, tok_w, rows_lds};
                pg8::gemm_phase<pg8::EpiMoeUp, pg8::ListSched, true, true>(F.lds + RING_OFF, P, S, E, rows_lds);
            } else {
                pg8::Prob P{HIDB, Wdn_t + (size_t)l * NEXP * D * DEXP, DEXP, DEXP, DEXP, 0, (long long)256 * DEXP, 0, 0, (long long)256 * DEXP, (long long)D * DEXP, 0};
                pg8::EpiMoeDown E{Y2, rows_lds};
                pg8::gemm_phase<pg8::EpiMoeDown, pg8::ListSched, false, true>(F.lds + RING_OFF, P, S, E, rows_lds);
            }
        }
    }
    if (kk == -2) {
        PHASE_PROLOG;
        const float* modl1 = modv + (size_t)3 * NMOD * D;
        const int l4 = lane * 4;
        f32x4 vn[8]; pg8::u32x2 yn0[8], yn1[8];
        int row = gw;
        { const int r0 = min(row, MLAT - 1);
#pragma unroll
            for (int j = 0; j < 8; ++j) { vn[j] = *(const f32x4*)(X + (size_t)r0 * D + l4 + 256 * j); yn0[j] = *(const pg8::u32x2*)(Y2 + (size_t)(2 * r0) * D + l4 + 256 * j); yn1[j] = *(const pg8::u32x2*)(Y2 + (size_t)(2 * r0 + 1) * D + l4 + 256 * j); } }
#pragma unroll 1
        for (; row < MLAT; row += NGW) {
            const int l4 = opqv(lane * 4);
            const int s = modsel(row);
            const float* ga = modl1 + (size_t)s * (NMOD * D) + 5 * D;
            f32x4 v[8]; pg8::u32x2 y0[8], y1[8];
#pragma unroll
            for (int j = 0; j < 8; ++j) { v[j] = vn[j]; y0[j] = yn0[j]; y1[j] = yn1[j]; }
            const int nrow = min(row + NGW, MLAT - 1);
            {
#pragma unroll
                for (int j = 0; j < 8; ++j) { vn[j] = *(const f32x4*)(X + (size_t)nrow * D + l4 + 256 * j); yn0[j] = *(const pg8::u32x2*)(Y2 + (size_t)(2 * nrow) * D + l4 + 256 * j); yn1[j] = *(const pg8::u32x2*)(Y2 + (size_t)(2 * nrow + 1) * D + l4 + 256 * j); } }
            float ss = 0.f;
#pragma unroll
            for (int j = 0; j < 8; ++j) { const int col = l4 + 256 * j; const f32x4 g = *(const f32x4*)(ga + col);
                v[j][0] += g[0] * (__uint_as_float(y0[j].x << 16) + __uint_as_float(y1[j].x << 16)); v[j][1] += g[1] * (__uint_as_float(y0[j].x & 0xffff0000u) + __uint_as_float(y1[j].x & 0xffff0000u));
                v[j][2] += g[2] * (__uint_as_float(y0[j].y << 16) + __uint_as_float(y1[j].y << 16)); v[j][3] += g[3] * (__uint_as_float(y0[j].y & 0xffff0000u) + __uint_as_float(y1[j].y & 0xffff0000u));
                ss += v[j][0] * v[j][0] + v[j][1] * v[j][1] + v[j][2] * v[j][2] + v[j][3] * v[j][3]; }
            ss = wave_sum(ss);
            const float rstd = rsqrtf(ss * (1.f / D) + 1e-6f);
#pragma unroll
            for (int j = 0; j < 8; ++j) { const int col = l4 + 256 * j; const f32x4 g = *(const f32x4*)(g_final + col); *(f32x4*)(args.out + (size_t)row * D + col) = v[j] * rstd * g; }
        }
    }
    if (pi + 1 < hi) GRID_BAR();
  }
#undef x_in
#undef c_in
#undef ctx_in
#undef c_ctx
#undef w_mod
#undef b_mod
#undef w_in
#undef w_out
#undef w_gate
#undef w_up
#undef w_down
#undef modv
#undef rope
#undef tok_w
#undef tok_e
#undef list
#undef X
#undef H
#undef U
#undef MIX
#undef Y2
#undef Win_t
#undef Wout_t
#undef Wgu_t
#undef Wdn_t
#undef CS
#undef CSC
#undef WC
#undef PQT
#undef PQTC
#undef PART
#undef HIDB
#undef g_norm1
#undef g_norm2
#undef g_final
#undef w_rg
#undef b_rg
#undef w_re
#undef b_re
#undef PC_OF
#undef GRID_BAR
}

static int g_grid = 0;
static void mega_launch(MArgs a, int lo, int hi, int layer, int use_bar, hipStream_t stream) {
    a.ph_lo = lo; a.ph_hi = hi; a.layer = layer; a.use_bar = use_bar;
    hipLaunchKernelGGL(mega_fwd, dim3(g_grid), dim3(NWAVES * 64), LDS_BYTES, stream, a);
}
extern "C" void kernel_launch(void* const* d_in, const int* in_sizes, int n_in, void* d_out, int out_size, void* d_ws, size_t ws_size, hipStream_t stream) {
    if (g_grid == 0) {
        int dev = 0, cus = 0;
        (void)hipGetDevice(&dev); (void)hipDeviceGetAttribute(&cus, hipDeviceAttributeMultiprocessorCount, dev);
        (void)hipFuncSetAttribute((const void*)mega_fwd, hipFuncAttributeMaxDynamicSharedMemorySize, LDS_BYTES);
        g_grid = cus > 0 ? cus : 256;
    }
    const float* x_in = (const float*)d_in[0]; const float* ctx = (const float*)d_in[2];
    const float* g_norm1 = (const float*)d_in[6]; const float* g_norm2 = (const float*)d_in[7];
    const float* attn_sink = (const float*)d_in[10]; const float* sconv_w = (const float*)d_in[11];
    const float* cconv_w = (const float*)d_in[12]; const float* cconv_b = (const float*)d_in[13]; const float* cnorm_g = (const float*)d_in[14]; const float* cnorm_b = (const float*)d_in[15];
    const float* w_rg = (const float*)d_in[16]; const float* b_rg = (const float*)d_in[17]; const float* w_re = (const float*)d_in[18]; const float* b_re = (const float*)d_in[19];
    const float* g_final = (const float*)d_in[23];
    unsigned char* ws = (unsigned char*)d_ws;
    unsigned* ctl = (unsigned*)(ws + WS_CTL);
    float* modv = (float*)(ws + WS_MOD);
    int* tok_e = (int*)(ws + WS_TOK); float* tok_w = (float*)(ws + WS_TOK + 128 * 1024); unsigned* list = (unsigned*)(ws + WS_LIST);
    float* X = (float*)(ws + WS_X); bf16_t* H = (bf16_t*)(ws + WS_H); bf16_t* U = (bf16_t*)(ws + WS_U); bf16_t* MIX = (bf16_t*)(ws + WS_MIX);
    float* P = (float*)(ws + WS_P); float* Q = (float*)(ws + WS_Q); bf16_t* Y2 = (bf16_t*)(ws + WS_Y2);
    float* out = (float*)d_out;
    MArgs a{};
    for (int i = 0; i < 24; ++i) a.in[i] = (const float*)d_in[i];
    a.out = out; a.ws = ws;
    (void)hipMemsetAsync(ctl, 0, 65536, stream);
#ifdef PROBE_DUP
    mega_launch(a, 0, 23, 0, 1, stream);
#else
    mega_launch(a, 0, 22, 0, 1, stream);
#endif
}
```

```cpp
#include <hip/hip_runtime.h>
#include <stdint.h>
#include <math.h>

typedef unsigned short bf16_t;
__device__ __forceinline__ float bf2f(bf16_t v) { return __uint_as_float(((unsigned)v) << 16); }
__device__ __forceinline__ bf16_t f2bf(float f) { unsigned u = __float_as_uint(f); return (bf16_t)((u + 0x7fffu + ((u >> 16) & 1u)) >> 16); }

constexpr int D = 2048, SEQ = 4096, CTXL = 256, NBATCH = 2;
constexpr int MLAT = NBATCH * SEQ, MCTX = NBATCH * CTXL, MROWS = MLAT + MCTX;
constexpr int IN_DIM = 3840, NMOD = 6;
constexpr int NEXP = 16, DEXP = 512;
constexpr float QSCALE = 0.125f * 1.4426950408889634f;
constexpr float LOG2E = 1.4426950408889634f;
constexpr int UQ = 0, UK = 512, UV = 640, UF = 768, USB = 1280, USC = 1792, USV = 2304, UDA = 2816, UDG = 3328;

__device__ __forceinline__ int modsel(int row) { return row < SEQ ? 0 : (row < MLAT ? 1 : 2); }
__device__ __forceinline__ void seqinfo(int row, int& base, int& t, int& len) {
    if (row < MLAT) { base = row & ~(SEQ - 1); t = row & (SEQ - 1); len = SEQ; }
    else { int r = row - MLAT; base = MLAT + (r & ~(CTXL - 1)); t = r & (CTXL - 1); len = CTXL; }
}
__device__ __forceinline__ float silu_f(float v) { return v / (1.f + __expf(-v)); }
__device__ __forceinline__ float sigmoid_f(float v) { return 1.f / (1.f + __expf(-v)); }

constexpr size_t MiB = 1u << 20;
constexpr size_t WS_CTL = 0;
constexpr size_t WS_MODP = 1 * MiB;
constexpr size_t WS_MOD = 6 * MiB;
constexpr size_t WS_ROPE = 7 * MiB;
constexpr size_t WS_TOK = 8 * MiB;
constexpr size_t WS_LIST = 9 * MiB;
constexpr size_t WS_X = 16 * MiB;
constexpr size_t WS_H = 88 * MiB;
constexpr size_t WS_U = 124 * MiB;
constexpr size_t WS_MIX = 190 * MiB;
constexpr size_t WS_P = 226 * MiB;
constexpr size_t WS_Q = 244 * MiB;
constexpr size_t WS_HID = 262 * MiB;
constexpr size_t WS_Y2 = 280 * MiB;
constexpr size_t WS_END = 350 * MiB;

__device__ __forceinline__ float wave_sum(float v) {
#pragma unroll
    for (int o = 32; o > 0; o >>= 1) v += __shfl_xor(v, o);
    return v;
}

__device__ __forceinline__ int hw_lane_id() { unsigned z = 0u; asm volatile("" : "+v"(z)); return (int)__builtin_amdgcn_mbcnt_hi(~0u, __builtin_amdgcn_mbcnt_lo(~0u, z)); }
namespace pg8 {
#define PG8_LAS __attribute__((address_space(3)))
typedef short bf16x8 __attribute__((ext_vector_type(8)));
typedef float f32x4 __attribute__((ext_vector_type(4)));
typedef unsigned u32x4 __attribute__((ext_vector_type(4)));
typedef unsigned u32x2 __attribute__((ext_vector_type(2)));
constexpr int BM = 256, BK = 64, HALF = 128, HTB = HALF * BK * 2, STAGE_BYTES = 8 * HTB, NXCD = 8, WGM = 8;
__host__ __device__ __forceinline__ int lds_byte(int r, int c) { const int st = (r >> 4) * 2 + (c >> 5), rr = r & 15, cc = c & 31, ob = rr * 64 + cc * 2; return st * 1024 + (ob ^ (((ob >> 9) & 1) << 5)); }
__host__ __device__ __forceinline__ void stage_rc(int b, int& R, int& C) { const int st = b / 1024, sb = b % 1024, swz = sb ^ (((sb >> 9) & 1) << 5); R = (st >> 1) * 16 + swz / 64; C = (st & 1) * 32 + (swz % 64) / 2; }
__host__ __device__ __forceinline__ int perm32(int rho) { const int n = rho >> 4, i = rho & 15; return 8 * (i >> 2) + 4 * n + (i & 3); }

struct Unit { int pm, pn, grp, aux; };
struct Prob {
    const bf16_t* A; const bf16_t* Bt; int lda, ldb, K, pad;
    long long a_pm, a_grp, a_aux, b_pn, b_grp, b_aux;
    __device__ __forceinline__ const char* a_base(const Unit& u) const { return (const char*)(A + (long long)u.pm * a_pm + (long long)u.grp * a_grp + (long long)u.aux * a_aux); }
    __device__ __forceinline__ const char* b_base(const Unit& u) const { return (const char*)(Bt + (long long)u.pn * b_pn + (long long)u.grp * b_grp + (long long)u.aux * b_aux); }
};
struct StaticOrder {
    int nM, nN, nwg, G, c;
    __device__ void init(int nM_, int nN_, int G_, int c_) { nM = nM_; nN = nN_; nwg = nM * nN; G = G_; c = c_; }
    __device__ bool next(int i, Unit& u) const {
        const long L = (long)i * G + c; if (L >= nwg) return false;
        int wgid = (int)L; { const int q = nwg / NXCD, r = nwg % NXCD, xcd = wgid % NXCD, off = wgid / NXCD; wgid = (xcd < r ? xcd * (q + 1) : r * (q + 1) + (xcd - r) * q) + off; }
        const int nig = WGM * nN, gid = wgid / nig, fm = gid * WGM, gsz = (nM - fm) < WGM ? (nM - fm) : WGM;
        u.pm = fm + ((wgid % nig) % gsz); u.pn = (wgid % nig) / gsz; u.grp = 0; u.aux = 0; return true;
    }
};
struct ListSched {
    const PG8_LAS int* ul; int n;
    __device__ bool next(int i, Unit& u) const {
        if (i >= n) return false;
        u.pm = __builtin_amdgcn_readfirstlane(ul[i * 4]); u.pn = __builtin_amdgcn_readfirstlane(ul[i * 4 + 1]); u.grp = __builtin_amdgcn_readfirstlane(ul[i * 4 + 2]); u.aux = __builtin_amdgcn_readfirstlane(ul[i * 4 + 3]); return true;
    }
};
struct DftASched { int n, G, c, pad;
    __device__ bool next(int i, Unit& u) const { const int L = i * G + c; if (L >= n) return false; u.pm = 0; u.pn = L >> 2; u.grp = L & 3; u.aux = 0; return true; } };
struct DftBSched { int n, G, c, mode;
    __device__ bool next(int i, Unit& u) const { const int L = i * G + c; if (L >= n) return false;
        if (mode == 0) { const int x = L & 7, idx = L >> 3; u.aux = x & 3; u.pm = (x >> 2) * 8 + (idx & 7); u.grp = (idx >> 3) & 1; u.pn = idx >> 4; }
        else { u.grp = L >> 1; u.pn = L & 1; u.pm = 0; u.aux = 0; } return true; } };
struct DftB2Sched { int n, G, c, pad;
    __device__ bool next(int i, Unit& u) const { const int L = i * G + c; if (L >= n) return false; const int x = L & 7, idx = L >> 3; const int eo = x >> 2;
        u.aux = x & 3; u.pm = eo * 8 + (idx & 7); u.grp = (idx >> 3) & 1; u.pn = eo * 2 + (idx >> 4); return true; } };
__device__ __forceinline__ unsigned cvt_pk_bf16(float lo, float hi) { unsigned r; asm volatile("v_cvt_pk_bf16_f32 %0, %1, %2" : "=v"(r) : "v"(lo), "v"(hi)); return r; }

template <class Epi, class Sched, bool GATHER, bool ALIGN_EPI>
__device__ __forceinline__ void gemm_phase(PG8_LAS unsigned char* lds, const Prob P, const Sched& S, const Epi& E, const PG8_LAS unsigned* rows_lds, int wave_id) {
    int tid_ = wave_id * 64 + hw_lane_id(); asm volatile("" : "+v"(tid_));
    const int tid = tid_, wid = __builtin_amdgcn_readfirstlane(tid >> 6), lane = tid & 63, wr = wid >> 2, wc = wid & 3, fr = lane & 15, fq = lane >> 4;
    const int K = P.K, nt = K / BK;
    int Rr[2], Cc[2];
    unsigned voB[2], voA[2][2];
#pragma unroll
    for (int i = 0; i < 2; ++i) { int R, C; stage_rc(tid * 16 + i * 8192, R, C); Rr[i] = R; Cc[i] = C; const int Rb = Epi::PERM ? ((R & ~31) + perm32(R & 31)) : R;
        voB[i] = (unsigned)(Rb * P.ldb + C) * 2u; }
#define PG8_SETVOA(slot) do { _Pragma("unroll") for (int _h = 0; _h < 2; ++_h) _Pragma("unroll") for (int _i = 0; _i < 2; ++_i) { \
        unsigned _row = (unsigned)(_h * HALF + Rr[_i]); if (GATHER) { const unsigned _e = rows_lds[(slot) * 256 + _h * HALF + Rr[_i]]; _row = (_e == 0xFFFFFFFFu) ? 0u : (_e >> 1); } \
        voA[_h][_i] = (_row * (unsigned)P.lda + (unsigned)Cc[_i]) * 2u; } } while (0)
    const size_t kstep = (size_t)(BK * 2);
    const size_t hstepB = (size_t)HALF * P.ldb * 2;
    const unsigned ldsw = (unsigned)wid * 1024u;
    const int aoff = lds_byte(wr * 64 + fr, fq * 8), boff = lds_byte(wc * 32 + fr, fq * 8);
#define PG8_SA(b, h) (((b) * 2 + (h)) * HTB)
#define PG8_SB(b, h) ((4 + (b) * 2 + (h)) * HTB)
#define PG8_STAGE(bufoff, gbase, voff) do { _Pragma("unroll") for (int _i = 0; _i < 2; ++_i) \
        __builtin_amdgcn_global_load_lds((const unsigned*)((const char*)(gbase) + (voff)[_i]), (PG8_LAS unsigned*)(lds + (bufoff) + ldsw + _i * 8192), 16, 0, 0); } while (0)
#define PG8_LDA(dst, b, h) do { _Pragma("unroll") for (int m = 0; m < 4; ++m) _Pragma("unroll") for (int k = 0; k < 2; ++k) dst[m][k] = *(const PG8_LAS bf16x8*)(lds + PG8_SA(b, h) + aoff + m * 2048 + k * 1024); } while (0)
#define PG8_LDB(dst, b, h) do { _Pragma("unroll") for (int n = 0; n < 2; ++n) _Pragma("unroll") for (int k = 0; k < 2; ++k) dst[n][k] = *(const PG8_LAS bf16x8*)(lds + PG8_SB(b, h) + boff + n * 2048 + k * 1024); } while (0)
#define PG8_MMA(ai, bj, At, Bt) do { __builtin_amdgcn_s_setprio(1); _Pragma("unroll") for (int m = 0; m < 4; ++m) _Pragma("unroll") for (int n = 0; n < 2; ++n) _Pragma("unroll") for (int k = 0; k < 2; ++k) \
        acc[ai][bj][m][n] = __builtin_amdgcn_mfma_f32_16x16x32_bf16(Bt[n][k], At[m][k], acc[ai][bj][m][n], 0, 0, 0); __builtin_amdgcn_s_setprio(0); } while (0)
#define PG8_WAIT_V(n) asm volatile("s_waitcnt vmcnt(" #n ")" ::: "memory")
#define PG8_WAIT_L(n) asm volatile("s_waitcnt lgkmcnt(" #n ")" ::: "memory")
#define PG8_BAR __builtin_amdgcn_s_barrier()
#define PG8_SCHED __builtin_amdgcn_sched_barrier(0)
    Unit cur, nxt; int ui = 0;
    if (!S.next(0, cur)) return;
    f32x4 acc[2][2][4][2];
#pragma unroll
    for (int a = 0; a < 2; ++a)
#pragma unroll
        for (int b = 0; b < 2; ++b)
#pragma unroll
            for (int m = 0; m < 4; ++m)
#pragma unroll
                for (int n = 0; n < 2; ++n) acc[a][b][m][n] = (f32x4){0.f, 0.f, 0.f, 0.f};
    bf16x8 At[4][2], B0[2][2], B1[2][2];
    const char* cA = P.a_base(cur); const char* cB = P.b_base(cur);
    PG8_SETVOA(0);
    PG8_STAGE(PG8_SB(0, 0), cB, voB); PG8_STAGE(PG8_SB(0, 1), cB + hstepB, voB); PG8_STAGE(PG8_SA(0, 0), cA, voA[0]); PG8_STAGE(PG8_SA(0, 1), cA, voA[1]);
    if (wr == 1) PG8_BAR;
    PG8_WAIT_V(2); PG8_BAR;
    PG8_STAGE(PG8_SB(1, 0), cB + kstep, voB); PG8_STAGE(PG8_SA(1, 0), cA + kstep, voA[0]); PG8_STAGE(PG8_SB(1, 1), cB + hstepB + kstep, voB);
    PG8_WAIT_V(6); PG8_BAR;
    for (;;) {
        const bool has_next = S.next(ui + 1, nxt);
        const char* nA = has_next ? P.a_base(nxt) : cA; const char* nB = has_next ? P.b_base(nxt) : cB;
        for (int t = 0; t < nt; t += 2) {
            const bool last = (t == nt - 2);
            const char* a1 = cA + (size_t)(t + 1) * kstep;
            const char* a2 = last ? nA : cA + (size_t)(t + 2) * kstep; const char* b2 = last ? nB : cB + (size_t)(t + 2) * kstep;
            const char* a3 = a2 + kstep; const char* b3 = b2 + kstep;
            PG8_LDB(B0, 0, 0); PG8_LDB(B1, 0, 1); PG8_SCHED; PG8_LDA(At, 0, 0); PG8_STAGE(PG8_SA(1, 1), a1, voA[1]);
            PG8_WAIT_V(8); PG8_WAIT_L(0); PG8_BAR; PG8_MMA(0, 0, At, B0); PG8_MMA(0, 1, At, B1); PG8_BAR; PG8_SCHED;
            if (GATHER) { if (last && has_next) { PG8_SETVOA(ui + 1); } }
            PG8_LDA(At, 0, 1); PG8_STAGE(PG8_SB(0, 0), b2, voB); PG8_STAGE(PG8_SB(0, 1), b2 + hstepB, voB); PG8_STAGE(PG8_SA(0, 0), a2, voA[0]);
            PG8_WAIT_V(8); PG8_WAIT_L(0); PG8_BAR; PG8_MMA(1, 0, At, B0); PG8_MMA(1, 1, At, B1); PG8_BAR; PG8_SCHED;
            PG8_LDB(B0, 1, 0); PG8_LDB(B1, 1, 1); PG8_SCHED; PG8_LDA(At, 1, 0); PG8_STAGE(PG8_SA(0, 1), a2, voA[1]);
            PG8_WAIT_V(8); PG8_WAIT_L(0); PG8_BAR; PG8_MMA(0, 0, At, B0); PG8_MMA(0, 1, At, B1); PG8_BAR; PG8_SCHED;
            PG8_LDA(At, 1, 1); PG8_STAGE(PG8_SB(1, 0), b3, voB); PG8_STAGE(PG8_SB(1, 1), b3 + hstepB, voB); PG8_STAGE(PG8_SA(1, 0), a3, voA[0]);
            PG8_WAIT_V(8); PG8_WAIT_L(0); PG8_BAR; PG8_MMA(1, 0, At, B0); PG8_MMA(1, 1, At, B1); PG8_BAR; PG8_SCHED;
        }
        if constexpr (ALIGN_EPI) { if (wr == 0) PG8_BAR; }
        E(acc, cur, ui, wr, wc, fr, fq);
        if (!has_next) break;
#pragma unroll
        for (int a = 0; a < 2; ++a)
#pragma unroll
            for (int b = 0; b < 2; ++b)
#pragma unroll
                for (int m = 0; m < 4; ++m)
#pragma unroll
                    for (int n = 0; n < 2; ++n) acc[a][b][m][n] = (f32x4){0.f, 0.f, 0.f, 0.f};
        cur = nxt; cA = nA; cB = nB; ++ui;
        if constexpr (ALIGN_EPI) { if (wr == 1) PG8_BAR; }
    }
    PG8_WAIT_V(0);
    if constexpr (!ALIGN_EPI) { if (wr == 0) PG8_BAR; }
    PG8_BAR;
#undef PG8_SETVOA
#undef PG8_SA
#undef PG8_SB
#undef PG8_STAGE
#undef PG8_LDA
#undef PG8_LDB
#undef PG8_MMA
#undef PG8_WAIT_V
#undef PG8_WAIT_L
#undef PG8_BAR
#undef PG8_SCHED
}

struct EpiG1 {
    static constexpr bool PERM = true;
    bf16_t* U; const PG8_LAS float* rope;
    __device__ __forceinline__ void operator()(const f32x4 (&acc)[2][2][4][2], const Unit& u, int ui, int wr, int wc, int fr, int fq) const {
        const int row0 = u.pm * BM + wr * 64 + fr, colt = u.pn * BM, col0 = colt + wc * 32 + 8 * fq;
        const bool latent = u.pm < 32;
        const int axis = wc & 1; const float sgn = fq < 2 ? -1.f : 1.f;
#pragma unroll
        for (int ai = 0; ai < 2; ++ai)
#pragma unroll
            for (int m = 0; m < 4; ++m) {
                const int row = row0 + ai * HALF + m * 16;
                bf16_t* rowp = U + (size_t)row * IN_DIM + col0;
                const int t = row & (SEQ - 1); const int pos = axis ? (t & 63) : (t >> 6);
                const PG8_LAS f32x4* tp = (const PG8_LAS f32x4*)(rope + (pos * 16 + 8 * (fq & 1)) * 2);
#pragma unroll
                for (int bj = 0; bj < 2; ++bj) {
                    const int cb = colt + bj * HALF;
                    f32x4 v0 = acc[ai][bj][m][0], v1 = acc[ai][bj][m][1];
                    if (cb < 640) {
                        if (latent) {
                            const f32x4 t0 = tp[0], t1 = tp[1], t2 = tp[2], t3 = tp[3];
                            f32x4 p0, p1;
                            p0[0] = __shfl_xor(v0[0], 32); p0[1] = __shfl_xor(v0[1], 32); p0[2] = __shfl_xor(v0[2], 32); p0[3] = __shfl_xor(v0[3], 32);
                            p1[0] = __shfl_xor(v1[0], 32); p1[1] = __shfl_xor(v1[1], 32); p1[2] = __shfl_xor(v1[2], 32); p1[3] = __shfl_xor(v1[3], 32);
                            v0[0] = v0[0] * t0[0] + sgn * p0[0] * t0[1]; v0[1] = v0[1] * t0[2] + sgn * p0[1] * t0[3];
                            v0[2] = v0[2] * t1[0] + sgn * p0[2] * t1[1]; v0[3] = v0[3] * t1[2] + sgn * p0[3] * t1[3];
                            v1[0] = v1[0] * t2[0] + sgn * p1[0] * t2[1]; v1[1] = v1[1] * t2[2] + sgn * p1[1] * t2[3];
                            v1[2] = v1[2] * t3[0] + sgn * p1[2] * t3[1]; v1[3] = v1[3] * t3[2] + sgn * p1[3] * t3[3];
                        }
                        if (cb < 512) { float qs = QSCALE; asm volatile("" : "+v"(qs)); v0 = v0 * qs; v1 = v1 * qs; }
                    }
                    u32x4 w; w.x = cvt_pk_bf16(v0[0], v0[1]); w.y = cvt_pk_bf16(v0[2], v0[3]); w.z = cvt_pk_bf16(v1[0], v1[1]); w.w = cvt_pk_bf16(v1[2], v1[3]);
                    *(u32x4*)(rowp + bj * HALF) = w;
                }
            }
    }
};
struct EpiG2 {
    static constexpr bool PERM = false;
    float* X; const float* base_lat; const float* base_ctx; const float* modv_l;
    __device__ __forceinline__ void operator()(const f32x4 (&acc)[2][2][4][2], const Unit& u, int ui, int wr, int wc, int fr, int fq) const {
        const int s = u.pm < 16 ? 0 : (u.pm < 32 ? 1 : 2);
        const float* ga = modv_l + (size_t)s * (NMOD * D) + 2 * D;
        const int col0 = u.pn * BM + wc * 32 + 4 * fq;
        f32x4 gv[2][2];
#pragma unroll
        for (int bj = 0; bj < 2; ++bj)
#pragma unroll
            for (int n = 0; n < 2; ++n) gv[bj][n] = *(const f32x4*)(ga + col0 + bj * HALF + n * 16);
#pragma unroll
        for (int ai = 0; ai < 2; ++ai)
#pragma unroll
            for (int mh = 0; mh < 2; ++mh) {
                f32x4 bv[2][2][2];
#pragma unroll
                for (int mm = 0; mm < 2; ++mm) { const int m = 2 * mh + mm;
                    const int row = u.pm * BM + ai * HALF + wr * 64 + m * 16 + fr;
                    const float* bp = (u.pm < 32 ? base_lat + (size_t)row * D : base_ctx + (size_t)(row - MLAT) * D) + col0;
#pragma unroll
                    for (int bj = 0; bj < 2; ++bj)
#pragma unroll
                        for (int n = 0; n < 2; ++n) bv[mm][bj][n] = *(const f32x4*)(bp + bj * HALF + n * 16);
                }
                asm volatile("" ::: "memory");
#pragma unroll
                for (int mm = 0; mm < 2; ++mm) { const int m = 2 * mh + mm;
                    const int row = u.pm * BM + ai * HALF + wr * 64 + m * 16 + fr;
                    float* xp = X + (size_t)row * D + col0;
#pragma unroll
                    for (int bj = 0; bj < 2; ++bj)
#pragma unroll
                        for (int n = 0; n < 2; ++n) *(f32x4*)(xp + bj * HALF + n * 16) = bv[mm][bj][n] + gv[bj][n] * acc[ai][bj][m][n];
                }
                asm volatile("" ::: "memory");
            }
    }
};
struct EpiMoeUp {
    static constexpr bool PERM = true;
    bf16_t* Hid; const float* tok_w; const PG8_LAS unsigned* rows_lds;
    __device__ __forceinline__ void operator()(const f32x4 (&acc)[2][2][4][2], const Unit& u, int ui, int wr, int wc, int fr, int fq) const {
        const int col0 = u.pn * HALF + wc * 32 + 8 * fq;
        float wv[2][4];
#pragma unroll
        for (int ai = 0; ai < 2; ++ai)
#pragma unroll
            for (int m = 0; m < 4; ++m) { const unsigned ent = rows_lds[ui * 256 + ai * HALF + wr * 64 + m * 16 + fr]; wv[ai][m] = (ent == 0xFFFFFFFFu) ? 0.f : tok_w[ent]; }
        asm volatile("" ::: "memory");
#pragma unroll
        for (int ai = 0; ai < 2; ++ai)
#pragma unroll
            for (int m = 0; m < 4; ++m) {
                const int r = ai * HALF + wr * 64 + m * 16 + fr;
                const float w = wv[ai][m];
                const f32x4 g0 = acc[ai][0][m][0], g1 = acc[ai][0][m][1], u0 = acc[ai][1][m][0], u1 = acc[ai][1][m][1];
                float h[8];
#pragma unroll
                for (int j = 0; j < 4; ++j) { h[j] = silu_f(g0[j]) * u0[j] * w; h[4 + j] = silu_f(g1[j]) * u1[j] * w; }
                u32x4 o; o.x = cvt_pk_bf16(h[0], h[1]); o.y = cvt_pk_bf16(h[2], h[3]); o.z = cvt_pk_bf16(h[4], h[5]); o.w = cvt_pk_bf16(h[6], h[7]);
                *(u32x4*)(Hid + (size_t)(u.pm * BM + r) * DEXP + col0) = o;
            }
    }
};
struct EpiMoeDown {
    static constexpr bool PERM = true;
    bf16_t* Y2; const PG8_LAS unsigned* rows_lds;
    __device__ __forceinline__ void operator()(const f32x4 (&acc)[2][2][4][2], const Unit& u, int ui, int wr, int wc, int fr, int fq) const {
        const int col0 = u.pn * BM + wc * 32 + 8 * fq;
#pragma unroll
        for (int ai = 0; ai < 2; ++ai)
#pragma unroll
            for (int m = 0; m < 4; ++m) {
                const int r = ai * HALF + wr * 64 + m * 16 + fr;
                const unsigned ent = rows_lds[ui * 256 + r];
                if (ent != 0xFFFFFFFFu) {
                    bf16_t* yp = Y2 + (size_t)ent * D + col0;
#pragma unroll
                    for (int bj = 0; bj < 2; ++bj) { const f32x4 v0 = acc[ai][bj][m][0], v1 = acc[ai][bj][m][1];
                        u32x4 o; o.x = cvt_pk_bf16(v0[0], v0[1]); o.y = cvt_pk_bf16(v0[2], v0[3]); o.z = cvt_pk_bf16(v1[0], v1[1]); o.w = cvt_pk_bf16(v1[2], v1[3]);
                        *(u32x4*)(yp + bj * HALF) = o; }
                }
            }
    }
};
struct EpiDftA {
    static constexpr bool PERM = false;
    bf16_t* PQt; bf16_t* PQtc;
    __device__ __forceinline__ void operator()(const f32x4 (&acc)[2][2][4][2], const Unit& u, int ui, int wr, int wc, int fr, int fq) const {
        const int g = u.grp;
#pragma unroll
        for (int ai = 0; ai < 2; ++ai)
#pragma unroll
            for (int m = 0; m < 4; ++m) {
                const int cq = wr * 64 + m * 16 + fr;
                bf16_t* dst;
                if (u.pn < 32) { const int b = u.pn >> 4; dst = PQt + ((size_t)(b * 512 + g * 128 + cq) * (2 * SEQ) + (size_t)ai * SEQ + (size_t)(u.pn & 15) * BM); }
                else { const int b = u.pn - 32; dst = PQtc + ((size_t)(b * 512 + g * 128 + cq) * (2 * CTXL) + (size_t)ai * CTXL); }
#pragma unroll
                for (int bj = 0; bj < 2; ++bj)
#pragma unroll
                    for (int n = 0; n < 2; ++n) { const f32x4 v = acc[ai][bj][m][n]; u32x2 o; o.x = cvt_pk_bf16(v[0], v[1]); o.y = cvt_pk_bf16(v[2], v[3]);
                        *(u32x2*)(dst + bj * HALF + wc * 32 + n * 16 + 4 * fq) = o; }
            }
    }
};
struct EpiDftB {
    static constexpr bool PERM = false;
    float* PART; int row_base; int pad;
    long long seq_rows;
    __device__ __forceinline__ void operator()(const f32x4 (&acc)[2][2][4][2], const Unit& u, int ui, int wr, int wc, int fr, int fq) const {
        const int col0 = u.pn * BM + wc * 32 + 4 * fq;
#pragma unroll
        for (int ai = 0; ai < 2; ++ai)
#pragma unroll
            for (int m = 0; m < 4; ++m) {
                const int row = row_base + u.grp * (int)seq_rows + u.pm * BM + ai * HALF + wr * 64 + m * 16 + fr;
                float* pp = PART + ((size_t)u.aux * MROWS + row) * 512 + col0;
#pragma unroll
                for (int bj = 0; bj < 2; ++bj)
#pragma unroll
                    for (int n = 0; n < 2; ++n) *(f32x4*)(pp + bj * HALF + n * 16) = acc[ai][bj][m][n];
            }
    }
};
struct EpiDftB2 {
    static constexpr bool PERM = false;
    float* PART2;
    __device__ __forceinline__ void operator()(const f32x4 (&acc)[2][2][4][2], const Unit& u, int ui, int wr, int wc, int fr, int fq) const {
        const int eo = u.pm >> 3, col0 = (u.pn & 1) * BM + wc * 32 + 4 * fq;
        float* base = PART2 + (size_t)(((u.aux * 2 + eo) * 2 + u.grp) * 2048) * 512;
#pragma unroll
        for (int ai = 0; ai < 2; ++ai)
#pragma unroll
            for (int m = 0; m < 4; ++m) {
                const int row = (u.pm & 7) * BM + ai * HALF + wr * 64 + m * 16 + fr;
                float* pp = base + (size_t)row * 512 + col0;
#pragma unroll
                for (int bj = 0; bj < 2; ++bj)
#pragma unroll
                    for (int n = 0; n < 2; ++n) *(f32x4*)(pp + bj * HALF + n * 16) = acc[ai][bj][m][n];
            }
    }
};
}


namespace att {
typedef short bf16x8 __attribute__((ext_vector_type(8)));
typedef short s16x4 __attribute__((ext_vector_type(4)));
typedef float f32x16 __attribute__((ext_vector_type(16)));
typedef unsigned u32x4 __attribute__((ext_vector_type(4)));
typedef unsigned u32x2 __attribute__((ext_vector_type(2)));
typedef short v4i16_t __attribute__((ext_vector_type(4)));
typedef __attribute__((address_space(3))) const unsigned char* lds_cptr;
__device__ __forceinline__ int crow(int r, int hi) { return (r & 3) + 8 * (r >> 2) + 4 * hi; }
__device__ __forceinline__ s16x4 vtr(lds_cptr p) { return __builtin_bit_cast(s16x4, __builtin_amdgcn_ds_read_tr16_b64_v4i16((__attribute__((address_space(3))) v4i16_t*)p)); }
__device__ __forceinline__ unsigned cvtpk(float lo, float hi) { unsigned r; asm volatile("v_cvt_pk_bf16_f32 %0, %1, %2" : "=v"(r) : "v"(lo), "v"(hi)); return r; }

__device__ __forceinline__ void attn_unit(__attribute__((address_space(3))) unsigned char* lds, const bf16_t* __restrict__ Ub, bf16_t* __restrict__ MIXb, const float* __restrict__ sink, int unit, int tid_in) {
    int tid = tid_in; asm volatile("" : "+v"(tid));
    const int lane = tid & 63, r32 = lane & 31, hi = lane >> 5; const int wid = __builtin_amdgcn_readfirstlane(tid >> 6);
    const bool latent = unit < 256;
    int b, kvh, p0;
    if (latent) { b = unit >> 7; kvh = (unit >> 6) & 1; p0 = (unit & 63) * 64; } else { const int u2 = unit - 256; b = u2 >> 3; kvh = (u2 >> 2) & 1; p0 = (u2 & 3) * 64; }
    const int g = wid >> 1, ph = wid & 1, head = kvh * 4 + g;
    const int qrow = (latent ? b * SEQ + p0 : MLAT + b * CTXL + p0) + 32 * ph + r32;
    bf16x8 qr[4];
#pragma unroll
    for (int d0 = 0; d0 < 4; ++d0) qr[d0] = *(const bf16x8*)(Ub + (size_t)qrow * IN_DIM + UQ + head * 64 + 16 * d0 + 8 * hi);
    const int jlo = latent ? (p0 >= 128 ? 0 : (p0 == 64 ? 1 : 2)) : 0;
    const int jhi = latent ? min(4, (4160 - p0) >> 6) : -1;
    const int nloc = latent ? (jhi - jlo + 1) : 0, ntl = nloc + 4;
    const int kkey = lane, kc = wid;
    const int vkey = 16 * (wid & 3) + (lane >> 2), vd = 32 * (wid >> 2) + 8 * (lane & 3);
    const bf16_t* kcol = Ub + UK + kvh * 64 + 8 * kc; const bf16_t* vcol = Ub + UV + kvh * 64 + vd;
#define ATT_KROW0(t) (((t) < nloc) ? (b * SEQ + p0 - 128 + 64 * (jlo + (t))) : (MLAT + b * CTXL + 64 * ((t) - nloc)))
    u32x4 kreg, vreg;
    { const int kr0 = ATT_KROW0(0); kreg = *(const u32x4*)(kcol + (size_t)(kr0 + kkey) * IN_DIM); vreg = *(const u32x4*)(vcol + (size_t)(kr0 + vkey) * IN_DIM); }
    *(__attribute__((address_space(3))) u32x4*)(lds + tid * 16) = kreg; *(__attribute__((address_space(3))) u32x4*)(lds + 16384 + tid * 16) = vreg;
    const float sk2 = sink[head] * LOG2E;
    float m = sk2, l = (hi == 0) ? 1.f : 0.f;
    f32x16 o[2]; o[0] = f32x16{}; o[1] = f32x16{};
    __syncthreads();
    for (int t = 0; t < ntl; ++t) {
        const int slot = (t & 1) * 8192;
        const bool more = (t + 1 < ntl);
        if (more) { const int kr0 = ATT_KROW0(t + 1); kreg = *(const u32x4*)(kcol + (size_t)(kr0 + kkey) * IN_DIM); vreg = *(const u32x4*)(vcol + (size_t)(kr0 + vkey) * IN_DIM); }
        f32x16 s0 = f32x16{}, s1 = f32x16{};
        { const lds_cptr kb = (lds_cptr)lds + slot + hi * 1024 + r32 * 16;
#pragma unroll
          for (int d0 = 0; d0 < 4; ++d0) { const bf16x8 b0 = *(const __attribute__((address_space(3))) bf16x8*)(kb + d0 * 2048); const bf16x8 b1 = *(const __attribute__((address_space(3))) bf16x8*)(kb + d0 * 2048 + 512);
              s0 = __builtin_amdgcn_mfma_f32_32x32x16_bf16(b0, qr[d0], s0, 0, 0, 0); s1 = __builtin_amdgcn_mfma_f32_32x32x16_bf16(b1, qr[d0], s1, 0, 0, 0); } }
        if (t < nloc) {
            const int rel0 = 64 * (jlo + t) - 128 - 32 * ph - r32 + 4 * hi;
#pragma unroll
            for (int r = 0; r < 16; ++r) { const int rel = rel0 + (r & 3) + 8 * (r >> 2); if (rel < -128 || rel > 128) s0[r] = -1e30f; if (rel + 32 < -128 || rel + 32 > 128) s1[r] = -1e30f; }
        }
        float tm = fmaxf(s0[0], s1[0]);
#pragma unroll
        for (int r = 1; r < 16; ++r) tm = fmaxf(tm, fmaxf(s0[r], s1[r]));
        tm = fmaxf(tm, __shfl_xor(tm, 32));
        const float mn = fmaxf(m, tm), alpha = exp2f(m - mn); m = mn;
        float ps = 0.f;
#pragma unroll
        for (int r = 0; r < 16; ++r) { s0[r] = exp2f(s0[r] - mn); s1[r] = exp2f(s1[r] - mn); ps += s0[r] + s1[r]; }
        l = l * alpha + ps;
#pragma unroll
        for (int r = 0; r < 16; ++r) { o[0][r] *= alpha; o[1][r] *= alpha; }
        u32x4 pw[4];
#pragma unroll
        for (int q = 0; q < 4; ++q) { pw[0][q] = cvtpk(s0[2 * q], s0[2 * q + 1]); pw[1][q] = cvtpk(s0[8 + 2 * q], s0[8 + 2 * q + 1]); pw[2][q] = cvtpk(s1[2 * q], s1[2 * q + 1]); pw[3][q] = cvtpk(s1[8 + 2 * q], s1[8 + 2 * q + 1]); }
        { const lds_cptr vp = (lds_cptr)lds + 16384 + slot + ((lane >> 4) & 1) * 32 + (lane & 3) * 8 + (4 * hi + ((lane & 15) >> 2)) * 64;
#pragma unroll
          for (int d0 = 0; d0 < 2; ++d0)
#pragma unroll
            for (int ks = 0; ks < 4; ++ks) { const s16x4 lo = vtr(vp + d0 * 4096 + ks * 1024), hh = vtr(vp + d0 * 4096 + ks * 1024 + 512);
                const bf16x8 vf = (bf16x8){lo[0], lo[1], lo[2], lo[3], hh[0], hh[1], hh[2], hh[3]};
                o[d0] = __builtin_amdgcn_mfma_f32_32x32x16_bf16(vf, __builtin_bit_cast(bf16x8, pw[ks]), o[d0], 0, 0, 0); } }
        if (more) { const int ns = ((t + 1) & 1) * 8192; *(__attribute__((address_space(3))) u32x4*)(lds + ns + tid * 16) = kreg; *(__attribute__((address_space(3))) u32x4*)(lds + 16384 + ns + tid * 16) = vreg; }
        __syncthreads();
    }
#undef ATT_KROW0
    l += __shfl_xor(l, 32);
    const float inv = 1.f / l;
    bf16_t* op = MIXb + (size_t)qrow * D + head * 64 + 4 * hi;
#pragma unroll
    for (int d0 = 0; d0 < 2; ++d0)
#pragma unroll
        for (int g4 = 0; g4 < 4; ++g4) { u32x2 w; w.x = cvtpk(o[d0][4 * g4] * inv, o[d0][4 * g4 + 1] * inv); w.y = cvtpk(o[d0][4 * g4 + 2] * inv, o[d0][4 * g4 + 3] * inv);
            *(u32x2*)(op + 32 * d0 + 8 * g4) = w; }
}
}

constexpr int CONV_W_OFF = 65536;
using pg8::f32x4;
__device__ __forceinline__ void unpack8(const pg8::u32x4 p, float (&f)[8]) {
#pragma unroll
    for (int q = 0; q < 4; ++q) { f[2 * q] = __uint_as_float(p[q] << 16); f[2 * q + 1] = __uint_as_float(p[q] & 0xffff0000u); }
}
__device__ __forceinline__ void conv_fill_w(__attribute__((address_space(3))) unsigned char* lds, const float* __restrict__ cw, int tid) {
    __attribute__((address_space(3))) f32x4* wl = (__attribute__((address_space(3))) f32x4*)(lds + CONV_W_OFF);
    for (int e = tid; e < 31 * 128; e += 512) wl[e] = *(const f32x4*)(cw + (size_t)e * 4);
}
__device__ __forceinline__ void conv_tile(__attribute__((address_space(3))) unsigned char* lds, const bf16_t* __restrict__ Ub, bf16_t* __restrict__ MIXb, const float* __restrict__ sw,
                                          const float* __restrict__ cb, const float* __restrict__ ng, const float* __restrict__ nb, int tile, int tid_in) {
    typedef pg8::u32x4 u32x4;
    int tid = tid_in; asm volatile("" : "+v"(tid));
    const int lane = tid & 63, w = tid >> 6, c8 = 8 * lane;
    int base, t0, len;
    if (tile < 256) { base = (tile >> 7) * SEQ; t0 = (tile & 127) * 32; len = SEQ; } else { const int u2 = tile - 256; base = MLAT + (u2 >> 3) * CTXL; t0 = (u2 & 7) * 32; len = CTXL; }
#pragma unroll 2
    for (int q = 0; q < 8; ++q) {
        const int it = tid + 512 * q;
        if (it < 62 * 64) {
            const int tok = it >> 6, cg = (it & 63) * 8; const int tt = t0 - 15 + tok;
            u32x4 o = (u32x4){0u, 0u, 0u, 0u};
            if (tt >= 0 && tt < len) {
                const bf16_t* u = Ub + (size_t)(base + tt) * IN_DIM;
                const u32x4 a = *(const u32x4*)(u + UDA + cg), g = *(const u32x4*)(u + UDG + cg);
                float fa[8], fg[8]; unpack8(a, fa); unpack8(g, fg);
#pragma unroll
                for (int e = 0; e < 4; ++e) o[e] = pg8::cvt_pk_bf16(fa[2 * e] * sigmoid_f(fg[2 * e]), fa[2 * e + 1] * sigmoid_f(fg[2 * e + 1]));
            }
            *(__attribute__((address_space(3))) u32x4*)(lds + (size_t)(tok * 512 + cg) * 2) = o;
        }
    }
    asm volatile("" ::: "memory"); __builtin_amdgcn_sched_barrier(0);
    {
        float v[6][8];
#pragma unroll
        for (int k = 0; k < 6; ++k) { const int tt = t0 + 4 * w - 1 + k;
            if (tt >= 0 && tt < len) { const bf16_t* u = Ub + (size_t)(base + tt) * IN_DIM; float a[8], b[8]; unpack8(*(const u32x4*)(u + USC + c8), a); unpack8(*(const u32x4*)(u + USV + c8), b);
#pragma unroll
                for (int e = 0; e < 8; ++e) v[k][e] = a[e] * b[e]; }
            else {
#pragma unroll
                for (int e = 0; e < 8; ++e) v[k][e] = 0.f; } }
        float w0[8], w1[8], w2[8];
#pragma unroll
        for (int h2 = 0; h2 < 2; ++h2) { const f32x4 a = *(const f32x4*)(sw + c8 + 4 * h2), b = *(const f32x4*)(sw + 512 + c8 + 4 * h2), cc = *(const f32x4*)(sw + 1024 + c8 + 4 * h2);
#pragma unroll
            for (int e = 0; e < 4; ++e) { w0[4 * h2 + e] = a[e]; w1[4 * h2 + e] = b[e]; w2[4 * h2 + e] = cc[e]; } }
#pragma unroll
        for (int i = 0; i < 4; ++i) { const size_t row = (size_t)(base + t0 + 4 * w + i); float sb[8]; unpack8(*(const u32x4*)(Ub + row * IN_DIM + USB + c8), sb);
            u32x4 o;
#pragma unroll
            for (int e = 0; e < 4; ++e) o[e] = pg8::cvt_pk_bf16(sb[2 * e] * (w0[2 * e] * v[i][2 * e] + w1[2 * e] * v[i + 1][2 * e] + w2[2 * e] * v[i + 2][2 * e]),
                                                          sb[2 * e + 1] * (w0[2 * e + 1] * v[i][2 * e + 1] + w1[2 * e + 1] * v[i + 1][2 * e + 1] + w2[2 * e + 1] * v[i + 2][2 * e + 1]));
            *(u32x4*)(MIXb + row * D + 1024 + c8) = o; }
    }
    asm volatile("" ::: "memory"); __builtin_amdgcn_sched_barrier(0);
    __syncthreads();
    float z[4][8];
    {
        const f32x4 b0 = *(const f32x4*)(cb + c8), b1 = *(const f32x4*)(cb + c8 + 4);
#pragma unroll
        for (int i = 0; i < 4; ++i)
#pragma unroll
            for (int e = 0; e < 4; ++e) { z[i][e] = b0[e]; z[i][4 + e] = b1[e]; }
        float wq[4][8];
        const __attribute__((address_space(3))) f32x4* wl = (const __attribute__((address_space(3))) f32x4*)(lds + CONV_W_OFF);
#pragma unroll 1
        for (int ko = 0; ko < 9; ++ko) {
#pragma unroll
            for (int ki = 0; ki < 4; ++ki) {
                const int k = 4 * ko + ki;
                if (k < 34) {
                    if (k < 31) { const f32x4 a = wl[k * 128 + 2 * lane], b = wl[k * 128 + 2 * lane + 1];
#pragma unroll
                        for (int e = 0; e < 4; ++e) { wq[ki][e] = a[e]; wq[ki][4 + e] = b[e]; } }
                    float g[8]; unpack8(*(const __attribute__((address_space(3))) u32x4*)(lds + (size_t)((4 * w + k) * 512 + c8) * 2), g);
#pragma unroll
                    for (int i = 0; i < 4; ++i) { const int j = k - i; if (j >= 0 && j < 31) {
#pragma unroll
                        for (int e = 0; e < 8; ++e) z[i][e] += wq[(ki - i) & 3][e] * g[e]; } }
                }
            }
        }
    }
    {
        float gg[8], bb[8];
        { const f32x4 a = *(const f32x4*)(ng + c8), b = *(const f32x4*)(ng + c8 + 4), cc = *(const f32x4*)(nb + c8), d = *(const f32x4*)(nb + c8 + 4);
#pragma unroll
          for (int e = 0; e < 4; ++e) { gg[e] = a[e]; gg[4 + e] = b[e]; bb[e] = cc[e]; bb[4 + e] = d[e]; } }
#pragma unroll
        for (int i = 0; i < 4; ++i) {
            float s = 0.f;
#pragma unroll
            for (int e = 0; e < 8; ++e) s += z[i][e];
            const float mu = wave_sum(s) * (1.f / 512.f);
            float s2 = 0.f;
#pragma unroll
            for (int e = 0; e < 8; ++e) { const float d = z[i][e] - mu; s2 += d * d; }
            const float rstd = rsqrtf(wave_sum(s2) * (1.f / 512.f) + 1e-6f);
            u32x4 o;
#pragma unroll
            for (int e = 0; e < 4; ++e) { const float y0 = (z[i][2 * e] - mu) * rstd * gg[2 * e] + bb[2 * e], y1 = (z[i][2 * e + 1] - mu) * rstd * gg[2 * e + 1] + bb[2 * e + 1]; o[e] = pg8::cvt_pk_bf16(silu_f(y0), silu_f(y1)); }
            *(u32x4*)(MIXb + (size_t)(base + t0 + 4 * w + i) * D + 1536 + c8) = o;
        }
    }
    __syncthreads();
}

constexpr int NWAVES = 8;
constexpr int RING_OFF = 0, RING_BYTES = 131072;
constexpr int ROWS_OFF = 131072;
constexpr int ULIST_OFF = ROWS_OFF + 4096;
constexpr int ROPE_OFF = ULIST_OFF + 256;
constexpr int LDSCTL_OFF = ROPE_OFF + 8192, MISC_OFF = LDSCTL_OFF + 320;
constexpr int LDS_BYTES = 147456;
static_assert(MISC_OFF + 256 <= LDS_BYTES, "LDS map");

#define GAS __attribute__((address_space(1)))
#define LAS __attribute__((address_space(3)))
typedef unsigned v4u __attribute__((ext_vector_type(4)));
typedef GAS unsigned gu32;
#define RLX_AGENT __ATOMIC_RELAXED, __HIP_MEMORY_SCOPE_AGENT
#define LDS_WAIT() asm volatile("s_waitcnt lgkmcnt(0)" ::: "memory")
#define VM_WAIT() asm volatile("s_waitcnt vmcnt(0)" ::: "memory")
__device__ __forceinline__ unsigned pk2(float lo, float hi) { return (unsigned)f2bf(lo) | ((unsigned)f2bf(hi) << 16); }

#define XB_TMO      128
#define XB_XCNT(j)  (256  + 64 * (j))
#define XB_XSUB(j)  (1280 + 64 * (j))
#define XB_XGEN(j)  (2304 + 64 * (j))
#define XB_TOP      3328
#define XB_TOPGEN   3392
#define XCD_BAR_WORDS 3456
#define XB_SPIN_CAP (1u << 20)
__device__ __forceinline__ unsigned xb_ld(unsigned* p)              { return __hip_atomic_load(p, __ATOMIC_RELAXED, __HIP_MEMORY_SCOPE_AGENT); }
__device__ __forceinline__ unsigned xb_add(unsigned* p, unsigned v) { return __hip_atomic_fetch_add(p, v, __ATOMIC_RELAXED, __HIP_MEMORY_SCOPE_AGENT); }
__device__ __forceinline__ unsigned xb_xcc_id() { return (unsigned)__builtin_amdgcn_s_getreg((3 << 11) | 20) & 0xFu; }
#define XB_SPIN(cond, bar) do { unsigned _sp = 0; while (cond) { \
    if ((++_sp & 255u) == 0u) { if (xb_ld(&(bar)[XB_TMO])) break; if (_sp > XB_SPIN_CAP) { atomicAdd(&(bar)[XB_TMO], 1u); break; } } } } while (0)
struct XcdBarrier { unsigned* bar; unsigned x; volatile LAS unsigned* st; };
__device__ __forceinline__ XcdBarrier xcd_barrier_post(unsigned* bar, volatile LAS unsigned* st, bool leader) {
    XcdBarrier b; b.bar = bar; b.x = xb_xcc_id(); b.st = st;
    if (leader) (void)xb_add(&bar[XB_XCNT(b.x)], 1u);
    return b;
}
__device__ __forceinline__ void xcd_barrier_complete(unsigned* bar, unsigned x, unsigned& nloc, unsigned& nx) {
    const unsigned G = gridDim.x * gridDim.y * gridDim.z;
    unsigned sum, cnt, mine, sp = 0u;
    for (;;) {
        sum = 0u; cnt = 0u; mine = 0u;
#pragma unroll
        for (unsigned j = 0; j < 16; ++j) { const unsigned c = xb_ld(&bar[XB_XCNT(j)]); sum += c; cnt += (c > 0u) ? 1u : 0u; mine = (j == x) ? c : mine; }
        if (sum == G) break;
        __builtin_amdgcn_s_sleep(1);
        if ((++sp & 255u) == 0u) { if (xb_ld(&bar[XB_TMO])) break; if (sp > XB_SPIN_CAP) { atomicAdd(&bar[XB_TMO], 1u); break; } }
    }
    nloc = mine > 0u ? mine : 1u; nx = cnt > 0u ? cnt : 1u;
}
__device__ __forceinline__ void xcd_barrier(const XcdBarrier& b, bool leader) {
    asm volatile("s_waitcnt vmcnt(0)" ::: "memory");
    __syncthreads();
    if (leader) {
        unsigned* bar = b.bar;
        __builtin_amdgcn_s_waitcnt(0);
        unsigned nloc = b.st[0], nx = b.st[1];
        if (nloc == 0u) { xcd_barrier_complete(bar, b.x, nloc, nx); b.st[0] = nloc; b.st[1] = nx; }
        const unsigned old = xb_add(&bar[XB_XSUB(b.x)], 1u);
        const unsigned gen = old / nloc;
        if (old + 1u == (gen + 1u) * nloc) {
            __builtin_amdgcn_fence(__ATOMIC_RELEASE, "agent");
            asm volatile("s_waitcnt vmcnt(0)" ::: "memory");
            const unsigned og = xb_add(&bar[XB_TOP], 1u);
            const unsigned tg = og / nx;
            if (og + 1u == (tg + 1u) * nx) xb_add(&bar[XB_TOPGEN], 1u);
            else XB_SPIN(xb_ld(&bar[XB_TOPGEN]) == tg, bar);
            __builtin_amdgcn_fence(__ATOMIC_ACQUIRE, "agent");
            xb_add(&bar[XB_XGEN(b.x)], 1u);
            asm volatile("s_waitcnt vmcnt(0)" ::: "memory");
        } else {
            XB_SPIN(xb_ld(&bar[XB_XGEN(b.x)]) == gen, bar);
            __builtin_amdgcn_fence(__ATOMIC_ACQUIRE, "agent");
            asm volatile("s_waitcnt vmcnt(0)" ::: "memory");
        }
    }
    __syncthreads();
}

constexpr size_t WM_CTL = 0;
constexpr int CW_BAR = 4096;
constexpr size_t WM_WIN = 352 * MiB;
constexpr size_t WM_WOUT = 384 * MiB;
constexpr size_t WM_WGU = 400 * MiB;
constexpr size_t WM_WDN = 528 * MiB;
constexpr size_t WM_CS = 592 * MiB;
constexpr size_t WM_CSC = 656 * MiB;
constexpr size_t WM_WC = 657 * MiB;
constexpr size_t WM_PQT = 658 * MiB;
constexpr size_t WM_PQTC = 674 * MiB;
constexpr size_t WM_PART = 676 * MiB;
constexpr size_t WM_HIDB = 744 * MiB;
constexpr size_t WM_END = 768 * MiB;

struct MArgs { const float* in[24]; float* out; unsigned char* ws; int ph_lo, ph_hi, layer, use_bar; };

struct Frame {
    LAS unsigned char* lds; volatile LAS unsigned* MISC; unsigned* ctl;
    int wave, vcu, G;
};

__device__ __forceinline__ void p0_transpose_item(const float* W, int K, int N, bf16_t* WT, int n_row_base, LAS float* scr, int item, int lane) {
    const int nblk = N / 32, kb = item / nblk, nb = item % nblk, k0 = 64 * kb, n0 = 32 * nb;
    float tv[32];
    { const float* wp = W + (size_t)(k0 + (lane >> 5)) * N + n0 + (lane & 31);
#pragma unroll
      for (int i = 0; i < 32; ++i) tv[i] = __builtin_nontemporal_load(wp + (size_t)(2 * i) * N); }
#pragma unroll
    for (int i = 0; i < 32; ++i) scr[(2 * i + (lane >> 5)) * 33 + (lane & 31)] = tv[i];
    LDS_WAIT(); asm volatile("" ::: "memory");
    const int c = lane & 7;
#pragma unroll
    for (int j = 0; j < 4; ++j) { const int n = (lane >> 3) + 8 * j; const LAS float* s = scr + (8 * c) * 33 + n;
        v4u o; o.x = pk2(s[0 * 33], s[1 * 33]); o.y = pk2(s[2 * 33], s[3 * 33]); o.z = pk2(s[4 * 33], s[5 * 33]); o.w = pk2(s[6 * 33], s[7 * 33]);
        *(v4u*)(WT + (size_t)(n_row_base + n) * K + k0 + 8 * c) = o; }
    LDS_WAIT(); asm volatile("" ::: "memory");
}

__device__ __forceinline__ unsigned char* opq(unsigned char* p) { unsigned lo = (unsigned)(uintptr_t)p, hi = (unsigned)((uintptr_t)p >> 32); asm volatile("" : "+v"(lo), "+v"(hi)); lo = __builtin_amdgcn_readfirstlane(lo); hi = __builtin_amdgcn_readfirstlane(hi); return (unsigned char*)(((uintptr_t)hi << 32) | (uintptr_t)lo); }
__device__ __forceinline__ const char* opqc(const char* p) { return (const char*)opq((unsigned char*)p); }
__device__ __forceinline__ int opqv(int v) { asm volatile("" : "+v"(v)); return v; }
#define PHASE_PROLOG unsigned char* ws = opq(args.ws); const char* ka = opqc((const char*)__builtin_amdgcn_kernarg_segment_ptr()); const int lane = opqv(hw_lane_id()), tid = F.wave * 64 + lane; (void)ws; (void)ka; (void)lane; (void)tid
#define INP(k) (*(const float* const*)(ka + (k) * 8))

#ifdef PROBE_TA
#define PROBE_MARK(i) do { if (blockIdx.x == 0 && __builtin_amdgcn_readfirstlane((int)threadIdx.x) < 64 && hw_lane_id() == 0) ((volatile unsigned long long*)(probe_ws_ + WM_CTL + 512 * 1024))[32 + (i)] = __builtin_amdgcn_s_memrealtime(); } while (0)
#else
#define PROBE_MARK(i) do { } while (0)
#endif

__device__ __forceinline__ float wave_sum_dpp(float v) {
    v += __int_as_float(__builtin_amdgcn_update_dpp(0, __float_as_int(v), 0xB1, 0xf, 0xf, false));
    v += __int_as_float(__builtin_amdgcn_update_dpp(0, __float_as_int(v), 0x4E, 0xf, 0xf, false));
    v += __int_as_float(__builtin_amdgcn_update_dpp(0, __float_as_int(v), 0x141, 0xf, 0xf, false));
    v += __int_as_float(__builtin_amdgcn_update_dpp(0, __float_as_int(v), 0x140, 0xf, 0xf, false));
    const float r0 = __int_as_float(__builtin_amdgcn_readlane(__float_as_int(v), 0)), r1 = __int_as_float(__builtin_amdgcn_readlane(__float_as_int(v), 16));
    const float r2 = __int_as_float(__builtin_amdgcn_readlane(__float_as_int(v), 32)), r3 = __int_as_float(__builtin_amdgcn_readlane(__float_as_int(v), 48));
    return (r0 + r1) + (r2 + r3);
}
struct N2Ctx { const float* X; bf16_t* H; const float* g2; const float* modl; const float* wg; const float* we; const float* bg; const float* be; int* tok_e; float* tok_w; LAS int* sel; int row0; };
__device__ __forceinline__ void n2_pass(const N2Ctx& C, LAS float* wt, int rb, int lim, int wave, int lane, int tid, unsigned char* probe_ws_) {
    const int l4 = lane * 4;
    PROBE_MARK(0);
    int rw[5]; bool ok[5]; float rstd[5]; const float* shp[5];
#pragma unroll
    for (int i = 0; i < 5; ++i) { const int r = rb + wave + 8 * i; ok[i] = r < lim; rw[i] = ok[i] ? r : rb; shp[i] = C.modl + (size_t)modsel(rw[i]) * (NMOD * D) + 3 * D; }
    {
        pg8::f32x4 vn[8];
#pragma unroll
        for (int j = 0; j < 8; ++j) vn[j] = *(const pg8::f32x4*)(C.X + (size_t)rw[0] * D + l4 + 256 * j);
#pragma unroll
        for (int i = 0; i < 5; ++i) {
            pg8::f32x4 v[8]; float ss = 0.f;
#pragma unroll
            for (int j = 0; j < 8; ++j) v[j] = vn[j];
            if (i < 4) {
#pragma unroll
                for (int j = 0; j < 8; ++j) vn[j] = *(const pg8::f32x4*)(C.X + (size_t)rw[i + 1] * D + l4 + 256 * j); }
#pragma unroll
            for (int j = 0; j < 8; ++j) ss += v[j][0] * v[j][0] + v[j][1] * v[j][1] + v[j][2] * v[j][2] + v[j][3] * v[j][3];
            ss = wave_sum(ss);
            rstd[i] = rsqrtf(ss * (1.f / D) + 1e-6f);
            if (ok[i]) {
#pragma unroll
                for (int j = 0; j < 8; ++j) { const int col = l4 + 256 * j; const pg8::f32x4 g = *(const pg8::f32x4*)(C.g2 + col), a = *(const pg8::f32x4*)(shp[i] + D + col), b = *(const pg8::f32x4*)(shp[i] + col);
                    const pg8::f32x4 h = v[j] * rstd[i] * g * (a + 1.f) + b; pg8::u32x2 o; o.x = pk2(h[0], h[1]); o.y = pk2(h[2], h[3]); *(pg8::u32x2*)(C.H + (size_t)rw[i] * D + col) = o; }
            }
        }
    }
    PROBE_MARK(1);
    float lg[5][20];
#pragma unroll
    for (int i = 0; i < 5; ++i)
#pragma unroll
        for (int q = 0; q < 20; ++q) lg[i][q] = 0.f;
    {
        pg8::f32x4 xn[5], gn;
        gn = *(const pg8::f32x4*)(C.g2 + l4);
#pragma unroll
        for (int i = 0; i < 5; ++i) xn[i] = *(const pg8::f32x4*)(C.X + (size_t)rw[i] * D + l4);
#pragma unroll 1
        for (int jt = 0; jt < 8; ++jt) {
            const int half = jt >> 2, jj = jt & 3;
            if (jj == 0) {
                __syncthreads();
#pragma unroll
                for (int cc = 0; cc < 2; ++cc) { const int c = tid + 512 * cc; const int col = 1024 * half + c;
                    const pg8::f32x4 a = *(const pg8::f32x4*)(C.wg + (size_t)col * 4);
                    wt[0 * 1024 + c] = a[0]; wt[1 * 1024 + c] = a[1]; wt[2 * 1024 + c] = a[2]; wt[3 * 1024 + c] = a[3];
#pragma unroll
                    for (int q = 0; q < 4; ++q) { const pg8::f32x4 b = *(const pg8::f32x4*)(C.we + (size_t)col * 16 + q * 4);
                        wt[(4 + 4 * q) * 1024 + c] = b[0]; wt[(5 + 4 * q) * 1024 + c] = b[1]; wt[(6 + 4 * q) * 1024 + c] = b[2]; wt[(7 + 4 * q) * 1024 + c] = b[3]; } }
                __syncthreads();
            }
            const int cl = l4 + 256 * jj, col = 1024 * half + cl;
            const pg8::f32x4 g = gn;
            pg8::f32x4 h[5];
#pragma unroll
            for (int i = 0; i < 5; ++i) h[i] = xn[i];
            { const int coln = l4 + 256 * min(jt + 1, 7);
              gn = *(const pg8::f32x4*)(C.g2 + coln);
#pragma unroll
              for (int i = 0; i < 5; ++i) xn[i] = *(const pg8::f32x4*)(C.X + (size_t)rw[i] * D + coln); }
#pragma unroll
            for (int i = 0; i < 5; ++i) { const pg8::f32x4 a = *(const pg8::f32x4*)(shp[i] + D + col), b = *(const pg8::f32x4*)(shp[i] + col); h[i] = h[i] * rstd[i] * g * (a + 1.f) + b; }
#pragma unroll
            for (int q = 0; q < 20; ++q) { const pg8::f32x4 w = *(const LAS pg8::f32x4*)(wt + q * 1024 + cl);
#pragma unroll
                for (int i = 0; i < 5; ++i) lg[i][q] += h[i][0] * w[0] + h[i][1] * w[1] + h[i][2] * w[2] + h[i][3] * w[3]; }
        }
    }
    PROBE_MARK(2);
#pragma unroll
    for (int i = 0; i < 5; ++i)
#pragma unroll
        for (int q = 0; q < 20; ++q) lg[i][q] = wave_sum_dpp(lg[i][q]);
    PROBE_MARK(3);
    if (lane < 5) {
        int row = rw[0]; bool okr = ok[0];
#pragma unroll
        for (int i = 1; i < 5; ++i) { row = (lane == i) ? rw[i] : row; okr = (lane == i) ? ok[i] : okr; }
        if (okr) {
            float gl[4], el[16];
#pragma unroll
            for (int q = 0; q < 20; ++q) { float vq = lg[0][q];
#pragma unroll
                for (int i = 1; i < 5; ++i) vq = (lane == i) ? lg[i][q] : vq;
                if (q < 4) gl[q] = vq + C.bg[q]; else el[q - 4] = vq + C.be[q - 4]; }
            int gs = 0; float gm = gl[0];
#pragma unroll
            for (int q = 1; q < 4; ++q) if (gl[q] > gm) { gm = gl[q]; gs = q; }
            float den = 0.f;
#pragma unroll
            for (int q = 0; q < 4; ++q) den += __expf(gl[q] - gm);
            const float pg = 1.f / den;
            float eg[4];
#pragma unroll
            for (int q = 0; q < 4; ++q) eg[q] = gs == 0 ? el[q] : (gs == 1 ? el[4 + q] : (gs == 2 ? el[8 + q] : el[12 + q]));
            int i0 = 0; float m0 = eg[0];
#pragma unroll
            for (int q = 1; q < 4; ++q) if (eg[q] > m0) { m0 = eg[q]; i0 = q; }
            int i1 = -1; float m1 = -3.0e38f;
#pragma unroll
            for (int q = 0; q < 4; ++q) if (q != i0 && eg[q] > m1) { m1 = eg[q]; i1 = q; }
            const float w0 = 1.f / (1.f + __expf(m1 - m0)), w1 = 1.f - w0;
            const int e0 = gs * 4 + i0, e1 = gs * 4 + i1;
            C.tok_e[row * 2] = e0; C.tok_e[row * 2 + 1] = e1; C.tok_w[row * 2] = w0 * pg; C.tok_w[row * 2 + 1] = w1 * pg;
            C.sel[(row - C.row0) * 2] = e0; C.sel[(row - C.row0) * 2 + 1] = e1;
        }
    }
}

__global__ void __launch_bounds__(NWAVES * 64, 2) mega_fwd(MArgs args) {
    extern __shared__ __attribute__((aligned(16))) unsigned char lds_raw[];
    Frame F;
    F.lds = (LAS unsigned char*)lds_raw;
    F.MISC = (volatile LAS unsigned*)(F.lds + MISC_OFF);
    F.wave = __builtin_amdgcn_readfirstlane((int)threadIdx.x >> 6);
    F.G = gridDim.x; { const int bx = blockIdx.x; F.vcu = (F.G % 8 == 0) ? (bx % 8) * (F.G / 8) + bx / 8 : bx; }
    F.ctl = (unsigned*)(args.ws + WM_CTL);
    for (int u = threadIdx.x; u < (LDS_BYTES - LDSCTL_OFF) / 4; u += NWAVES * 64) ((LAS unsigned*)(F.lds + LDSCTL_OFF))[u] = 0u;
    __syncthreads();
    XcdBarrier bar; bar.bar = F.ctl + CW_BAR; bar.x = 0; bar.st = nullptr;
    if (args.use_bar) bar = xcd_barrier_post(F.ctl + CW_BAR, F.MISC + 8, threadIdx.x == 0);
#define GRID_BAR() do { if (args.use_bar) xcd_barrier(bar, F.wave == 0 && hw_lane_id() == 0); } while (0)
    const int lo = args.ph_lo, hi = args.ph_hi;
#ifdef PROBE_DUP
#define PC_OF(pi) ((pi) <= PROBE_DUP ? (pi) : (pi) - 1)
#else
#define PC_OF(pi) (pi)
#endif
    const int gw = F.vcu * NWAVES + F.wave, NGW = F.G * NWAVES;
#if defined(PROBE_TS) && !defined(PROBE_TA)
#define PROBE_TA PROBE_TS
#define PROBE_TB (PROBE_TS + 1)
#endif
#ifdef PROBE_TA
    volatile unsigned long long* ts_ = (volatile unsigned long long*)(args.ws + WM_CTL + 512 * 1024);
    if (blockIdx.x == 0 && F.wave == 0 && hw_lane_id() == 0) ts_[lo] = __builtin_amdgcn_s_memrealtime();
#endif
  for (int pi = lo; pi < hi; ++pi) {
    const int pc = PC_OF(pi);
    const int l = (pc >= 12 && pc < 23) ? 1 : 0;
    const int kk = (pc == 0) ? -1 : (pc == 23 ? -2 : pc - 1 - 11 * l);
    const int mrows = (l == 1) ? MLAT : MROWS;


#define x_in INP(0)
#define c_in INP(1)
#define ctx_in INP(2)
#define c_ctx INP(3)
#define w_mod INP(4)
#define b_mod INP(5)
#define w_in INP(8)
#define w_out INP(9)
#define w_gate INP(20)
#define w_up INP(21)
#define w_down INP(22)
#define modv   ((float*)(ws + WS_MOD))
#define rope   ((float*)(ws + WS_ROPE))
#define tok_w  ((float*)(ws + WS_TOK + 128 * 1024))
#define tok_e  ((int*)(ws + WS_TOK))
#define list   ((unsigned*)(ws + WS_LIST))
#define X      ((float*)(ws + WS_X))
#define H      ((bf16_t*)(ws + WS_H))
#define U      ((bf16_t*)(ws + WS_U))
#define MIX    ((bf16_t*)(ws + WS_MIX))
#define Y2     ((bf16_t*)(ws + WS_Y2))
#define Win_t  ((bf16_t*)(ws + WM_WIN))
#define Wout_t ((bf16_t*)(ws + WM_WOUT))
#define Wgu_t  ((bf16_t*)(ws + WM_WGU))
#define Wdn_t  ((bf16_t*)(ws + WM_WDN))
#define CS     ((bf16_t*)(ws + WM_CS))
#define CSC    ((bf16_t*)(ws + WM_CSC))
#define PEQO   ((bf16_t*)(ws + WM_CS + 16 * MiB))
#define AUXB   ((float*)(ws + WM_CS + 32 * MiB))
#define PARTC  ((float*)(ws + WM_CS + 33 * MiB))
#define WC     ((bf16_t*)(ws + WM_WC))
#define PQT    ((bf16_t*)(ws + WM_PQT))
#define PQTC   ((bf16_t*)(ws + WM_PQTC))
#define PART   ((float*)(ws + WM_PART))
#define HIDB   ((bf16_t*)(ws + WM_HIDB))
#define g_norm1 INP(6)
#define g_norm2 INP(7)
#define g_final INP(23)
#define w_rg INP(16)
#define b_rg INP(17)
#define w_re INP(18)
#define b_re INP(19)
    const PG8_LAS unsigned* rows_lds = (const PG8_LAS unsigned*)(F.lds + ROWS_OFF);
    LAS int* ulist = (LAS int*)(F.lds + ULIST_OFF);

    if (pc == 0) {
        PHASE_PROLOG;
        unsigned char* probe_ws_ = args.ws; (void)probe_ws_; PROBE_MARK(8);
        LAS float* ctab = (LAS float*)(F.lds + 67584); LAS float* stab = ctab + 4096;
        for (int i = tid; i < 4096; i += NWAVES * 64) { float s, c; sincospif((float)i * (1.f / 2048.f), &s, &c); ctab[i] = c; stab[i] = s; }
        __syncthreads();
#ifdef PROBE_P0
        for (int rep_ = 0; rep_ < (PROBE_P0 == 1 ? 2 : 1); ++rep_)
#endif
        for (int rt = F.vcu; rt < 2 * 2048; rt += F.G) {
            const int eo = rt >> 11, tp = rt & 2047;
            if (tid < 256) { const int k0 = tid * 8; float v[8];
#pragma unroll
                for (int q = 0; q < 8; ++q) { const float rev = (float)((tp * (k0 + q)) & 4095) * (1.f / 4096.f); v[q] = eo ? __builtin_amdgcn_sinf(rev) : __builtin_amdgcn_cosf(rev); }
                v4u o; o.x = pk2(v[0], v[1]); o.y = pk2(v[2], v[3]); o.z = pk2(v[4], v[5]); o.w = pk2(v[6], v[7]);
                *(v4u*)(CS + (size_t)rt * 2048 + k0) = o; }
        }
        PROBE_MARK(9);
        if (F.vcu == 1 % F.G) {
            for (int e = tid; e < 256 * 256; e += NWAVES * 64) { const int r = e >> 8, c = e & 255; const int part = r >> 7, cq = r & 127; float v = 0.f;
                if (c < 128) { const int idx = ((c * cq) & 127) * 32; v = part ? stab[idx] : ctab[idx]; } WC[e] = f2bf(v); }
        }
        if (F.vcu == 2 % F.G) {
            for (int e = tid; e < 256 * 512; e += NWAVES * 64) { const int tp = e >> 9, k = e & 511; const int part = k >> 8; const int idx = ((tp * (k & 255)) & 255) * 16;
                CSC[e] = f2bf(part ? -stab[idx] : ctab[idx]); }
        }
        if (F.vcu == 3 % F.G) {
            for (int e = tid; e < 64 * 16; e += NWAVES * 64) { const int pos = e >> 4, i = e & 15; const float freq = powf(10000.f, -(float)(2 * i) / 32.f); const float ang = (float)pos * freq;
                rope[e * 2] = cosf(ang); rope[e * 2 + 1] = sinf(ang); }
        }
        __syncthreads();
        PROBE_MARK(10);
        {
            LAS float* sl = (LAS float*)(F.lds + 67584);
            for (int e = tid; e < 3 * D; e += NWAVES * 64) { const int sidx = e / D, k = e % D; sl[e] = silu_f(sidx == 0 ? c_in[k] : (sidx == 1 ? c_in[D + k] : c_ctx[k])); }
            __syncthreads();
#ifdef PROBE_P0
            for (int rep_ = 0; rep_ < (PROBE_P0 == 2 ? 2 : 1); ++rep_)
#endif
            for (int it = blockIdx.x; it < 256; it += F.G) {
                const int l = it >> 7, j0 = (it & 127) * 96;
                LAS float* red = (LAS float*)(F.lds + 67584 + 32768);
                const int gq = lane / 24, lq = lane - 24 * gq;
                pg8::f32x4 a0 = {0.f, 0.f, 0.f, 0.f}, a1 = a0, a2 = a0;
                if (lane < 48) {
                    const float* w = w_mod + ((size_t)l * D + (size_t)F.wave * 256 + gq) * (NMOD * D) + j0 + 4 * lq;
#pragma unroll 16
                    for (int i0_ = 0; i0_ < 128; ++i0_) { const int i = (i0_ + it) & 127; const int kk = F.wave * 256 + 2 * i + gq;
                        const pg8::f32x4 wv = __builtin_nontemporal_load((const pg8::f32x4*)(w + (size_t)(2 * i) * (NMOD * D)));
                        const float s0 = sl[kk], s1 = sl[D + kk], s2 = sl[2 * D + kk];
                        a0 += wv * s0; a1 += wv * s1; a2 += wv * s2; }
                    LAS float* rp = red + (size_t)((F.wave * 2 + gq) * 3) * 96 + 4 * lq;
#pragma unroll
                    for (int e = 0; e < 4; ++e) { rp[e] = a0[e]; rp[96 + e] = a1[e]; rp[192 + e] = a2[e]; }
                }
                __syncthreads();
                if (tid < 288) { const int s = tid / 96, j = tid % 96; float v = b_mod[l * NMOD * D + j0 + j];
#pragma unroll
                    for (int w = 0; w < 16; ++w) v += red[(w * 3 + s) * 96 + j];
                    modv[((size_t)l * 3 + s) * (NMOD * D) + j0 + j] = v; }
                __syncthreads();
            }
        }
        PROBE_MARK(11);
        {
            LAS float* scr = (LAS float*)(F.lds + F.wave * 8448);
            const int gw = F.vcu * NWAVES + F.wave, NGW = F.G * NWAVES;
            constexpr int I_IN = (D / 64) * (IN_DIM / 32), I_OUT = (D / 64) * (D / 32), I_GU = (D / 64) * (DEXP / 32), I_DN = (DEXP / 64) * (D / 32);
            constexpr int PER_L = I_IN + I_OUT + NEXP * (2 * I_GU + I_DN);
#ifdef PROBE_P0
            for (int rep_ = 0; rep_ < (PROBE_P0 == 3 ? 2 : 1); ++rep_)
#endif
            for (int it = gw; it < 2 * PER_L; it += NGW) {
                const int l = it / PER_L; int r = it % PER_L;
                if (r < I_IN) { const int nb = r % (IN_DIM / 32); p0_transpose_item(w_in + (size_t)l * D * IN_DIM, D, IN_DIM, Win_t + (size_t)l * IN_DIM * D, nb * 32, scr, r, lane); continue; } r -= I_IN;
                if (r < I_OUT) { const int nb = r % (D / 32); p0_transpose_item(w_out + (size_t)l * D * D, D, D, Wout_t + (size_t)l * D * D, nb * 32, scr, r, lane); continue; } r -= I_OUT;
                const int e = r / (2 * I_GU + I_DN); r %= (2 * I_GU + I_DN);
                const size_t le = (size_t)l * NEXP + e;
                if (r < 2 * I_GU) { const int up = r >= I_GU; if (up) r -= I_GU; const int nb = r % (DEXP / 32); const int n0 = nb * 32;
                    const int rowb = (n0 >> 7) * 256 + (n0 & 127) + up * 128;
                    p0_transpose_item((up ? w_up : w_gate) + le * D * DEXP, D, DEXP, Wgu_t + le * (2 * DEXP) * D, rowb, scr, r, lane); continue; } r -= 2 * I_GU;
                { const int nb = r % (D / 32); p0_transpose_item(w_down + le * DEXP * D, DEXP, D, Wdn_t + le * D * DEXP, nb * 32, scr, r, lane); }
            }
        }
    }


    if (kk == 0) {
        PHASE_PROLOG; const float* modl = modv + (size_t)l * 3 * NMOD * D; (void)modl;
        const float* g1 = g_norm1 + l * D;
        const int l4 = lane * 4;
#define N1_SRC(row) ((l == 0) ? ((row) < MLAT ? x_in + (size_t)(row) * D : ctx_in + (size_t)((row) - MLAT) * D) : X + (size_t)(row) * D)
        f32x4 vn[8]; pg8::u32x2 yn0[8], yn1[8];
        int row = gw;
        { const int r0 = min(row, MROWS - 1); const float* src = N1_SRC(r0);
#pragma unroll
            for (int j = 0; j < 8; ++j) vn[j] = *(const f32x4*)(src + l4 + 256 * j);
#pragma unroll
            for (int j = 0; j < 8; ++j) { yn0[j] = (pg8::u32x2){0u, 0u}; yn1[j] = (pg8::u32x2){0u, 0u}; }
            if (l == 1) {
#pragma unroll
                for (int j = 0; j < 8; ++j) { yn0[j] = *(const pg8::u32x2*)(Y2 + (size_t)(2 * r0) * D + l4 + 256 * j); yn1[j] = *(const pg8::u32x2*)(Y2 + (size_t)(2 * r0 + 1) * D + l4 + 256 * j); } } }
#pragma unroll 1
        for (; row < MROWS; row += NGW) {
            const int l4 = opqv(lane * 4);
            const int s = modsel(row);
            f32x4 v[8]; pg8::u32x2 y0[8], y1[8];
#pragma unroll
            for (int j = 0; j < 8; ++j) { v[j] = vn[j]; y0[j] = yn0[j]; y1[j] = yn1[j]; }
            const int nrow = min(row + NGW, MROWS - 1);
            { const float* src = N1_SRC(nrow);
#pragma unroll
                for (int j = 0; j < 8; ++j) vn[j] = *(const f32x4*)(src + l4 + 256 * j);
                if (l == 1) {
#pragma unroll
                    for (int j = 0; j < 8; ++j) { yn0[j] = *(const pg8::u32x2*)(Y2 + (size_t)(2 * nrow) * D + l4 + 256 * j); yn1[j] = *(const pg8::u32x2*)(Y2 + (size_t)(2 * nrow + 1) * D + l4 + 256 * j); } } }
            if (l == 1) {
                const float* ga = modv + (size_t)s * (NMOD * D) + 5 * D;
#pragma unroll
                for (int j = 0; j < 8; ++j) { const int col = l4 + 256 * j; const f32x4 g = *(const f32x4*)(ga + col);
                    v[j][0] += g[0] * (__uint_as_float(y0[j].x << 16) + __uint_as_float(y1[j].x << 16)); v[j][1] += g[1] * (__uint_as_float(y0[j].x & 0xffff0000u) + __uint_as_float(y1[j].x & 0xffff0000u));
                    v[j][2] += g[2] * (__uint_as_float(y0[j].y << 16) + __uint_as_float(y1[j].y << 16)); v[j][3] += g[3] * (__uint_as_float(y0[j].y & 0xffff0000u) + __uint_as_float(y1[j].y & 0xffff0000u));
                    *(f32x4*)(X + (size_t)row * D + col) = v[j]; }
            }
            float ss = 0.f;
#pragma unroll
            for (int j = 0; j < 8; ++j) ss += v[j][0] * v[j][0] + v[j][1] * v[j][1] + v[j][2] * v[j][2] + v[j][3] * v[j][3];
            ss = wave_sum(ss);
            const float rstd = rsqrtf(ss * (1.f / D) + 1e-6f);
            const float* sh = modl + (size_t)s * (NMOD * D); const float* sc = sh + D;
#pragma unroll
            for (int j = 0; j < 8; ++j) { const int col = l4 + 256 * j; const f32x4 g = *(const f32x4*)(g1 + col), a = *(const f32x4*)(sc + col), b = *(const f32x4*)(sh + col);
                const f32x4 h = v[j] * rstd * g * (a + 1.f) + b; pg8::u32x2 o; o.x = pk2(h[0], h[1]); o.y = pk2(h[2], h[3]); *(pg8::u32x2*)(H + (size_t)row * D + col) = o; }
        }
#undef N1_SRC
    }
    if (kk == 1) {
        PHASE_PROLOG; const float* modl = modv + (size_t)l * 3 * NMOD * D; (void)modl;
        pg8::Prob P{H, Win_t + (size_t)l * IN_DIM * D, D, D, D, 0, (long long)256 * D, 0, 0, (long long)256 * D, 0, 0};
        pg8::StaticOrder S; S.init(MROWS / 256, IN_DIM / 256, F.G, (int)blockIdx.x);
        for (int e = tid; e < 2048; e += NWAVES * 64) ((LAS float*)(F.lds + ROPE_OFF))[e] = rope[e];
        __syncthreads();
        pg8::EpiG1 E{U, (const PG8_LAS float*)(F.lds + ROPE_OFF)};
        pg8::gemm_phase<pg8::EpiG1, pg8::StaticOrder, false, true>(F.lds + RING_OFF, P, S, E, rows_lds, F.wave);
    }
    if (kk == 2) {
        PHASE_PROLOG; const float* modl = modv + (size_t)l * 3 * NMOD * D; (void)modl;
        { unsigned char* probe_ws_ = args.ws; (void)probe_ws_; PROBE_MARK(16); }
        const int NT = mrows / 256;
        pg8::Prob P{WC, U + UF, 256, IN_DIM, 256, 0, 0, 0, 0, (long long)256 * IN_DIM, 128, 0};
        pg8::DftASched S{4 * NT, F.G, (int)blockIdx.x, 0};
        pg8::EpiDftA E{PQT, PQTC};
#ifdef PROBE_SUB
        for (int rep_ = 0; rep_ < (PROBE_SUB == 3 ? 2 : 1); ++rep_)
#endif
        pg8::gemm_phase<pg8::EpiDftA, pg8::DftASched, false, true>(F.lds + RING_OFF, P, S, E, rows_lds, F.wave);
        __syncthreads();
        { unsigned char* probe_ws_ = args.ws; (void)probe_ws_; PROBE_MARK(17); }
        {
            const int nun = (l == 0) ? 272 : 256;
#ifdef PROBE_SUB
            for (int rep_ = 0; rep_ < (PROBE_SUB == 1 ? 2 : 1); ++rep_)
#endif
            for (int un = blockIdx.x; un < 256; un += F.G) att::attn_unit(F.lds + RING_OFF, U, MIX, INP(10) + l * 8, un, tid);
            { const int first = (F.G >= 152) ? 136 : 0; for (int un = 256 + (int)blockIdx.x - first; un >= 256 && un < nun; un += F.G) att::attn_unit(F.lds + RING_OFF, U, MIX, INP(10) + l * 8, un, tid); }
        }

        { unsigned char* probe_ws_ = args.ws; (void)probe_ws_; PROBE_MARK(18); }
        {
            const int nti = (l == 0) ? 272 : 256;
            { __syncthreads(); conv_fill_w(F.lds + RING_OFF, INP(12) + l * 31 * 512, tid); }
#ifdef PROBE_SUB
            for (int rep_ = 0; rep_ < (PROBE_SUB == 2 ? 2 : 1); ++rep_)
#endif
            for (int ti = blockIdx.x; ti < 256; ti += F.G) conv_tile(F.lds + RING_OFF, U, MIX, INP(11) + l * 3 * 512, INP(13) + l * 512, INP(14) + l * 512, INP(15) + l * 512, ti, tid);
            { const int first = (F.G >= 168) ? 152 : 0; for (int ti = 256 + (int)blockIdx.x - first; ti >= 256 && ti < nti; ti += F.G) conv_tile(F.lds + RING_OFF, U, MIX, INP(11) + l * 3 * 512, INP(13) + l * 512, INP(14) + l * 512, INP(15) + l * 512, ti, tid); }
        }
    }
    if (kk == 3) {
        PHASE_PROLOG;
        if (l == 0) {
            pg8::Prob P{CSC, PQTC, 2 * CTXL, 2 * CTXL, 2 * CTXL, 0, 0, 0, 0, (long long)256 * 2 * CTXL, (long long)512 * 2 * CTXL, 0};
            pg8::DftBSched S{4, F.G, (int)blockIdx.x, 1};
            pg8::EpiDftB E{PARTC - (size_t)MLAT * 512, MLAT, 0, CTXL};
            pg8::gemm_phase<pg8::EpiDftB, pg8::DftBSched, false, true>(F.lds + RING_OFF, P, S, E, rows_lds, F.wave);
            __syncthreads();
        }
        LAS unsigned short* rowbuf = (LAS unsigned short*)(F.lds + RING_OFF) + F.wave * 8192;
#pragma unroll 1
        for (int it = gw; it < 2 * 512; it += NGW) {
            const int ln = opqv(lane);
            const bf16_t* src = PQT + (size_t)it * 8192;
            pg8::u32x4 rv[16];
#pragma unroll
            for (int i = 0; i < 16; ++i) rv[i] = *(const pg8::u32x4*)(src + (size_t)(ln + 64 * i) * 8);
#pragma unroll
            for (int i = 0; i < 16; ++i) *(LAS pg8::u32x4*)(rowbuf + (ln + 64 * i) * 8) = rv[i];
            LDS_WAIT(); asm volatile("" ::: "memory");
            const int b = it >> 9, n = it & 511;
            bf16_t* pe_row = PEQO + (size_t)((b * 2 + 0) * 512 + n) * 2048; bf16_t* qo_row = PEQO + (size_t)((b * 2 + 1) * 512 + n) * 2048;
            float alt = 0.f;
#pragma unroll
            for (int i = 0; i < 4; ++i) {
                const int t0 = 8 * (ln + 64 * i);
                float p8[8], q8[8], pm[8], qm[8];
                unpack8(*(const LAS pg8::u32x4*)(rowbuf + t0), p8); unpack8(*(const LAS pg8::u32x4*)(rowbuf + 4096 + t0), q8);
                unpack8(*(const LAS pg8::u32x4*)(rowbuf + 4096 - t0 - 8), pm); unpack8(*(const LAS pg8::u32x4*)(rowbuf + 8192 - t0 - 8), qm);
                const float pm0 = bf2f(rowbuf[4096 - t0]), qm0 = bf2f(rowbuf[(8192 - t0) & 8191]);
                float pe[8], qo[8];
                pe[0] = (t0 == 0) ? p8[0] : p8[0] + pm0; qo[0] = (t0 == 0) ? 0.f : q8[0] - qm0;
#pragma unroll
                for (int j = 1; j < 8; ++j) { pe[j] = p8[j] + pm[8 - j]; qo[j] = q8[j] - qm[8 - j]; }
#pragma unroll
                for (int j = 0; j < 8; ++j) alt += (j & 1) ? -pe[j] : pe[j];
                pg8::u32x4 o1, o2;
#pragma unroll
                for (int e = 0; e < 4; ++e) { o1[e] = pg8::cvt_pk_bf16(pe[2 * e], pe[2 * e + 1]); o2[e] = pg8::cvt_pk_bf16(qo[2 * e], qo[2 * e + 1]); }
                *(pg8::u32x4*)(pe_row + t0) = o1; *(pg8::u32x4*)(qo_row + t0) = o2;
            }
            const float ph = bf2f(rowbuf[2048]);
            alt = wave_sum(alt) + ph;
            if (ln == 0) { AUXB[b * 1024 + n] = alt; AUXB[b * 1024 + 512 + n] = ph; }
            asm volatile("" ::: "memory");
        }
        __syncthreads();
    }
    if (kk == 4) {
        PHASE_PROLOG;
        pg8::Prob P{CS, PEQO, 2048, 2048, 512, 0, (long long)256 * 2048, 0, 512, (long long)256 * 2048, (long long)2 * 512 * 2048, 512};
        pg8::DftB2Sched S{256, F.G, (int)blockIdx.x, 0};
        pg8::EpiDftB2 E{PART};
        pg8::gemm_phase<pg8::EpiDftB2, pg8::DftB2Sched, false, true>(F.lds + RING_OFF, P, S, E, rows_lds, F.wave);
    }
    if (kk == 5) {
        PHASE_PROLOG;
        float sc_lat = 0.001381067932f, sc_ctx = 0.005524271728f;
        asm volatile("" : "+v"(sc_lat), "+v"(sc_ctx));
        for (int it = blockIdx.x * (NWAVES * 64) + tid; it < 2 * 2048 * 128; it += F.G * NWAVES * 64) {
            const int b = it >> 18, tp = (it >> 7) & 2047, n = (it & 127) * 4;
            f32x4 e = {0.f, 0.f, 0.f, 0.f}, o = e;
#pragma unroll
            for (int sp = 0; sp < 4; ++sp) { e += *(const f32x4*)(PART + ((size_t)(((sp * 2 + 0) * 2 + b) * 2048 + tp)) * 512 + n); o += *(const f32x4*)(PART + ((size_t)(((sp * 2 + 1) * 2 + b) * 2048 + tp)) * 512 + n); }
            f32x4 ph = *(const f32x4*)(AUXB + b * 1024 + 512 + n); if (tp & 1) ph = -ph;
            const f32x4 o1 = (e - o + ph) * sc_lat;
            f32x4 o2 = (e + o + ph) * sc_lat;
            if (tp == 0) o2 = *(const f32x4*)(AUXB + b * 1024 + n) * sc_lat;
            const int r2 = (tp == 0) ? 2048 : SEQ - tp;
            pg8::u32x2 w1, w2; w1.x = pk2(o1[0], o1[1]); w1.y = pk2(o1[2], o1[3]); w2.x = pk2(o2[0], o2[1]); w2.y = pk2(o2[2], o2[3]);
            *(pg8::u32x2*)(MIX + (size_t)(b * SEQ + tp) * D + 512 + n) = w1;
            *(pg8::u32x2*)(MIX + (size_t)(b * SEQ + r2) * D + 512 + n) = w2;
        }
        if (l == 0) {
            for (int it = blockIdx.x * (NWAVES * 64) + tid; it < MCTX * 128; it += F.G * NWAVES * 64) {
                const int r = it >> 7, n = (it & 127) * 4;
                const f32x4 a = *(const f32x4*)(PARTC + (size_t)r * 512 + n) * sc_ctx;
                pg8::u32x2 w; w.x = pk2(a[0], a[1]); w.y = pk2(a[2], a[3]); *(pg8::u32x2*)(MIX + (size_t)(MLAT + r) * D + 512 + n) = w;
            }
        }
    }
    if (kk == 6) {
        PHASE_PROLOG; const float* modl = modv + (size_t)l * 3 * NMOD * D; (void)modl;
        pg8::Prob P{MIX, Wout_t + (size_t)l * D * D, D, D, D, 0, (long long)256 * D, 0, 0, (long long)256 * D, 0, 0};
        pg8::StaticOrder S; S.init(mrows / 256, D / 256, F.G, (int)blockIdx.x);
        pg8::EpiG2 E{X, l == 0 ? x_in : X, l == 0 ? ctx_in : X + (size_t)MLAT * D, modl};
        pg8::gemm_phase<pg8::EpiG2, pg8::StaticOrder, false, true>(F.lds + RING_OFF, P, S, E, rows_lds, F.wave);
    }
    if (kk == 7) {
        PHASE_PROLOG; const float* modl = modv + (size_t)l * 3 * NMOD * D; (void)modl;
        LAS int* sel = (LAS int*)(F.lds + RING_OFF + 81920);
        LAS float* wt = (LAS float*)(F.lds + RING_OFF);
        unsigned* cnt = F.ctl + 2048 + 1024 * l;
        const int nr = (mrows + F.G - 1) / F.G;
        const int rbeg = F.vcu * nr, rend = min(mrows, rbeg + nr);
        for (int rb = rbeg; rb < rend; rb += 40) {
            const int lim = min(rend, rb + 40);
            N2Ctx C{X, H, g_norm2 + l * D, modl, w_rg + (size_t)l * D * 4, w_re + (size_t)l * D * 16, b_rg + l * 4, b_re + l * 16, tok_e, tok_w, sel, rb};
            n2_pass(C, wt, rb, lim, F.wave, lane, tid, args.ws);
            { unsigned char* probe_ws_ = args.ws; (void)probe_ws_; PROBE_MARK(4); }
            __syncthreads();
            if (F.wave < 2) {
                const int ln = opqv(lane); const int nrw = lim - rb; const int slot = F.wave;
                const int e = (ln < nrw) ? sel[ln * 2 + slot] : -1;
                int rank = 0, mycnt = 0;
#pragma unroll
                for (int x = 0; x < NEXP; ++x) { const unsigned long long m = __ballot(e == x); if (e == x) rank = __popcll(m & ((1ull << ln) - 1ull)); if (ln == x) mycnt = __popcll(m); }
                unsigned base = 0u;
                if (ln < NEXP && mycnt > 0) base = atomicAdd(cnt + 64 * ln, (unsigned)mycnt);
                const unsigned mybase = (unsigned)__shfl((int)base, e < 0 ? 0 : e);
                if (e >= 0) list[(size_t)e * (2 * MROWS) + mybase + rank] = (unsigned)((rb + ln) * 2 + slot);
            }
            __syncthreads();
            { unsigned char* probe_ws_ = args.ws; (void)probe_ws_; PROBE_MARK(5); }
        }
        __syncthreads();
    }
    if (kk == 8 || kk == 9 || kk == 10) {
        PHASE_PROLOG;
        const unsigned* cnt = F.ctl + 2048 + 1024 * l;
        __syncthreads();
        if (tid == 0) { LAS int* pre = ulist + 40; pre[0] = 0;
            for (int e = 0; e < NEXP; ++e) pre[e + 1] = pre[e] + (int)((__hip_atomic_load(cnt + 64 * e, RLX_AGENT) + 255u) >> 8); }
        __syncthreads();
        const int T = __builtin_amdgcn_readfirstlane(ulist[40 + NEXP]);
        const int G = F.G, bid = (int)blockIdx.x;
        const int NU = 4 * T, ND = 8 * T;
        const int nheavy = min(G, max(0, NU - G)), nlight = G - nheavy;
        const bool lightB = nlight >= G / 4;
        const int Te = lightB ? min(T, G / 4) : 0;
        int ufirst = 0, ustride = 1, ulimit = 0, kind = 0;
        if (kk == 8) { kind = 0; ufirst = bid; ustride = G; ulimit = min(NU, G); }
        else if (kk == 9) { if (bid < nheavy) { kind = 0; ufirst = bid + G; ustride = G; ulimit = NU; }
                            else if (lightB) { kind = 1; ufirst = bid - nheavy; ustride = nlight; ulimit = 8 * Te; } }
        else { kind = 1; ufirst = 8 * Te + bid; ustride = G; ulimit = ND; }
        const int NPN = kind ? 8 : 4;
        for (int u0 = ufirst; u0 < ulimit; u0 += 4 * ustride) {
            __syncthreads();
            if (tid == 0) { const LAS int* pre = ulist + 40; int n = 0;
                for (int i = 0; i < 4; ++i) { const int L = u0 + i * ustride; if (L >= ulimit) break; const int tau = L / NPN; int e = 0; while (pre[e + 1] <= tau) ++e;
                    ulist[n * 4] = tau; ulist[n * 4 + 1] = L % NPN; ulist[n * 4 + 2] = e; ulist[n * 4 + 3] = tau - pre[e]; ++n; }
                ulist[32] = n; }
            __syncthreads();
            const int nu = __builtin_amdgcn_readfirstlane(ulist[32]);
            for (int i = 0; i < nu; ++i) { const int e = ulist[i * 4 + 2], rt = ulist[i * 4 + 3]; const unsigned ce = __hip_atomic_load(cnt + 64 * e, RLX_AGENT);
                for (int r = tid; r < 256; r += NWAVES * 64) { const unsigned idx = (unsigned)rt * 256u + (unsigned)r; ((LAS unsigned*)(F.lds + ROWS_OFF))[i * 256 + r] = idx < ce ? list[(size_t)e * (2 * MROWS) + idx] : 0xFFFFFFFFu; } }
            __syncthreads();
            pg8::ListSched S{(const PG8_LAS int*)ulist, nu};
            if (kind == 0) {
                pg8::Prob P{H, Wgu_t + (size_t)l * NEXP * (2 * DEXP) * D, D, D, D, 0, 0, 0, 0, (long long)256 * D, (long long)(2 * DEXP) * D, 0};
                pg8::EpiMoeUp E{HIDB, tok_w, rows_lds};
                pg8::gemm_phase<pg8::EpiMoeUp, pg8::ListSched, true, true>(F.lds + RING_OFF, P, S, E, rows_lds, F.wave);
            } else {
                pg8::Prob P{HIDB, Wdn_t + (size_t)l * NEXP * D * DEXP, DEXP, DEXP, DEXP, 0, (long long)256 * DEXP, 0, 0, (long long)256 * DEXP, (long long)D * DEXP, 0};
                pg8::EpiMoeDown E{Y2, rows_lds};
                pg8::gemm_phase<pg8::EpiMoeDown, pg8::ListSched, false, true>(F.lds + RING_OFF, P, S, E, rows_lds, F.wave);
            }
        }
    }
    if (kk == -2) {
        PHASE_PROLOG;
        const float* modl1 = modv + (size_t)3 * NMOD * D;
        const int l4 = lane * 4;
        f32x4 vn[8]; pg8::u32x2 yn0[8], yn1[8];
        int row = gw;
        { const int r0 = min(row, MLAT - 1);
#pragma unroll
            for (int j = 0; j < 8; ++j) { vn[j] = *(const f32x4*)(X + (size_t)r0 * D + l4 + 256 * j); yn0[j] = *(const pg8::u32x2*)(Y2 + (size_t)(2 * r0) * D + l4 + 256 * j); yn1[j] = *(const pg8::u32x2*)(Y2 + (size_t)(2 * r0 + 1) * D + l4 + 256 * j); } }
#pragma unroll 1
        for (; row < MLAT; row += NGW) {
            const int l4 = opqv(lane * 4);
            const int s = modsel(row);
            const float* ga = modl1 + (size_t)s * (NMOD * D) + 5 * D;
            f32x4 v[8]; pg8::u32x2 y0[8], y1[8];
#pragma unroll
            for (int j = 0; j < 8; ++j) { v[j] = vn[j]; y0[j] = yn0[j]; y1[j] = yn1[j]; }
            const int nrow = min(row + NGW, MLAT - 1);
            {
#pragma unroll
                for (int j = 0; j < 8; ++j) { vn[j] = *(const f32x4*)(X + (size_t)nrow * D + l4 + 256 * j); yn0[j] = *(const pg8::u32x2*)(Y2 + (size_t)(2 * nrow) * D + l4 + 256 * j); yn1[j] = *(const pg8::u32x2*)(Y2 + (size_t)(2 * nrow + 1) * D + l4 + 256 * j); } }
            float ss = 0.f;
#pragma unroll
            for (int j = 0; j < 8; ++j) { const int col = l4 + 256 * j; const f32x4 g = *(const f32x4*)(ga + col);
                v[j][0] += g[0] * (__uint_as_float(y0[j].x << 16) + __uint_as_float(y1[j].x << 16)); v[j][1] += g[1] * (__uint_as_float(y0[j].x & 0xffff0000u) + __uint_as_float(y1[j].x & 0xffff0000u));
                v[j][2] += g[2] * (__uint_as_float(y0[j].y << 16) + __uint_as_float(y1[j].y << 16)); v[j][3] += g[3] * (__uint_as_float(y0[j].y & 0xffff0000u) + __uint_as_float(y1[j].y & 0xffff0000u));
                ss += v[j][0] * v[j][0] + v[j][1] * v[j][1] + v[j][2] * v[j][2] + v[j][3] * v[j][3]; }
            ss = wave_sum(ss);
            const float rstd = rsqrtf(ss * (1.f / D) + 1e-6f);
#pragma unroll
            for (int j = 0; j < 8; ++j) { const int col = l4 + 256 * j; const f32x4 g = *(const f32x4*)(g_final + col); *(f32x4*)(args.out + (size_t)row * D + col) = v[j] * rstd * g; }
        }
    }
    if (pi + 1 < hi) GRID_BAR();
#ifdef PROBE_TA
    if (blockIdx.x == 0 && F.wave == 0 && hw_lane_id() == 0) ts_[pi + 1] = __builtin_amdgcn_s_memrealtime();
#endif
  }
#ifdef PROBE_TA
    if (blockIdx.x == 0 && F.wave == 0 && hw_lane_id() == 0) {
        const unsigned long long dt = ts_[PROBE_TB] - ts_[PROBE_TA]; const unsigned long long t0 = __builtin_amdgcn_s_memrealtime();
        while (__builtin_amdgcn_s_memrealtime() - t0 < 4ull * dt) __builtin_amdgcn_s_sleep(8);
    }
#endif
#undef x_in
#undef c_in
#undef ctx_in
#undef c_ctx
#undef w_mod
#undef b_mod
#undef w_in
#undef w_out
#undef w_gate
#undef w_up
#undef w_down
#undef modv
#undef rope
#undef tok_w
#undef tok_e
#undef list
#undef X
#undef H
#undef U
#undef MIX
#undef Y2
#undef Win_t
#undef Wout_t
#undef Wgu_t
#undef Wdn_t
#undef CS
#undef CSC
#undef PEQO
#undef AUXB
#undef PARTC
#undef WC
#undef PQT
#undef PQTC
#undef PART
#undef HIDB
#undef g_norm1
#undef g_norm2
#undef g_final
#undef w_rg
#undef b_rg
#undef w_re
#undef b_re
#undef PC_OF
#undef GRID_BAR
}

static int g_grid = 0;
static void mega_launch(MArgs a, int lo, int hi, int layer, int use_bar, hipStream_t stream) {
    a.ph_lo = lo; a.ph_hi = hi; a.layer = layer; a.use_bar = use_bar;
    hipLaunchKernelGGL(mega_fwd, dim3(g_grid), dim3(NWAVES * 64), LDS_BYTES, stream, a);
}
extern "C" void kernel_launch(void* const* d_in, const int* in_sizes, int n_in, void* d_out, int out_size, void* d_ws, size_t ws_size, hipStream_t stream) {
    if (g_grid == 0) {
        int dev = 0, cus = 0;
        (void)hipGetDevice(&dev); (void)hipDeviceGetAttribute(&cus, hipDeviceAttributeMultiprocessorCount, dev);
        (void)hipFuncSetAttribute((const void*)mega_fwd, hipFuncAttributeMaxDynamicSharedMemorySize, LDS_BYTES);
        g_grid = cus > 0 ? cus : 256;
    }
    unsigned char* ws = (unsigned char*)d_ws;
    unsigned* ctl = (unsigned*)(ws + WS_CTL);
    float* out = (float*)d_out;
    MArgs a{};
    for (int i = 0; i < 24; ++i) a.in[i] = (const float*)d_in[i];
    a.out = out; a.ws = ws;
    (void)hipMemsetAsync(ctl, 0, 65536, stream);
#ifdef PROBE_DUP
    mega_launch(a, 0, 25, 0, 1, stream);
#else
    mega_launch(a, 0, 24, 0, 1, stream);
#endif
}
```

```cpp
#include <hip/hip_runtime.h>
#include <stdint.h>
#include <math.h>

typedef unsigned short bf16_t;
__device__ __forceinline__ float bf2f(bf16_t v) { return __uint_as_float(((unsigned)v) << 16); }
__device__ __forceinline__ bf16_t f2bf(float f) { unsigned u = __float_as_uint(f); return (bf16_t)((u + 0x7fffu + ((u >> 16) & 1u)) >> 16); }

constexpr int D = 2048, SEQ = 4096, CTXL = 256, NBATCH = 2;
constexpr int MLAT = NBATCH * SEQ, MCTX = NBATCH * CTXL, MROWS = MLAT + MCTX;
constexpr int IN_DIM = 3840, NMOD = 6;
constexpr int NEXP = 16, DEXP = 512;
constexpr float QSCALE = 0.125f * 1.4426950408889634f;
constexpr float LOG2E = 1.4426950408889634f;
constexpr int UQ = 0, UK = 512, UV = 640, UF = 768, USB = 1280, USC = 1792, USV = 2304, UDA = 2816, UDG = 3328;

__device__ __forceinline__ int modsel(int row) { return row < SEQ ? 0 : (row < MLAT ? 1 : 2); }
__device__ __forceinline__ void seqinfo(int row, int& base, int& t, int& len) {
    if (row < MLAT) { base = row & ~(SEQ - 1); t = row & (SEQ - 1); len = SEQ; }
    else { int r = row - MLAT; base = MLAT + (r & ~(CTXL - 1)); t = r & (CTXL - 1); len = CTXL; }
}
__device__ __forceinline__ float silu_f(float v) { return v * __builtin_amdgcn_rcpf(1.f + __expf(-v)); }
__device__ __forceinline__ float sigmoid_f(float v) { return __builtin_amdgcn_rcpf(1.f + __expf(-v)); }

constexpr size_t MiB = 1u << 20;
constexpr size_t WS_CTL = 0;
constexpr size_t WS_MODP = 1 * MiB;
constexpr size_t WS_MOD = 6 * MiB;
constexpr size_t WS_ROPE = 7 * MiB;
constexpr size_t WS_TOK = 8 * MiB;
constexpr size_t WS_LIST = 9 * MiB;
constexpr size_t WS_X = 16 * MiB;
constexpr size_t WS_H = 88 * MiB;
constexpr size_t WS_U = 124 * MiB;
constexpr size_t WS_MIX = 190 * MiB;
constexpr size_t WS_P = 226 * MiB;
constexpr size_t WS_Q = 244 * MiB;
constexpr size_t WS_HID = 262 * MiB;
constexpr size_t WS_Y2 = 280 * MiB;
constexpr size_t WS_END = 350 * MiB;

__device__ __forceinline__ float wave_sum(float v) {
    v += __int_as_float(__builtin_amdgcn_update_dpp(0, __float_as_int(v), 0xB1, 0xf, 0xf, false));
    v += __int_as_float(__builtin_amdgcn_update_dpp(0, __float_as_int(v), 0x4E, 0xf, 0xf, false));
    v += __int_as_float(__builtin_amdgcn_update_dpp(0, __float_as_int(v), 0x141, 0xf, 0xf, false));
    v += __int_as_float(__builtin_amdgcn_update_dpp(0, __float_as_int(v), 0x140, 0xf, 0xf, false));
    const float r0 = __int_as_float(__builtin_amdgcn_readlane(__float_as_int(v), 0)), r1 = __int_as_float(__builtin_amdgcn_readlane(__float_as_int(v), 16));
    const float r2 = __int_as_float(__builtin_amdgcn_readlane(__float_as_int(v), 32)), r3 = __int_as_float(__builtin_amdgcn_readlane(__float_as_int(v), 48));
    return (r0 + r1) + (r2 + r3);
}

__device__ __forceinline__ unsigned long long rt_now() { unsigned long long t; asm volatile("s_memrealtime %0\n\ts_waitcnt lgkmcnt(0)" : "=s"(t) :: "memory"); return t; }
__device__ __forceinline__ int hw_lane_id() { unsigned z = 0u; asm volatile("" : "+v"(z)); return (int)__builtin_amdgcn_mbcnt_hi(~0u, __builtin_amdgcn_mbcnt_lo(~0u, z)); }
#ifndef PROBE_BLK
#define PROBE_BLK 0
#endif
#ifdef PROBE_TA
#define PROBE_MARK(i) do { if (blockIdx.x == PROBE_BLK && __builtin_amdgcn_readfirstlane((int)threadIdx.x) < 64 && hw_lane_id() == 0) ((volatile __attribute__((address_space(3))) unsigned long long*)((__attribute__((address_space(3))) unsigned char*)0 + 144448))[32 + (i)] = rt_now(); } while (0)
#else
#define PROBE_MARK(i) do { } while (0)
#endif
namespace pg8 {
#define PG8_LAS __attribute__((address_space(3)))
typedef short bf16x8 __attribute__((ext_vector_type(8)));
typedef float f32x4 __attribute__((ext_vector_type(4)));
typedef unsigned u32x4 __attribute__((ext_vector_type(4)));
typedef unsigned u32x2 __attribute__((ext_vector_type(2)));
constexpr int BM = 256, BK = 64, HALF = 128, HTB = HALF * BK * 2, STAGE_BYTES = 8 * HTB, NXCD = 8, WGM = 8;
__host__ __device__ __forceinline__ int lds_byte(int r, int c) { const int st = (r >> 4) * 2 + (c >> 5), rr = r & 15, cc = c & 31, ob = rr * 64 + cc * 2; return st * 1024 + (ob ^ (((ob >> 9) & 1) << 5)); }
__host__ __device__ __forceinline__ void stage_rc(int b, int& R, int& C) { const int st = b / 1024, sb = b % 1024, swz = sb ^ (((sb >> 9) & 1) << 5); R = (st >> 1) * 16 + swz / 64; C = (st & 1) * 32 + (swz % 64) / 2; }
__host__ __device__ __forceinline__ int perm32(int rho) { const int n = rho >> 4, i = rho & 15; return 8 * (i >> 2) + 4 * n + (i & 3); }

struct Unit { int pm, pn, grp, aux; };
struct Prob {
    const bf16_t* A; const bf16_t* Bt; int lda, ldb, K, pad;
    long long a_pm, a_grp, a_aux, b_pn, b_grp, b_aux;
    __device__ __forceinline__ const char* a_base(const Unit& u) const { return (const char*)(A + (long long)u.pm * a_pm + (long long)u.grp * a_grp + (long long)u.aux * a_aux); }
    __device__ __forceinline__ const char* b_base(const Unit& u) const { return (const char*)(Bt + (long long)u.pn * b_pn + (long long)u.grp * b_grp + (long long)u.aux * b_aux); }
};
struct StaticOrder {
    int nM, nN, nwg, G, c;
    __device__ void init(int nM_, int nN_, int G_, int c_) { nM = nM_; nN = nN_; nwg = nM * nN; G = G_; c = c_; }
    __device__ bool next(int i, Unit& u) const {
        const long L = (long)i * G + c; if (L >= nwg) return false;
        int wgid = (int)L; { const int q = nwg / NXCD, r = nwg % NXCD, xcd = wgid % NXCD, off = wgid / NXCD; wgid = (xcd < r ? xcd * (q + 1) : r * (q + 1) + (xcd - r) * q) + off; }
        const int nig = WGM * nN, gid = wgid / nig, fm = gid * WGM, gsz = (nM - fm) < WGM ? (nM - fm) : WGM;
        u.pm = fm + ((wgid % nig) % gsz); u.pn = (wgid % nig) / gsz; u.grp = 0; u.aux = 0; return true;
    }
};
struct ListSched {
    const PG8_LAS int* ul; int n;
    __device__ bool next(int i, Unit& u) const {
        if (i >= n) return false;
        u.pm = __builtin_amdgcn_readfirstlane(ul[i * 4]); u.pn = __builtin_amdgcn_readfirstlane(ul[i * 4 + 1]); u.grp = __builtin_amdgcn_readfirstlane(ul[i * 4 + 2]); u.aux = __builtin_amdgcn_readfirstlane(ul[i * 4 + 3]); return true;
    }
};
struct DftASched { int n, G, c, pad;
    __device__ bool next(int i, Unit& u) const { const int L = i * G + c; if (L >= n) return false; u.pm = 0; u.pn = L >> 2; u.grp = L & 3; u.aux = 0; return true; } };
struct DftBSched { int n, G, c, mode;
    __device__ bool next(int i, Unit& u) const { const int L = i * G + c; if (L >= n) return false;
        if (mode == 0) { const int x = L & 7, idx = L >> 3; u.aux = x & 3; u.pm = (x >> 2) * 8 + (idx & 7); u.grp = (idx >> 3) & 1; u.pn = idx >> 4; }
        else { u.grp = L >> 1; u.pn = L & 1; u.pm = 0; u.aux = 0; } return true; } };
struct DftB2Sched { int n, G, c, pad;
    __device__ bool next(int i, Unit& u) const { const int L = i * G + c; if (L >= n) return false; const int x = L & 7, idx = L >> 3; const int eo = x >> 2;
        u.aux = x & 3; u.pm = eo * 8 + (idx & 7); u.grp = (idx >> 3) & 1; u.pn = eo * 2 + (idx >> 4); return true; } };
__device__ __forceinline__ unsigned cvt_pk_bf16(float lo, float hi) { unsigned r; asm volatile("v_cvt_pk_bf16_f32 %0, %1, %2" : "=v"(r) : "v"(lo), "v"(hi)); return r; }

template <class Epi, class Sched, bool GATHER, bool ALIGN_EPI>
__device__ __forceinline__ void gemm_phase(PG8_LAS unsigned char* lds, const Prob P, const Sched& S, const Epi& E, const PG8_LAS unsigned* rows_lds, int wave_id) {
    int tid_ = wave_id * 64 + hw_lane_id(); asm volatile("" : "+v"(tid_));
    const int tid = tid_, wid = __builtin_amdgcn_readfirstlane(tid >> 6), lane = tid & 63, wr = wid >> 2, wc = wid & 3, fr = lane & 15, fq = lane >> 4;
    const int K = P.K, nt = K / BK;
    int Rr[2], Cc[2];
    unsigned voB[2], voA[2][2];
#pragma unroll
    for (int i = 0; i < 2; ++i) { int R, C; stage_rc(tid * 16 + i * 8192, R, C); Rr[i] = R; Cc[i] = C; const int Rb = Epi::PERM ? ((R & ~31) + perm32(R & 31)) : R;
        voB[i] = (unsigned)(Rb * P.ldb + C) * 2u; }
#define PG8_SETVOA(slot) do { _Pragma("unroll") for (int _h = 0; _h < 2; ++_h) _Pragma("unroll") for (int _i = 0; _i < 2; ++_i) { \
        unsigned _row = (unsigned)(_h * HALF + Rr[_i]); if (GATHER) { const unsigned _e = rows_lds[(slot) * 256 + _h * HALF + Rr[_i]]; _row = (_e == 0xFFFFFFFFu) ? 0u : (_e >> 1); } \
        voA[_h][_i] = (_row * (unsigned)P.lda + (unsigned)Cc[_i]) * 2u; } } while (0)
    const size_t kstep = (size_t)(BK * 2);
    const size_t hstepB = (size_t)HALF * P.ldb * 2;
    const unsigned ldsw = (unsigned)wid * 1024u;
    const int aoff = lds_byte(wr * 64 + fr, fq * 8), boff = lds_byte(wc * 32 + fr, fq * 8);
#define PG8_SA(b, h) (((b) * 2 + (h)) * HTB)
#define PG8_SB(b, h) ((4 + (b) * 2 + (h)) * HTB)
#define PG8_STAGE(bufoff, gbase, voff) do { _Pragma("unroll") for (int _i = 0; _i < 2; ++_i) \
        __builtin_amdgcn_global_load_lds((const unsigned*)((const char*)(gbase) + (voff)[_i]), (PG8_LAS unsigned*)(lds + (bufoff) + ldsw + _i * 8192), 16, 0, 0); } while (0)
#define PG8_LDA(dst, b, h) do { _Pragma("unroll") for (int m = 0; m < 4; ++m) _Pragma("unroll") for (int k = 0; k < 2; ++k) dst[m][k] = *(const PG8_LAS bf16x8*)(lds + PG8_SA(b, h) + aoff + m * 2048 + k * 1024); } while (0)
#define PG8_LDB(dst, b, h) do { _Pragma("unroll") for (int n = 0; n < 2; ++n) _Pragma("unroll") for (int k = 0; k < 2; ++k) dst[n][k] = *(const PG8_LAS bf16x8*)(lds + PG8_SB(b, h) + boff + n * 2048 + k * 1024); } while (0)
#define PG8_MMA(ai, bj, At, Bt) do { __builtin_amdgcn_s_setprio(1); _Pragma("unroll") for (int m = 0; m < 4; ++m) _Pragma("unroll") for (int n = 0; n < 2; ++n) _Pragma("unroll") for (int k = 0; k < 2; ++k) \
        acc[ai][bj][m][n] = __builtin_amdgcn_mfma_f32_16x16x32_bf16(Bt[n][k], At[m][k], acc[ai][bj][m][n], 0, 0, 0); __builtin_amdgcn_s_setprio(0); } while (0)
#define PG8_WAIT_V(n) asm volatile("s_waitcnt vmcnt(" #n ")" ::: "memory")
#define PG8_WAIT_L(n) asm volatile("s_waitcnt lgkmcnt(" #n ")" ::: "memory")
#define PG8_BAR __builtin_amdgcn_s_barrier()
#define PG8_SCHED __builtin_amdgcn_sched_barrier(0)
    Unit cur, nxt; int ui = 0;
    if (!S.next(0, cur)) return;
    f32x4 acc[2][2][4][2];
#pragma unroll
    for (int a = 0; a < 2; ++a)
#pragma unroll
        for (int b = 0; b < 2; ++b)
#pragma unroll
            for (int m = 0; m < 4; ++m)
#pragma unroll
                for (int n = 0; n < 2; ++n) acc[a][b][m][n] = (f32x4){0.f, 0.f, 0.f, 0.f};
    bf16x8 At[4][2], B0[2][2], B1[2][2];
    const char* cA = P.a_base(cur); const char* cB = P.b_base(cur);
    PG8_SETVOA(0);
    PG8_STAGE(PG8_SB(0, 0), cB, voB); PG8_STAGE(PG8_SB(0, 1), cB + hstepB, voB); PG8_STAGE(PG8_SA(0, 0), cA, voA[0]); PG8_STAGE(PG8_SA(0, 1), cA, voA[1]);
    if (wr == 1) PG8_BAR;
    PG8_WAIT_V(2); PG8_BAR;
    PG8_STAGE(PG8_SB(1, 0), cB + kstep, voB); PG8_STAGE(PG8_SA(1, 0), cA + kstep, voA[0]); PG8_STAGE(PG8_SB(1, 1), cB + hstepB + kstep, voB);
    PG8_WAIT_V(6); PG8_BAR;
    for (;;) {
        const bool has_next = S.next(ui + 1, nxt);
        const char* nA = has_next ? P.a_base(nxt) : cA; const char* nB = has_next ? P.b_base(nxt) : cB;
        for (int t = 0; t < nt; t += 2) {
            const bool last = (t == nt - 2);
            const char* a1 = cA + (size_t)(t + 1) * kstep;
            const char* a2 = last ? nA : cA + (size_t)(t + 2) * kstep; const char* b2 = last ? nB : cB + (size_t)(t + 2) * kstep;
            const char* a3 = a2 + kstep; const char* b3 = b2 + kstep;
            PG8_LDB(B0, 0, 0); PG8_LDB(B1, 0, 1); PG8_SCHED; PG8_LDA(At, 0, 0); PG8_STAGE(PG8_SA(1, 1), a1, voA[1]);
            PG8_WAIT_V(8); PG8_WAIT_L(0); PG8_BAR; PG8_MMA(0, 0, At, B0); PG8_MMA(0, 1, At, B1); PG8_BAR; PG8_SCHED;
            if (GATHER) { if (last && has_next) { PG8_SETVOA(ui + 1); } }
            PG8_LDA(At, 0, 1); PG8_STAGE(PG8_SB(0, 0), b2, voB); PG8_STAGE(PG8_SB(0, 1), b2 + hstepB, voB); PG8_STAGE(PG8_SA(0, 0), a2, voA[0]);
            PG8_WAIT_V(8); PG8_WAIT_L(0); PG8_BAR; PG8_MMA(1, 0, At, B0); PG8_MMA(1, 1, At, B1); PG8_BAR; PG8_SCHED;
            PG8_LDB(B0, 1, 0); PG8_LDB(B1, 1, 1); PG8_SCHED; PG8_LDA(At, 1, 0); PG8_STAGE(PG8_SA(0, 1), a2, voA[1]);
            PG8_WAIT_V(8); PG8_WAIT_L(0); PG8_BAR; PG8_MMA(0, 0, At, B0); PG8_MMA(0, 1, At, B1); PG8_BAR; PG8_SCHED;
            PG8_LDA(At, 1, 1); PG8_STAGE(PG8_SB(1, 0), b3, voB); PG8_STAGE(PG8_SB(1, 1), b3 + hstepB, voB); PG8_STAGE(PG8_SA(1, 0), a3, voA[0]);
            PG8_WAIT_V(8); PG8_WAIT_L(0); PG8_BAR; PG8_MMA(1, 0, At, B0); PG8_MMA(1, 1, At, B1); PG8_BAR; PG8_SCHED;
        }
        if constexpr (ALIGN_EPI) { if (wr == 0) PG8_BAR; }
        E(acc, cur, ui, wr, wc, fr, fq);
        if (!has_next) break;
#pragma unroll
        for (int a = 0; a < 2; ++a)
#pragma unroll
            for (int b = 0; b < 2; ++b)
#pragma unroll
                for (int m = 0; m < 4; ++m)
#pragma unroll
                    for (int n = 0; n < 2; ++n) acc[a][b][m][n] = (f32x4){0.f, 0.f, 0.f, 0.f};
        cur = nxt; cA = nA; cB = nB; ++ui;
        if constexpr (ALIGN_EPI) { if (wr == 1) PG8_BAR; }
    }
    PG8_WAIT_V(0);
    if constexpr (!ALIGN_EPI) { if (wr == 0) PG8_BAR; }
    PG8_BAR;
#undef PG8_SETVOA
#undef PG8_SA
#undef PG8_SB
#undef PG8_STAGE
#undef PG8_LDA
#undef PG8_LDB
#undef PG8_MMA
#undef PG8_WAIT_V
#undef PG8_WAIT_L
#undef PG8_BAR
#undef PG8_SCHED
}

struct EpiG1 {
    static constexpr bool PERM = true;
    bf16_t* U; const PG8_LAS float* rope;
    __device__ __forceinline__ void operator()(const f32x4 (&acc)[2][2][4][2], const Unit& u, int ui, int wr, int wc, int fr, int fq) const {
        const int row0 = u.pm * BM + wr * 64 + fr, colt = u.pn * BM, col0 = colt + wc * 32 + 8 * fq;
        const bool latent = u.pm < 32;
        const int axis = wc & 1; const float sgn = fq < 2 ? -1.f : 1.f;
#pragma unroll
        for (int ai = 0; ai < 2; ++ai)
#pragma unroll
            for (int m = 0; m < 4; ++m) {
                const int row = row0 + ai * HALF + m * 16;
                bf16_t* rowp = U + (size_t)row * IN_DIM + col0;
                const int t = row & (SEQ - 1); const int pos = axis ? (t & 63) : (t >> 6);
                const PG8_LAS f32x4* tp = (const PG8_LAS f32x4*)(rope + (pos * 16 + 8 * (fq & 1)) * 2);
#pragma unroll
                for (int bj = 0; bj < 2; ++bj) {
                    const int cb = colt + bj * HALF;
                    f32x4 v0 = acc[ai][bj][m][0], v1 = acc[ai][bj][m][1];
                    if (cb < 640) {
                        if (latent) {
                            const f32x4 t0 = tp[0], t1 = tp[1], t2 = tp[2], t3 = tp[3];
                            f32x4 p0, p1;
                            p0[0] = __shfl_xor(v0[0], 32); p0[1] = __shfl_xor(v0[1], 32); p0[2] = __shfl_xor(v0[2], 32); p0[3] = __shfl_xor(v0[3], 32);
                            p1[0] = __shfl_xor(v1[0], 32); p1[1] = __shfl_xor(v1[1], 32); p1[2] = __shfl_xor(v1[2], 32); p1[3] = __shfl_xor(v1[3], 32);
                            v0[0] = v0[0] * t0[0] + sgn * p0[0] * t0[1]; v0[1] = v0[1] * t0[2] + sgn * p0[1] * t0[3];
                            v0[2] = v0[2] * t1[0] + sgn * p0[2] * t1[1]; v0[3] = v0[3] * t1[2] + sgn * p0[3] * t1[3];
                            v1[0] = v1[0] * t2[0] + sgn * p1[0] * t2[1]; v1[1] = v1[1] * t2[2] + sgn * p1[1] * t2[3];
                            v1[2] = v1[2] * t3[0] + sgn * p1[2] * t3[1]; v1[3] = v1[3] * t3[2] + sgn * p1[3] * t3[3];
                        }
                        if (cb < 512) { float qs = QSCALE; asm volatile("" : "+v"(qs)); v0 = v0 * qs; v1 = v1 * qs; }
                    }
                    u32x4 w; w.x = cvt_pk_bf16(v0[0], v0[1]); w.y = cvt_pk_bf16(v0[2], v0[3]); w.z = cvt_pk_bf16(v1[0], v1[1]); w.w = cvt_pk_bf16(v1[2], v1[3]);
                    *(u32x4*)(rowp + bj * HALF) = w;
                }
            }
    }
};
struct EpiG2 {
    static constexpr bool PERM = false;
    float* X; const float* base_lat; const float* base_ctx; const float* modv_l;
    __device__ __forceinline__ void operator()(const f32x4 (&acc)[2][2][4][2], const Unit& u, int ui, int wr, int wc, int fr, int fq) const {
        const int s = u.pm < 16 ? 0 : (u.pm < 32 ? 1 : 2);
        const float* ga = modv_l + (size_t)s * (NMOD * D) + 2 * D;
        const int col0 = u.pn * BM + wc * 32 + 4 * fq;
        f32x4 gv[2][2];
#pragma unroll
        for (int bj = 0; bj < 2; ++bj)
#pragma unroll
            for (int n = 0; n < 2; ++n) gv[bj][n] = *(const f32x4*)(ga + col0 + bj * HALF + n * 16);
#pragma unroll
        for (int ai = 0; ai < 2; ++ai)
#pragma unroll
            for (int mh = 0; mh < 2; ++mh) {
                f32x4 bv[2][2][2];
#pragma unroll
                for (int mm = 0; mm < 2; ++mm) { const int m = 2 * mh + mm;
                    const int row = u.pm * BM + ai * HALF + wr * 64 + m * 16 + fr;
                    const float* bp = (u.pm < 32 ? base_lat + (size_t)row * D : base_ctx + (size_t)(row - MLAT) * D) + col0;
#pragma unroll
                    for (int bj = 0; bj < 2; ++bj)
#pragma unroll
                        for (int n = 0; n < 2; ++n) bv[mm][bj][n] = *(const f32x4*)(bp + bj * HALF + n * 16);
                }
                asm volatile("" ::: "memory");
#pragma unroll
                for (int mm = 0; mm < 2; ++mm) { const int m = 2 * mh + mm;
                    const int row = u.pm * BM + ai * HALF + wr * 64 + m * 16 + fr;
                    float* xp = X + (size_t)row * D + col0;
#pragma unroll
                    for (int bj = 0; bj < 2; ++bj)
#pragma unroll
                        for (int n = 0; n < 2; ++n) *(f32x4*)(xp + bj * HALF + n * 16) = bv[mm][bj][n] + gv[bj][n] * acc[ai][bj][m][n];
                }
                asm volatile("" ::: "memory");
            }
    }
};
struct EpiMoeUp {
    static constexpr bool PERM = true;
    bf16_t* Hid; const float* tok_w; const PG8_LAS unsigned* rows_lds;
    __device__ __forceinline__ void operator()(const f32x4 (&acc)[2][2][4][2], const Unit& u, int ui, int wr, int wc, int fr, int fq) const {
        const int col0 = u.pn * HALF + wc * 32 + 8 * fq;
        float wv[2][4];
#pragma unroll
        for (int ai = 0; ai < 2; ++ai)
#pragma unroll
            for (int m = 0; m < 4; ++m) { const unsigned ent = rows_lds[ui * 256 + ai * HALF + wr * 64 + m * 16 + fr]; wv[ai][m] = (ent == 0xFFFFFFFFu) ? 0.f : tok_w[ent]; }
        asm volatile("" ::: "memory");
#pragma unroll
        for (int ai = 0; ai < 2; ++ai)
#pragma unroll
            for (int m = 0; m < 4; ++m) {
                const int r = ai * HALF + wr * 64 + m * 16 + fr;
                const float w = wv[ai][m];
                const f32x4 g0 = acc[ai][0][m][0], g1 = acc[ai][0][m][1], u0 = acc[ai][1][m][0], u1 = acc[ai][1][m][1];
                float h[8];
#pragma unroll
                for (int j = 0; j < 4; ++j) { h[j] = silu_f(g0[j]) * u0[j] * w; h[4 + j] = silu_f(g1[j]) * u1[j] * w; }
                u32x4 o; o.x = cvt_pk_bf16(h[0], h[1]); o.y = cvt_pk_bf16(h[2], h[3]); o.z = cvt_pk_bf16(h[4], h[5]); o.w = cvt_pk_bf16(h[6], h[7]);
                *(u32x4*)(Hid + (size_t)(u.pm * BM + r) * DEXP + col0) = o;
            }
    }
};
struct EpiMoeDown {
    static constexpr bool PERM = true;
    bf16_t* Y2; const PG8_LAS unsigned* rows_lds;
    __device__ __forceinline__ void operator()(const f32x4 (&acc)[2][2][4][2], const Unit& u, int ui, int wr, int wc, int fr, int fq) const {
        const int col0 = u.pn * BM + wc * 32 + 8 * fq;
#pragma unroll
        for (int ai = 0; ai < 2; ++ai)
#pragma unroll
            for (int m = 0; m < 4; ++m) {
                const int r = ai * HALF + wr * 64 + m * 16 + fr;
                const unsigned ent = rows_lds[ui * 256 + r];
                if (ent != 0xFFFFFFFFu) {
                    bf16_t* yp = Y2 + (size_t)ent * D + col0;
#pragma unroll
                    for (int bj = 0; bj < 2; ++bj) { const f32x4 v0 = acc[ai][bj][m][0], v1 = acc[ai][bj][m][1];
                        u32x4 o; o.x = cvt_pk_bf16(v0[0], v0[1]); o.y = cvt_pk_bf16(v0[2], v0[3]); o.z = cvt_pk_bf16(v1[0], v1[1]); o.w = cvt_pk_bf16(v1[2], v1[3]);
                        *(u32x4*)(yp + bj * HALF) = o; }
                }
            }
    }
};
struct EpiDftA {
    static constexpr bool PERM = false;
    bf16_t* PQt; bf16_t* PQtc;
    __device__ __forceinline__ void operator()(const f32x4 (&acc)[2][2][4][2], const Unit& u, int ui, int wr, int wc, int fr, int fq) const {
        const int g = u.grp;
#pragma unroll
        for (int ai = 0; ai < 2; ++ai)
#pragma unroll
            for (int m = 0; m < 4; ++m) {
                const int cq = wr * 64 + m * 16 + fr;
                bf16_t* dst;
                if (u.pn < 32) { const int b = u.pn >> 4; dst = PQt + ((size_t)(b * 512 + g * 128 + cq) * (2 * SEQ) + (size_t)ai * SEQ + (size_t)(u.pn & 15) * BM); }
                else { const int b = u.pn - 32; dst = PQtc + ((size_t)(b * 512 + g * 128 + cq) * (2 * CTXL) + (size_t)ai * CTXL); }
#pragma unroll
                for (int bj = 0; bj < 2; ++bj)
#pragma unroll
                    for (int n = 0; n < 2; ++n) { const f32x4 v = acc[ai][bj][m][n]; u32x2 o; o.x = cvt_pk_bf16(v[0], v[1]); o.y = cvt_pk_bf16(v[2], v[3]);
                        *(u32x2*)(dst + bj * HALF + wc * 32 + n * 16 + 4 * fq) = o; }
            }
    }
};
struct EpiDftB {
    static constexpr bool PERM = false;
    float* PART; int row_base; int pad;
    long long seq_rows;
    __device__ __forceinline__ void operator()(const f32x4 (&acc)[2][2][4][2], const Unit& u, int ui, int wr, int wc, int fr, int fq) const {
        const int col0 = u.pn * BM + wc * 32 + 4 * fq;
#pragma unroll
        for (int ai = 0; ai < 2; ++ai)
#pragma unroll
            for (int m = 0; m < 4; ++m) {
                const int row = row_base + u.grp * (int)seq_rows + u.pm * BM + ai * HALF + wr * 64 + m * 16 + fr;
                float* pp = PART + ((size_t)u.aux * MROWS + row) * 512 + col0;
#pragma unroll
                for (int bj = 0; bj < 2; ++bj)
#pragma unroll
                    for (int n = 0; n < 2; ++n) *(f32x4*)(pp + bj * HALF + n * 16) = acc[ai][bj][m][n];
            }
    }
};
struct EpiDftB2 {
    static constexpr bool PERM = true;
    bf16_t* PART2;
    __device__ __forceinline__ void operator()(const f32x4 (&acc)[2][2][4][2], const Unit& u, int ui, int wr, int wc, int fr, int fq) const {
        const int eo = u.pm >> 3, col0 = (u.pn & 1) * BM + wc * 32 + 8 * fq;
        bf16_t* base = PART2 + (size_t)(((u.aux * 2 + eo) * 2 + u.grp) * 2048) * 512;
#pragma unroll
        for (int ai = 0; ai < 2; ++ai)
#pragma unroll
            for (int m = 0; m < 4; ++m) {
                const int row = (u.pm & 7) * BM + ai * HALF + wr * 64 + m * 16 + fr;
                bf16_t* pp = base + (size_t)row * 512 + col0;
#pragma unroll
                for (int bj = 0; bj < 2; ++bj) { const f32x4 v0 = acc[ai][bj][m][0], v1 = acc[ai][bj][m][1];
                    u32x4 o; o.x = cvt_pk_bf16(v0[0], v0[1]); o.y = cvt_pk_bf16(v0[2], v0[3]); o.z = cvt_pk_bf16(v1[0], v1[1]); o.w = cvt_pk_bf16(v1[2], v1[3]);
                    *(u32x4*)(pp + bj * HALF) = o; }
            }
    }
};
}


namespace att {
typedef short bf16x8 __attribute__((ext_vector_type(8)));
typedef short s16x4 __attribute__((ext_vector_type(4)));
typedef float f32x16 __attribute__((ext_vector_type(16)));
typedef unsigned u32x4 __attribute__((ext_vector_type(4)));
typedef unsigned u32x2 __attribute__((ext_vector_type(2)));
typedef short v4i16_t __attribute__((ext_vector_type(4)));
typedef __attribute__((address_space(3))) const unsigned char* lds_cptr;
__device__ __forceinline__ int crow(int r, int hi) { return (r & 3) + 8 * (r >> 2) + 4 * hi; }
__device__ __forceinline__ s16x4 vtr(lds_cptr p) { return __builtin_bit_cast(s16x4, __builtin_amdgcn_ds_read_tr16_b64_v4i16((__attribute__((address_space(3))) v4i16_t*)p)); }
__device__ __forceinline__ unsigned cvtpk(float lo, float hi) { unsigned r; asm volatile("v_cvt_pk_bf16_f32 %0, %1, %2" : "=v"(r) : "v"(lo), "v"(hi)); return r; }

__device__ __forceinline__ void attn_unit(__attribute__((address_space(3))) unsigned char* lds, const bf16_t* __restrict__ Ub, bf16_t* __restrict__ MIXb, const float* __restrict__ sink, int unit, int tid_in) {
    int tid = tid_in; asm volatile("" : "+v"(tid));
    const int lane = tid & 63, r32 = lane & 31, hi = lane >> 5; const int wid = __builtin_amdgcn_readfirstlane(tid >> 6);
    const bool latent = unit < 256;
    int b, kvh, p0;
    if (latent) { b = unit >> 7; kvh = (unit >> 6) & 1; p0 = (unit & 63) * 64; } else { const int u2 = unit - 256; b = u2 >> 3; kvh = (u2 >> 2) & 1; p0 = (u2 & 3) * 64; }
    const int g = wid >> 1, ph = wid & 1, head = kvh * 4 + g;
    const int qrow = (latent ? b * SEQ + p0 : MLAT + b * CTXL + p0) + 32 * ph + r32;
    bf16x8 qr[4];
#pragma unroll
    for (int d0 = 0; d0 < 4; ++d0) qr[d0] = *(const bf16x8*)(Ub + (size_t)qrow * IN_DIM + UQ + head * 64 + 16 * d0 + 8 * hi);
    const int jlo = latent ? (p0 >= 128 ? 0 : (p0 == 64 ? 1 : 2)) : 0;
    const int jhi = latent ? min(4, (4160 - p0) >> 6) : -1;
    const int nloc = latent ? (jhi - jlo + 1) : 0, ntl = nloc + 4;
    const int kkey = lane, kc = wid;
    const int vkey = 16 * (wid & 3) + (lane >> 2), vd = 32 * (wid >> 2) + 8 * (lane & 3);
    const bf16_t* kcol = Ub + UK + kvh * 64 + 8 * kc; const bf16_t* vcol = Ub + UV + kvh * 64 + vd;
#define ATT_KROW0(t) (((t) < nloc) ? (b * SEQ + p0 - 128 + 64 * (jlo + (t))) : (MLAT + b * CTXL + 64 * ((t) - nloc)))
    u32x4 kreg, vreg;
    { const int kr0 = ATT_KROW0(0); kreg = *(const u32x4*)(kcol + (size_t)(kr0 + kkey) * IN_DIM); vreg = *(const u32x4*)(vcol + (size_t)(kr0 + vkey) * IN_DIM); }
    *(__attribute__((address_space(3))) u32x4*)(lds + tid * 16) = kreg; *(__attribute__((address_space(3))) u32x4*)(lds + 16384 + tid * 16) = vreg;
    const float sk2 = sink[head] * LOG2E;
    float m = sk2, l = (hi == 0) ? 1.f : 0.f;
    f32x16 o[2]; o[0] = f32x16{}; o[1] = f32x16{};
    __syncthreads();
    for (int t = 0; t < ntl; ++t) {
        const int slot = (t & 1) * 8192;
        const bool more = (t + 1 < ntl);
        if (more) { const int kr0 = ATT_KROW0(t + 1); kreg = *(const u32x4*)(kcol + (size_t)(kr0 + kkey) * IN_DIM); vreg = *(const u32x4*)(vcol + (size_t)(kr0 + vkey) * IN_DIM); }
        f32x16 s0 = f32x16{}, s1 = f32x16{};
        { const lds_cptr kb = (lds_cptr)lds + slot + hi * 1024 + r32 * 16;
#pragma unroll
          for (int d0 = 0; d0 < 4; ++d0) { const bf16x8 b0 = *(const __attribute__((address_space(3))) bf16x8*)(kb + d0 * 2048); const bf16x8 b1 = *(const __attribute__((address_space(3))) bf16x8*)(kb + d0 * 2048 + 512);
              s0 = __builtin_amdgcn_mfma_f32_32x32x16_bf16(b0, qr[d0], s0, 0, 0, 0); s1 = __builtin_amdgcn_mfma_f32_32x32x16_bf16(b1, qr[d0], s1, 0, 0, 0); } }
        if (t < nloc) {
            const int rel0 = 64 * (jlo + t) - 128 - 32 * ph - r32 + 4 * hi;
#pragma unroll
            for (int r = 0; r < 16; ++r) { const int rel = rel0 + (r & 3) + 8 * (r >> 2); if (rel < -128 || rel > 128) s0[r] = -1e30f; if (rel + 32 < -128 || rel + 32 > 128) s1[r] = -1e30f; }
        }
        float tm = fmaxf(s0[0], s1[0]);
#pragma unroll
        for (int r = 1; r < 16; ++r) tm = fmaxf(tm, fmaxf(s0[r], s1[r]));
        tm = fmaxf(tm, __shfl_xor(tm, 32));
        const float mn = fmaxf(m, tm), alpha = __builtin_amdgcn_exp2f(m - mn); m = mn;
        float ps = 0.f;
#pragma unroll
        for (int r = 0; r < 16; ++r) { s0[r] = __builtin_amdgcn_exp2f(s0[r] - mn); s1[r] = __builtin_amdgcn_exp2f(s1[r] - mn); ps += s0[r] + s1[r]; }
        l = l * alpha + ps;
#pragma unroll
        for (int r = 0; r < 16; ++r) { o[0][r] *= alpha; o[1][r] *= alpha; }
        u32x4 pw[4];
#pragma unroll
        for (int q = 0; q < 4; ++q) { pw[0][q] = cvtpk(s0[2 * q], s0[2 * q + 1]); pw[1][q] = cvtpk(s0[8 + 2 * q], s0[8 + 2 * q + 1]); pw[2][q] = cvtpk(s1[2 * q], s1[2 * q + 1]); pw[3][q] = cvtpk(s1[8 + 2 * q], s1[8 + 2 * q + 1]); }
        { const lds_cptr vp = (lds_cptr)lds + 16384 + slot + ((lane >> 4) & 1) * 32 + (lane & 3) * 8 + (4 * hi + ((lane & 15) >> 2)) * 64;
#pragma unroll
          for (int d0 = 0; d0 < 2; ++d0)
#pragma unroll
            for (int ks = 0; ks < 4; ++ks) { const s16x4 lo = vtr(vp + d0 * 4096 + ks * 1024), hh = vtr(vp + d0 * 4096 + ks * 1024 + 512);
                const bf16x8 vf = (bf16x8){lo[0], lo[1], lo[2], lo[3], hh[0], hh[1], hh[2], hh[3]};
                o[d0] = __builtin_amdgcn_mfma_f32_32x32x16_bf16(vf, __builtin_bit_cast(bf16x8, pw[ks]), o[d0], 0, 0, 0); } }
        if (more) { const int ns = ((t + 1) & 1) * 8192; *(__attribute__((address_space(3))) u32x4*)(lds + ns + tid * 16) = kreg; *(__attribute__((address_space(3))) u32x4*)(lds + 16384 + ns + tid * 16) = vreg; }
        __syncthreads();
    }
#undef ATT_KROW0
    l += __shfl_xor(l, 32);
    const float inv = 1.f / l;
    bf16_t* op = MIXb + (size_t)qrow * D + head * 64 + 4 * hi;
#pragma unroll
    for (int d0 = 0; d0 < 2; ++d0)
#pragma unroll
        for (int g4 = 0; g4 < 4; ++g4) { u32x2 w; w.x = cvtpk(o[d0][4 * g4] * inv, o[d0][4 * g4 + 1] * inv); w.y = cvtpk(o[d0][4 * g4 + 2] * inv, o[d0][4 * g4 + 3] * inv);
            *(u32x2*)(op + 32 * d0 + 8 * g4) = w; }
}
}

constexpr int CONV_W_OFF = 65536;
using pg8::f32x4;
__device__ __forceinline__ void unpack8(const pg8::u32x4 p, float (&f)[8]) {
#pragma unroll
    for (int q = 0; q < 4; ++q) { f[2 * q] = __uint_as_float(p[q] << 16); f[2 * q + 1] = __uint_as_float(p[q] & 0xffff0000u); }
}
__device__ __forceinline__ void conv_fill_w(__attribute__((address_space(3))) unsigned char* lds, const float* __restrict__ cw, int tid) {
    __attribute__((address_space(3))) f32x4* wl = (__attribute__((address_space(3))) f32x4*)(lds + CONV_W_OFF);
    for (int e = tid; e < 31 * 128; e += 512) wl[e] = *(const f32x4*)(cw + (size_t)e * 4);
}
__device__ __forceinline__ void conv_tile(__attribute__((address_space(3))) unsigned char* lds, const bf16_t* __restrict__ Ub, bf16_t* __restrict__ MIXb, const float* __restrict__ sw,
                                          const float* __restrict__ cb, const float* __restrict__ ng, const float* __restrict__ nb, int tile, int tid_in) {
    typedef pg8::u32x4 u32x4;
    int tid = tid_in; asm volatile("" : "+v"(tid));
    const int lane = tid & 63, w = tid >> 6, c8 = 8 * lane;
    int base, t0, len;
    if (tile < 256) { base = (tile >> 7) * SEQ; t0 = (tile & 127) * 32; len = SEQ; } else { const int u2 = tile - 256; base = MLAT + (u2 >> 3) * CTXL; t0 = (u2 & 7) * 32; len = CTXL; }
#pragma unroll 2
    for (int q = 0; q < 8; ++q) {
        const int it = tid + 512 * q;
        if (it < 62 * 64) {
            const int tok = it >> 6, cg = (it & 63) * 8; const int tt = t0 - 15 + tok;
            u32x4 o = (u32x4){0u, 0u, 0u, 0u};
            if (tt >= 0 && tt < len) {
                const bf16_t* u = Ub + (size_t)(base + tt) * IN_DIM;
                const u32x4 a = *(const u32x4*)(u + UDA + cg), g = *(const u32x4*)(u + UDG + cg);
                float fa[8], fg[8]; unpack8(a, fa); unpack8(g, fg);
#pragma unroll
                for (int e = 0; e < 4; ++e) o[e] = pg8::cvt_pk_bf16(fa[2 * e] * sigmoid_f(fg[2 * e]), fa[2 * e + 1] * sigmoid_f(fg[2 * e + 1]));
            }
            *(__attribute__((address_space(3))) u32x4*)(lds + (size_t)(tok * 512 + cg) * 2) = o;
        }
    }
    PROBE_MARK(21);
    asm volatile("" ::: "memory"); __builtin_amdgcn_sched_barrier(0);
    {
        float v[6][8];
#pragma unroll
        for (int k = 0; k < 6; ++k) { const int tt = t0 + 4 * w - 1 + k;
            if (tt >= 0 && tt < len) { const bf16_t* u = Ub + (size_t)(base + tt) * IN_DIM; float a[8], b[8]; unpack8(*(const u32x4*)(u + USC + c8), a); unpack8(*(const u32x4*)(u + USV + c8), b);
#pragma unroll
                for (int e = 0; e < 8; ++e) v[k][e] = a[e] * b[e]; }
            else {
#pragma unroll
                for (int e = 0; e < 8; ++e) v[k][e] = 0.f; } }
        float w0[8], w1[8], w2[8];
#pragma unroll
        for (int h2 = 0; h2 < 2; ++h2) { const f32x4 a = *(const f32x4*)(sw + c8 + 4 * h2), b = *(const f32x4*)(sw + 512 + c8 + 4 * h2), cc = *(const f32x4*)(sw + 1024 + c8 + 4 * h2);
#pragma unroll
            for (int e = 0; e < 4; ++e) { w0[4 * h2 + e] = a[e]; w1[4 * h2 + e] = b[e]; w2[4 * h2 + e] = cc[e]; } }
#pragma unroll
        for (int i = 0; i < 4; ++i) { const size_t row = (size_t)(base + t0 + 4 * w + i); float sb[8]; unpack8(*(const u32x4*)(Ub + row * IN_DIM + USB + c8), sb);
            u32x4 o;
#pragma unroll
            for (int e = 0; e < 4; ++e) o[e] = pg8::cvt_pk_bf16(sb[2 * e] * (w0[2 * e] * v[i][2 * e] + w1[2 * e] * v[i + 1][2 * e] + w2[2 * e] * v[i + 2][2 * e]),
                                                          sb[2 * e + 1] * (w0[2 * e + 1] * v[i][2 * e + 1] + w1[2 * e + 1] * v[i + 1][2 * e + 1] + w2[2 * e + 1] * v[i + 2][2 * e + 1]));
            *(u32x4*)(MIXb + row * D + 1024 + c8) = o; }
    }
    asm volatile("" ::: "memory"); __builtin_amdgcn_sched_barrier(0);
    PROBE_MARK(22);
    __syncthreads();
    float z[4][8];
    {
        const f32x4 b0 = *(const f32x4*)(cb + c8), b1 = *(const f32x4*)(cb + c8 + 4);
#pragma unroll
        for (int i = 0; i < 4; ++i)
#pragma unroll
            for (int e = 0; e < 4; ++e) { z[i][e] = b0[e]; z[i][4 + e] = b1[e]; }
        float wq[4][8];
        const __attribute__((address_space(3))) f32x4* wl = (const __attribute__((address_space(3))) f32x4*)(lds + CONV_W_OFF);
#pragma unroll 1
        for (int ko = 0; ko < 9; ++ko) {
#pragma unroll
            for (int ki = 0; ki < 4; ++ki) {
                const int k = 4 * ko + ki;
                if (k < 34) {
                    if (k < 31) { const f32x4 a = wl[k * 128 + 2 * lane], b = wl[k * 128 + 2 * lane + 1];
#pragma unroll
                        for (int e = 0; e < 4; ++e) { wq[ki][e] = a[e]; wq[ki][4 + e] = b[e]; } }
                    float g[8]; unpack8(*(const __attribute__((address_space(3))) u32x4*)(lds + (size_t)((4 * w + k) * 512 + c8) * 2), g);
#pragma unroll
                    for (int i = 0; i < 4; ++i) { const int j = k - i; if (j >= 0 && j < 31) {
#pragma unroll
                        for (int e = 0; e < 8; ++e) z[i][e] += wq[(ki - i) & 3][e] * g[e]; } }
                }
            }
        }
    }
    PROBE_MARK(23);
    {
        float gg[8], bb[8];
        { const f32x4 a = *(const f32x4*)(ng + c8), b = *(const f32x4*)(ng + c8 + 4), cc = *(const f32x4*)(nb + c8), d = *(const f32x4*)(nb + c8 + 4);
#pragma unroll
          for (int e = 0; e < 4; ++e) { gg[e] = a[e]; gg[4 + e] = b[e]; bb[e] = cc[e]; bb[4 + e] = d[e]; } }
#pragma unroll
        for (int i = 0; i < 4; ++i) {
            float s = 0.f;
#pragma unroll
            for (int e = 0; e < 8; ++e) s += z[i][e];
            const float mu = wave_sum(s) * (1.f / 512.f);
            float s2 = 0.f;
#pragma unroll
            for (int e = 0; e < 8; ++e) { const float d = z[i][e] - mu; s2 += d * d; }
            const float rstd = rsqrtf(wave_sum(s2) * (1.f / 512.f) + 1e-6f);
            u32x4 o;
#pragma unroll
            for (int e = 0; e < 4; ++e) { const float y0 = (z[i][2 * e] - mu) * rstd * gg[2 * e] + bb[2 * e], y1 = (z[i][2 * e + 1] - mu) * rstd * gg[2 * e + 1] + bb[2 * e + 1]; o[e] = pg8::cvt_pk_bf16(silu_f(y0), silu_f(y1)); }
            *(u32x4*)(MIXb + (size_t)(base + t0 + 4 * w + i) * D + 1536 + c8) = o;
        }
    }
    __syncthreads();
}

constexpr int NWAVES = 8;
constexpr int RING_OFF = 0, RING_BYTES = 131072;
constexpr int ROWS_OFF = 131072;
constexpr int ULIST_OFF = ROWS_OFF + 4096;
constexpr int ROPE_OFF = ULIST_OFF + 256;
constexpr int LDSCTL_OFF = ROPE_OFF + 8192, MISC_OFF = LDSCTL_OFF + 320;
constexpr int LDS_BYTES = 147456;
static_assert(MISC_OFF + 256 <= LDS_BYTES, "LDS map");

#define GAS __attribute__((address_space(1)))
#define LAS __attribute__((address_space(3)))
typedef unsigned v4u __attribute__((ext_vector_type(4)));
typedef GAS unsigned gu32;
#define RLX_AGENT __ATOMIC_RELAXED, __HIP_MEMORY_SCOPE_AGENT
#define LDS_WAIT() asm volatile("s_waitcnt lgkmcnt(0)" ::: "memory")
#define VM_WAIT() asm volatile("s_waitcnt vmcnt(0)" ::: "memory")
__device__ __forceinline__ unsigned pk2(float lo, float hi) { return (unsigned)f2bf(lo) | ((unsigned)f2bf(hi) << 16); }

#define XB_TMO      128
#define XB_XCNT(j)  (256  + 64 * (j))
#define XB_XSUB(j)  (1280 + 64 * (j))
#define XB_XGEN(j)  (2304 + 64 * (j))
#define XB_TOP      3328
#define XB_TOPGEN   3392
#define XCD_BAR_WORDS 3456
#define XB_SPIN_CAP (1u << 20)
__device__ __forceinline__ unsigned xb_ld(unsigned* p)              { return __hip_atomic_load(p, __ATOMIC_RELAXED, __HIP_MEMORY_SCOPE_AGENT); }
__device__ __forceinline__ unsigned xb_add(unsigned* p, unsigned v) { return __hip_atomic_fetch_add(p, v, __ATOMIC_RELAXED, __HIP_MEMORY_SCOPE_AGENT); }
__device__ __forceinline__ unsigned xb_xcc_id() { return (unsigned)__builtin_amdgcn_s_getreg((3 << 11) | 20) & 0xFu; }
#define XB_SPIN(cond, bar) do { unsigned _sp = 0; while (cond) { __builtin_amdgcn_s_sleep(1); \
    if ((++_sp & 255u) == 0u) { if (xb_ld(&(bar)[XB_TMO])) break; if (_sp > XB_SPIN_CAP) { atomicAdd(&(bar)[XB_TMO], 1u); break; } } } } while (0)
struct XcdBarrier { unsigned* bar; unsigned x; volatile LAS unsigned* st; };
__device__ __forceinline__ XcdBarrier xcd_barrier_post(unsigned* bar, volatile LAS unsigned* st, bool leader) {
    XcdBarrier b; b.bar = bar; b.x = xb_xcc_id(); b.st = st;
    if (leader) (void)xb_add(&bar[XB_XCNT(b.x)], 1u);
    return b;
}
__device__ __forceinline__ void xcd_barrier_complete(unsigned* bar, unsigned x, unsigned& nloc, unsigned& nx) {
    const unsigned G = gridDim.x * gridDim.y * gridDim.z;
    unsigned sum, cnt, mine, sp = 0u;
    for (;;) {
        sum = 0u; cnt = 0u; mine = 0u;
#pragma unroll
        for (unsigned j = 0; j < 16; ++j) { const unsigned c = xb_ld(&bar[XB_XCNT(j)]); sum += c; cnt += (c > 0u) ? 1u : 0u; mine = (j == x) ? c : mine; }
        if (sum == G) break;
        __builtin_amdgcn_s_sleep(1);
        if ((++sp & 255u) == 0u) { if (xb_ld(&bar[XB_TMO])) break; if (sp > XB_SPIN_CAP) { atomicAdd(&bar[XB_TMO], 1u); break; } }
    }
    nloc = mine > 0u ? mine : 1u; nx = cnt > 0u ? cnt : 1u;
}
__device__ __forceinline__ void xcd_barrier(const XcdBarrier& b, bool leader) {
    asm volatile("s_waitcnt vmcnt(0)" ::: "memory");
    __syncthreads();
    if (leader) {
        unsigned* bar = b.bar;
        __builtin_amdgcn_s_waitcnt(0);
        unsigned nloc = b.st[0], nx = b.st[1];
        if (nloc == 0u) { xcd_barrier_complete(bar, b.x, nloc, nx); b.st[0] = nloc; b.st[1] = nx; }
        const unsigned old = xb_add(&bar[XB_XSUB(b.x)], 1u);
        const unsigned gen = old / nloc;
        if (old + 1u == (gen + 1u) * nloc) {
            __builtin_amdgcn_fence(__ATOMIC_RELEASE, "agent");
            asm volatile("s_waitcnt vmcnt(0)" ::: "memory");
            const unsigned og = xb_add(&bar[XB_TOP], 1u);
            const unsigned tg = og / nx;
            if (og + 1u == (tg + 1u) * nx) xb_add(&bar[XB_TOPGEN], 1u);
            else XB_SPIN(xb_ld(&bar[XB_TOPGEN]) == tg, bar);
            __builtin_amdgcn_fence(__ATOMIC_ACQUIRE, "agent");
            xb_add(&bar[XB_XGEN(b.x)], 1u);
            asm volatile("s_waitcnt vmcnt(0)" ::: "memory");
        } else {
            XB_SPIN(xb_ld(&bar[XB_XGEN(b.x)]) == gen, bar);
            __builtin_amdgcn_fence(__ATOMIC_ACQUIRE, "agent");
            asm volatile("s_waitcnt vmcnt(0)" ::: "memory");
        }
    }
    __syncthreads();
}

constexpr size_t WM_CTL = 0;
constexpr int CW_BAR = 4096;
constexpr size_t WM_WIN = 352 * MiB;
constexpr size_t WM_WOUT = 384 * MiB;
constexpr size_t WM_WGU = 400 * MiB;
constexpr size_t WM_WDN = 528 * MiB;
constexpr size_t WM_CS = 592 * MiB;
constexpr size_t WM_CSC = 656 * MiB;
constexpr size_t WM_WC = 657 * MiB;
constexpr size_t WM_PQT = 658 * MiB;
constexpr size_t WM_PQTC = 674 * MiB;
constexpr size_t WM_PART = 676 * MiB;
constexpr size_t WM_HIDB = 744 * MiB;
constexpr size_t WM_END = 768 * MiB;

struct MArgs { const float* in[24]; float* out; unsigned char* ws; int ph_lo, ph_hi, layer, use_bar; };

struct Frame {
    LAS unsigned char* lds; volatile LAS unsigned* MISC; unsigned* ctl;
    int wave, vcu, G;
};

__device__ __forceinline__ void p0_transpose_item(const float* W, int K, int N, bf16_t* WT, int n_row_base, LAS float* scr, int item, int lane) {
    const int nblk = N / 32, kb = item / nblk, nb = item % nblk, k0 = 64 * kb, n0 = 32 * nb;
    float tv[32];
    { const float* wp = W + (size_t)(k0 + (lane >> 5)) * N + n0 + (lane & 31);
#pragma unroll
      for (int i = 0; i < 32; ++i) tv[i] = __builtin_nontemporal_load(wp + (size_t)(2 * i) * N); }
#pragma unroll
    for (int i = 0; i < 32; ++i) scr[(2 * i + (lane >> 5)) * 33 + (lane & 31)] = tv[i];
    LDS_WAIT(); asm volatile("" ::: "memory");
    const int c = lane & 7;
#pragma unroll
    for (int j = 0; j < 4; ++j) { const int n = (lane >> 3) + 8 * j; const LAS float* s = scr + (8 * c) * 33 + n;
        v4u o; o.x = pk2(s[0 * 33], s[1 * 33]); o.y = pk2(s[2 * 33], s[3 * 33]); o.z = pk2(s[4 * 33], s[5 * 33]); o.w = pk2(s[6 * 33], s[7 * 33]);
        *(v4u*)(WT + (size_t)(n_row_base + n) * K + k0 + 8 * c) = o; }
    LDS_WAIT(); asm volatile("" ::: "memory");
}

constexpr int DEF0_EXP = 6144;
__device__ __forceinline__ unsigned char* opq(unsigned char* p) { unsigned lo = (unsigned)(uintptr_t)p, hi = (unsigned)((uintptr_t)p >> 32); asm volatile("" : "+v"(lo), "+v"(hi)); lo = __builtin_amdgcn_readfirstlane(lo); hi = __builtin_amdgcn_readfirstlane(hi); return (unsigned char*)(((uintptr_t)hi << 32) | (uintptr_t)lo); }
__device__ __forceinline__ const char* opqc(const char* p) { return (const char*)opq((unsigned char*)p); }
__device__ __forceinline__ int opqv(int v) { asm volatile("" : "+v"(v)); return v; }
#define PHASE_PROLOG unsigned char* ws = opq(args.ws); const char* ka = opqc((const char*)__builtin_amdgcn_kernarg_segment_ptr()); const int lane = opqv(hw_lane_id()), tid = F.wave * 64 + lane; (void)ws; (void)ka; (void)lane; (void)tid
#define INP(k) (*(const float* const*)(ka + (k) * 8))


__device__ __forceinline__ float wave_sum_dpp(float v) {
    v += __int_as_float(__builtin_amdgcn_update_dpp(0, __float_as_int(v), 0xB1, 0xf, 0xf, false));
    v += __int_as_float(__builtin_amdgcn_update_dpp(0, __float_as_int(v), 0x4E, 0xf, 0xf, false));
    v += __int_as_float(__builtin_amdgcn_update_dpp(0, __float_as_int(v), 0x141, 0xf, 0xf, false));
    v += __int_as_float(__builtin_amdgcn_update_dpp(0, __float_as_int(v), 0x140, 0xf, 0xf, false));
    const float r0 = __int_as_float(__builtin_amdgcn_readlane(__float_as_int(v), 0)), r1 = __int_as_float(__builtin_amdgcn_readlane(__float_as_int(v), 16));
    const float r2 = __int_as_float(__builtin_amdgcn_readlane(__float_as_int(v), 32)), r3 = __int_as_float(__builtin_amdgcn_readlane(__float_as_int(v), 48));
    return (r0 + r1) + (r2 + r3);
}
typedef float f32x2_t __attribute__((ext_vector_type(2)));
struct N2Ctx { const float* X; bf16_t* H; const LAS float* g2; const LAS float* vss; const float* wg; const float* we; const float* bg; const float* be; int* tok_e; float* tok_w; LAS int* sel; int row0; };
__device__ __forceinline__ void n2_pass(const N2Ctx& C, LAS float* wt, int rb, int lim, int wave, int lane, int tid, unsigned char* probe_ws_) {
    const int l4 = lane * 4;
    PROBE_MARK(0);
    int rw[5]; bool ok[5]; float rstd[5]; const LAS float* shp[5];
#pragma unroll
    for (int i = 0; i < 5; ++i) { const int r = rb + wave + 8 * i; ok[i] = r < lim; rw[i] = ok[i] ? r : rb; shp[i] = C.vss + modsel(rw[i]) * 2 * D; }
    {
        pg8::f32x4 vn[8];
#pragma unroll
        for (int j = 0; j < 8; ++j) vn[j] = *(const pg8::f32x4*)(C.X + (size_t)rw[0] * D + l4 + 256 * j);
#pragma unroll
        for (int i = 0; i < 5; ++i) {
            pg8::f32x4 v[8]; float ss = 0.f;
#pragma unroll
            for (int j = 0; j < 8; ++j) v[j] = vn[j];
            if (i < 4) {
#pragma unroll
                for (int j = 0; j < 8; ++j) vn[j] = *(const pg8::f32x4*)(C.X + (size_t)rw[i + 1] * D + l4 + 256 * j); }
#pragma unroll
            for (int j = 0; j < 8; ++j) ss += v[j][0] * v[j][0] + v[j][1] * v[j][1] + v[j][2] * v[j][2] + v[j][3] * v[j][3];
            ss = wave_sum(ss);
            rstd[i] = rsqrtf(ss * (1.f / D) + 1e-6f);
            if (ok[i]) {
#pragma unroll
                for (int j = 0; j < 8; ++j) { const int col = l4 + 256 * j; const pg8::f32x4 g = *(const LAS pg8::f32x4*)(C.g2 + col), a = *(const LAS pg8::f32x4*)(shp[i] + D + col), b = *(const LAS pg8::f32x4*)(shp[i] + col);
                    const pg8::f32x4 h = v[j] * rstd[i] * g * (a + 1.f) + b; pg8::u32x2 o; o.x = pk2(h[0], h[1]); o.y = pk2(h[2], h[3]); *(pg8::u32x2*)(C.H + (size_t)rw[i] * D + col) = o; }
            }
        }
    }
    PROBE_MARK(1);
    f32x2_t lgp[5][10];
#pragma unroll
    for (int i = 0; i < 5; ++i)
#pragma unroll
        for (int q = 0; q < 10; ++q) lgp[i][q] = (f32x2_t){0.f, 0.f};
    {
        pg8::f32x4 xn[5], xm[5], gn;
        gn = *(const LAS pg8::f32x4*)(C.g2 + l4);
#pragma unroll
        for (int i = 0; i < 5; ++i) xn[i] = *(const pg8::f32x4*)(C.X + (size_t)rw[i] * D + l4);
#pragma unroll
        for (int i = 0; i < 5; ++i) xm[i] = *(const pg8::f32x4*)(C.X + (size_t)rw[i] * D + l4 + 256);
#pragma unroll 1
        for (int jt = 0; jt < 8; ++jt) {
            const int half = jt >> 2, jj = jt & 3;
            if (jj == 0) {
                __syncthreads();
#pragma unroll
                for (int cc = 0; cc < 2; ++cc) { const int c = tid + 512 * cc; const int col = 1024 * half + c;
                    LAS f32x2_t* wt2 = (LAS f32x2_t*)wt;
                    const pg8::f32x4 a = *(const pg8::f32x4*)(C.wg + (size_t)col * 4);
                    wt2[0 * 1024 + c] = (f32x2_t){a[0], a[1]}; wt2[1 * 1024 + c] = (f32x2_t){a[2], a[3]};
#pragma unroll
                    for (int q = 0; q < 4; ++q) { const pg8::f32x4 b = *(const pg8::f32x4*)(C.we + (size_t)col * 16 + q * 4);
                        wt2[(2 + 2 * q) * 1024 + c] = (f32x2_t){b[0], b[1]}; wt2[(3 + 2 * q) * 1024 + c] = (f32x2_t){b[2], b[3]}; } }
                __syncthreads();
            }
            const int cl = l4 + 256 * jj, col = 1024 * half + cl;
            const pg8::f32x4 g = gn;
            pg8::f32x4 h[5];
#pragma unroll
            for (int i = 0; i < 5; ++i) h[i] = xn[i];
            { const int coln = l4 + 256 * min(jt + 1, 7), colm = l4 + 256 * min(jt + 2, 7);
              gn = *(const LAS pg8::f32x4*)(C.g2 + coln);
#pragma unroll
              for (int i = 0; i < 5; ++i) xn[i] = xm[i];
#pragma unroll
              for (int i = 0; i < 5; ++i) xm[i] = *(const pg8::f32x4*)(C.X + (size_t)rw[i] * D + colm); }
#pragma unroll
            for (int i = 0; i < 5; ++i) { const pg8::f32x4 a = *(const LAS pg8::f32x4*)(shp[i] + D + col), b = *(const LAS pg8::f32x4*)(shp[i] + col); h[i] = h[i] * rstd[i] * g * (a + 1.f) + b; }
#pragma unroll
            for (int qp = 0; qp < 10; ++qp) { const pg8::f32x4 wa = *(const LAS pg8::f32x4*)(wt + (qp * 1024 + cl) * 2), wb = *(const LAS pg8::f32x4*)(wt + (qp * 1024 + cl) * 2 + 4);
                const f32x2_t w0 = {wa[0], wa[1]}, w1 = {wa[2], wa[3]}, w2 = {wb[0], wb[1]}, w3 = {wb[2], wb[3]};
#pragma unroll
                for (int i = 0; i < 5; ++i) { lgp[i][qp] += h[i][0] * w0; lgp[i][qp] += h[i][1] * w1; lgp[i][qp] += h[i][2] * w2; lgp[i][qp] += h[i][3] * w3; } }
        }
    }
    PROBE_MARK(2);
    float lg[5][20];
#pragma unroll
    for (int i = 0; i < 5; ++i)
#pragma unroll
        for (int q = 0; q < 20; ++q) lg[i][q] = wave_sum_dpp(lgp[i][q >> 1][q & 1]);
    PROBE_MARK(3);
    if (lane < 5) {
        int row = rw[0]; bool okr = ok[0];
#pragma unroll
        for (int i = 1; i < 5; ++i) { row = (lane == i) ? rw[i] : row; okr = (lane == i) ? ok[i] : okr; }
        if (okr) {
            float gl[4], el[16];
#pragma unroll
            for (int q = 0; q < 20; ++q) { float vq = lg[0][q];
#pragma unroll
                for (int i = 1; i < 5; ++i) vq = (lane == i) ? lg[i][q] : vq;
                if (q < 4) gl[q] = vq + C.bg[q]; else el[q - 4] = vq + C.be[q - 4]; }
            int gs = 0; float gm = gl[0];
#pragma unroll
            for (int q = 1; q < 4; ++q) if (gl[q] > gm) { gm = gl[q]; gs = q; }
            float den = 0.f;
#pragma unroll
            for (int q = 0; q < 4; ++q) den += __expf(gl[q] - gm);
            const float pg = 1.f / den;
            float eg[4];
#pragma unroll
            for (int q = 0; q < 4; ++q) eg[q] = gs == 0 ? el[q] : (gs == 1 ? el[4 + q] : (gs == 2 ? el[8 + q] : el[12 + q]));
            int i0 = 0; float m0 = eg[0];
#pragma unroll
            for (int q = 1; q < 4; ++q) if (eg[q] > m0) { m0 = eg[q]; i0 = q; }
            int i1 = -1; float m1 = -3.0e38f;
#pragma unroll
            for (int q = 0; q < 4; ++q) if (q != i0 && eg[q] > m1) { m1 = eg[q]; i1 = q; }
            const float w0 = 1.f / (1.f + __expf(m1 - m0)), w1 = 1.f - w0;
            const int e0 = gs * 4 + i0, e1 = gs * 4 + i1;
            C.tok_e[row * 2] = e0; C.tok_e[row * 2 + 1] = e1; C.tok_w[row * 2] = w0 * pg; C.tok_w[row * 2 + 1] = w1 * pg;
            C.sel[(row - C.row0) * 2] = e0; C.sel[(row - C.row0) * 2 + 1] = e1;
        }
    }
}

__global__ void __launch_bounds__(NWAVES * 64, 2) mega_fwd(MArgs args) {
    extern __shared__ __attribute__((aligned(16))) unsigned char lds_raw[];
    Frame F;
    F.lds = (LAS unsigned char*)lds_raw;
    F.MISC = (volatile LAS unsigned*)(F.lds + MISC_OFF);
    F.wave = __builtin_amdgcn_readfirstlane((int)threadIdx.x >> 6);
    F.G = gridDim.x; { const int bx = blockIdx.x; F.vcu = (F.G % 8 == 0) ? (bx % 8) * (F.G / 8) + bx / 8 : bx; }
    F.ctl = (unsigned*)(args.ws + WM_CTL);
    for (int u = threadIdx.x; u < (LDS_BYTES - LDSCTL_OFF) / 4; u += NWAVES * 64) ((LAS unsigned*)(F.lds + LDSCTL_OFF))[u] = 0u;
    __syncthreads();
    XcdBarrier bar; bar.bar = F.ctl + CW_BAR; bar.x = 0; bar.st = nullptr;
    if (args.use_bar) bar = xcd_barrier_post(F.ctl + CW_BAR, F.MISC + 8, threadIdx.x == 0);
#define GRID_BAR() do { if (args.use_bar) xcd_barrier(bar, F.wave == 0 && hw_lane_id() == 0); } while (0)
    const int lo = args.ph_lo, hi = args.ph_hi;
#ifdef PROBE_DUP
#define PC_OF(pi) ((pi) <= PROBE_DUP ? (pi) : (pi) - 1)
#else
#define PC_OF(pi) (pi)
#endif
    const int gw = F.vcu * NWAVES + F.wave, NGW = F.G * NWAVES;
#if defined(PROBE_TS) && !defined(PROBE_TA)
#define PROBE_TA PROBE_TS
#define PROBE_TB (PROBE_TS + 1)
#endif
#ifdef PROBE_TA
static_assert(MISC_OFF + 512 == 144448, "probe stamp area");
#define TS_PTR ((volatile LAS unsigned long long*)(F.lds + MISC_OFF + 512))
    if (blockIdx.x == PROBE_BLK && F.wave == 0 && hw_lane_id() == 0) TS_PTR[lo] = rt_now();
#endif
  for (int pi = lo; pi < hi; ++pi) {
    const int pc = PC_OF(pi);
    const int l = (pc >= 12 && pc < 23) ? 1 : 0;
    const int kk = (pc == 0) ? -1 : (pc == 23 ? -2 : pc - 1 - 11 * l);
    const int mrows = (l == 1) ? MLAT : MROWS;


#define x_in INP(0)
#define c_in INP(1)
#define ctx_in INP(2)
#define c_ctx INP(3)
#define w_mod INP(4)
#define b_mod INP(5)
#define w_in INP(8)
#define w_out INP(9)
#define w_gate INP(20)
#define w_up INP(21)
#define w_down INP(22)
#define modv   ((float*)(ws + WS_MOD))
#define rope   ((float*)(ws + WS_ROPE))
#define tok_w  ((float*)(ws + WS_TOK + 128 * 1024))
#define tok_e  ((int*)(ws + WS_TOK))
#define list   ((unsigned*)(ws + WS_LIST))
#define X      ((float*)(ws + WS_X))
#define H      ((bf16_t*)(ws + WS_H))
#define U      ((bf16_t*)(ws + WS_U))
#define MIX    ((bf16_t*)(ws + WS_MIX))
#define Y2     ((bf16_t*)(ws + WS_Y2))
#define Win_t  ((bf16_t*)(ws + WM_WIN))
#define Wout_t ((bf16_t*)(ws + WM_WOUT))
#define Wgu_t  ((bf16_t*)(ws + WM_WGU))
#define Wdn_t  ((bf16_t*)(ws + WM_WDN))
#define CS     ((bf16_t*)(ws + WM_CS))
#define CSC    ((bf16_t*)(ws + WM_CSC))
#define PEQO   ((bf16_t*)(ws + WM_CS + 16 * MiB))
#define AUXB   ((float*)(ws + WM_CS + 32 * MiB))
#define PARTC  ((float*)(ws + WM_CS + 33 * MiB))
#define WC     ((bf16_t*)(ws + WM_WC))
#define PQT    ((bf16_t*)(ws + WM_PQT))
#define PQTC   ((bf16_t*)(ws + WM_PQTC))
#define PART   ((float*)(ws + WM_PART))
#define HIDB   ((bf16_t*)(ws + WM_HIDB))
#define g_norm1 INP(6)
#define g_norm2 INP(7)
#define g_final INP(23)
#define w_rg INP(16)
#define b_rg INP(17)
#define w_re INP(18)
#define b_re INP(19)
    const PG8_LAS unsigned* rows_lds = (const PG8_LAS unsigned*)(F.lds + ROWS_OFF);
    LAS int* ulist = (LAS int*)(F.lds + ULIST_OFF);

    if (pc == 0) {
        PHASE_PROLOG;
        unsigned char* probe_ws_ = args.ws; (void)probe_ws_; PROBE_MARK(8);
        LAS float* ctab = (LAS float*)(F.lds + 67584); LAS float* stab = ctab + 4096;
        for (int i = tid; i < 4096; i += NWAVES * 64) { float s, c; sincospif((float)i * (1.f / 2048.f), &s, &c); ctab[i] = c; stab[i] = s; }
        __syncthreads();
#ifdef PROBE_P0
        for (int rep_ = 0; rep_ < (PROBE_P0 == 1 ? 2 : 1); ++rep_)
#endif
        for (int rt = F.vcu; rt < 2 * 2048; rt += F.G) {
            const int eo = rt >> 11, tp = rt & 2047;
            if (tid < 256) { const int k0 = tid * 8; float v[8];
#pragma unroll
                for (int q = 0; q < 8; ++q) { const float rev = (float)((tp * (k0 + q)) & 4095) * (1.f / 4096.f); v[q] = eo ? __builtin_amdgcn_sinf(rev) : __builtin_amdgcn_cosf(rev); }
                v4u o; o.x = pk2(v[0], v[1]); o.y = pk2(v[2], v[3]); o.z = pk2(v[4], v[5]); o.w = pk2(v[6], v[7]);
                *(v4u*)(CS + (size_t)rt * 2048 + k0) = o; }
        }
        PROBE_MARK(9);
        {
            for (int e = (int)blockIdx.x * (NWAVES * 64) + tid; e < 256 * 256; e += F.G * NWAVES * 64) { const int r = e >> 8, c = e & 255; const int part = r >> 7, cq = r & 127; float v = 0.f;
                if (c < 128) { const int idx = ((c * cq) & 127) * 32; v = part ? stab[idx] : ctab[idx]; } WC[e] = f2bf(v); }
        }
        {
            for (int e = (int)blockIdx.x * (NWAVES * 64) + tid; e < 256 * 512; e += F.G * NWAVES * 64) { const int tp = e >> 9, k = e & 511; const int part = k >> 8; const int idx = ((tp * (k & 255)) & 255) * 16;
                CSC[e] = f2bf(part ? -stab[idx] : ctab[idx]); }
        }
        {
            for (int e = (int)blockIdx.x * (NWAVES * 64) + tid; e < 64 * 16; e += F.G * NWAVES * 64) { const int pos = e >> 4, i = e & 15; const float freq = powf(10000.f, -(float)(2 * i) / 32.f); const float ang = (float)pos * freq;
                rope[e * 2] = cosf(ang); rope[e * 2 + 1] = sinf(ang); }
        }
        __syncthreads();
        PROBE_MARK(10);
        {
            LAS float* sl = (LAS float*)(F.lds + 67584);
            for (int e = tid; e < 3 * D; e += NWAVES * 64) { const int sidx = e / D, k = e % D; sl[e] = silu_f(sidx == 0 ? c_in[k] : (sidx == 1 ? c_in[D + k] : c_ctx[k])); }
            __syncthreads();
#ifdef PROBE_P0
            for (int rep_ = 0; rep_ < (PROBE_P0 == 2 ? 2 : 1); ++rep_)
#endif
            for (int it = blockIdx.x; it < 128; it += F.G) {
                const int l = it >> 6, j0 = (it & 63) * 192;
                LAS float* red = (LAS float*)(F.lds + 67584 + 32768);
                pg8::f32x4 a0 = {0.f, 0.f, 0.f, 0.f}, a1 = a0, a2 = a0;
                if (lane < 48) {
                    const float* w = w_mod + ((size_t)l * D + (size_t)F.wave * 256) * (NMOD * D) + j0 + 4 * lane;
#pragma unroll 16
                    for (int i0_ = 0; i0_ < 256; ++i0_) { const int i = (i0_ + 2 * it) & 255; const int kk = F.wave * 256 + i;
                        const pg8::f32x4 wv = __builtin_nontemporal_load((const pg8::f32x4*)(w + (size_t)i * (NMOD * D)));
                        const float s0 = sl[kk], s1 = sl[D + kk], s2 = sl[2 * D + kk];
                        a0 += wv * s0; a1 += wv * s1; a2 += wv * s2; }
                    LAS float* rp = red + (size_t)(F.wave * 3) * 192 + 4 * lane;
#pragma unroll
                    for (int e = 0; e < 4; ++e) { rp[e] = a0[e]; rp[192 + e] = a1[e]; rp[384 + e] = a2[e]; }
                }
                __syncthreads();
                for (int o = tid; o < 576; o += NWAVES * 64) { const int s_ = o / 192, j = o % 192; float v = b_mod[l * NMOD * D + j0 + j];
#pragma unroll
                    for (int w = 0; w < 8; ++w) v += red[(w * 3 + s_) * 192 + j];
                    modv[((size_t)l * 3 + s_) * (NMOD * D) + j0 + j] = v; }
                __syncthreads();
            }
        }
        PROBE_MARK(11);
        {
            LAS float* scr = (LAS float*)(F.lds + F.wave * 8448);
            constexpr int I_IN = (D / 64) * (IN_DIM / 32), I_OUT = (D / 64) * (D / 32), I_GU = (D / 64) * (DEXP / 32), I_DN = (DEXP / 64) * (D / 32);
            constexpr int PER_L = I_IN + I_OUT + NEXP * (2 * I_GU + I_DN);
#ifdef PROBE_P0
            for (int rep_ = 0; rep_ < (PROBE_P0 == 3 ? 2 : 1); ++rep_)
#endif
            constexpr int CUT = PER_L - I_OUT - DEF0_EXP;
            int it_first = gw, it_step = NGW, it_end = CUT;
            if (F.G == 256) { constexpr int NA = CUT;   const bool gemv_wg = blockIdx.x < 128;
                const int ci = (gemv_wg ? (int)blockIdx.x : (int)blockIdx.x - 128) * NWAVES + F.wave;
                it_first = gemv_wg ? NA + ci : ci; it_step = 128 * NWAVES; it_end = gemv_wg ? CUT : NA; }
            for (int itc = it_first; itc < it_end; itc += it_step) {
                const int it = itc < I_IN ? itc : itc + I_OUT;
                const int l = it / PER_L; int r = it % PER_L;
                if (r < I_IN) { const int nb = r % (IN_DIM / 32); p0_transpose_item(w_in + (size_t)l * D * IN_DIM, D, IN_DIM, Win_t + (size_t)l * IN_DIM * D, nb * 32, scr, r, lane); continue; } r -= I_IN;
                if (r < I_OUT) { const int nb = r % (D / 32); p0_transpose_item(w_out + (size_t)l * D * D, D, D, Wout_t + (size_t)l * D * D, nb * 32, scr, r, lane); continue; } r -= I_OUT;
                const int e = r / (2 * I_GU + I_DN); r %= (2 * I_GU + I_DN);
                const size_t le = (size_t)l * NEXP + e;
                if (r < 2 * I_GU) { const int up = r >= I_GU; if (up) r -= I_GU; const int nb = r % (DEXP / 32); const int n0 = nb * 32;
                    const int rowb = (n0 >> 7) * 256 + (n0 & 127) + up * 128;
                    p0_transpose_item((up ? w_up : w_gate) + le * D * DEXP, D, DEXP, Wgu_t + le * (2 * DEXP) * D, rowb, scr, r, lane); continue; } r -= 2 * I_GU;
                { const int nb = r % (D / 32); p0_transpose_item(w_down + le * DEXP * D, DEXP, D, Wdn_t + le * D * DEXP, nb * 32, scr, r, lane); }
            }
        }
    }


    if (kk == 0) {
        PHASE_PROLOG; const float* modl = modv + (size_t)l * 3 * NMOD * D; (void)modl;
        const float* g1 = g_norm1 + l * D;
        const int l4 = lane * 4;
        LAS float* vg = (LAS float*)(F.lds + RING_OFF);
        LAS float* vss = vg + D;
        LAS float* vga = vss + 6 * D;
        for (int e = tid; e < D / 4; e += NWAVES * 64) {
            *(LAS f32x4*)(vg + 4 * e) = *(const f32x4*)(g1 + 4 * e);
#pragma unroll
            for (int s_ = 0; s_ < 3; ++s_) { const float* shp_ = modl + (size_t)s_ * (NMOD * D);
                *(LAS f32x4*)(vss + (s_ * 2 + 0) * D + 4 * e) = *(const f32x4*)(shp_ + 4 * e); *(LAS f32x4*)(vss + (s_ * 2 + 1) * D + 4 * e) = *(const f32x4*)(shp_ + D + 4 * e);
                if (l == 1) *(LAS f32x4*)(vga + s_ * D + 4 * e) = *(const f32x4*)(modv + (size_t)s_ * (NMOD * D) + 5 * D + 4 * e); }
        }
        __syncthreads();
#define N1_SRC(row) ((l == 0) ? ((row) < MLAT ? x_in + (size_t)(row) * D : ctx_in + (size_t)((row) - MLAT) * D) : X + (size_t)(row) * D)
        f32x4 vn[8]; pg8::u32x2 yn0[8], yn1[8];
        int row = gw;
        { const int r0 = min(row, MROWS - 1); const float* src = N1_SRC(r0);
#pragma unroll
            for (int j = 0; j < 8; ++j) vn[j] = *(const f32x4*)(src + l4 + 256 * j);
#pragma unroll
            for (int j = 0; j < 8; ++j) { yn0[j] = (pg8::u32x2){0u, 0u}; yn1[j] = (pg8::u32x2){0u, 0u}; }
            if (l == 1) {
#pragma unroll
                for (int j = 0; j < 8; ++j) { yn0[j] = *(const pg8::u32x2*)(Y2 + (size_t)(2 * r0) * D + l4 + 256 * j); yn1[j] = *(const pg8::u32x2*)(Y2 + (size_t)(2 * r0 + 1) * D + l4 + 256 * j); } } }
#pragma unroll 1
        for (; row < MROWS; row += NGW) {
            const int l4 = opqv(lane * 4);
            const int s = modsel(row);
            f32x4 v[8]; pg8::u32x2 y0[8], y1[8];
#pragma unroll
            for (int j = 0; j < 8; ++j) { v[j] = vn[j]; y0[j] = yn0[j]; y1[j] = yn1[j]; }
            const int nrow = min(row + NGW, MROWS - 1);
            { const float* src = N1_SRC(nrow);
#pragma unroll
                for (int j = 0; j < 8; ++j) vn[j] = *(const f32x4*)(src + l4 + 256 * j);
                if (l == 1) {
#pragma unroll
                    for (int j = 0; j < 8; ++j) { yn0[j] = *(const pg8::u32x2*)(Y2 + (size_t)(2 * nrow) * D + l4 + 256 * j); yn1[j] = *(const pg8::u32x2*)(Y2 + (size_t)(2 * nrow + 1) * D + l4 + 256 * j); } } }
            if (l == 1) {
                const float* ga = modv + (size_t)s * (NMOD * D) + 5 * D;
#pragma unroll
                for (int j = 0; j < 8; ++j) { const int col = l4 + 256 * j; const f32x4 g = *(const LAS f32x4*)(vga + s * D + col);
                    v[j][0] += g[0] * (__uint_as_float(y0[j].x << 16) + __uint_as_float(y1[j].x << 16)); v[j][1] += g[1] * (__uint_as_float(y0[j].x & 0xffff0000u) + __uint_as_float(y1[j].x & 0xffff0000u));
                    v[j][2] += g[2] * (__uint_as_float(y0[j].y << 16) + __uint_as_float(y1[j].y << 16)); v[j][3] += g[3] * (__uint_as_float(y0[j].y & 0xffff0000u) + __uint_as_float(y1[j].y & 0xffff0000u));
                    *(f32x4*)(X + (size_t)row * D + col) = v[j]; }
            }
            float ss = 0.f;
#pragma unroll
            for (int j = 0; j < 8; ++j) ss += v[j][0] * v[j][0] + v[j][1] * v[j][1] + v[j][2] * v[j][2] + v[j][3] * v[j][3];
            ss = wave_sum(ss);
            const float rstd = rsqrtf(ss * (1.f / D) + 1e-6f);
            const float* sh = modl + (size_t)s * (NMOD * D); const float* sc = sh + D;
#pragma unroll
            for (int j = 0; j < 8; ++j) { const int col = l4 + 256 * j; const f32x4 g = *(const LAS f32x4*)(vg + col), a = *(const LAS f32x4*)(vss + (s * 2 + 1) * D + col), b = *(const LAS f32x4*)(vss + (s * 2) * D + col);
                const f32x4 h = v[j] * rstd * g * (a + 1.f) + b; pg8::u32x2 o; o.x = pk2(h[0], h[1]); o.y = pk2(h[2], h[3]); *(pg8::u32x2*)(H + (size_t)row * D + col) = o; }
        }
#undef N1_SRC
    }
    if (kk == 1) {
        PHASE_PROLOG; const float* modl = modv + (size_t)l * 3 * NMOD * D; (void)modl;
        pg8::Prob P{H, Win_t + (size_t)l * IN_DIM * D, D, D, D, 0, (long long)256 * D, 0, 0, (long long)256 * D, 0, 0};
        pg8::StaticOrder S; S.init(MROWS / 256, IN_DIM / 256, F.G, (int)blockIdx.x);
        for (int e = tid; e < 2048; e += NWAVES * 64) ((LAS float*)(F.lds + ROPE_OFF))[e] = rope[e];
        __syncthreads();
        pg8::EpiG1 E{U, (const PG8_LAS float*)(F.lds + ROPE_OFF)};
        pg8::gemm_phase<pg8::EpiG1, pg8::StaticOrder, false, true>(F.lds + RING_OFF, P, S, E, rows_lds, F.wave);
    }
    if (kk == 2) {
        PHASE_PROLOG; const float* modl = modv + (size_t)l * 3 * NMOD * D; (void)modl;
        { unsigned char* probe_ws_ = args.ws; (void)probe_ws_; PROBE_MARK(16); }
        const int NT = mrows / 256;
        pg8::Prob P{WC, U + UF, 256, IN_DIM, 256, 0, 0, 0, 0, (long long)256 * IN_DIM, 128, 0};
        pg8::DftASched S{4 * NT, F.G, (int)blockIdx.x, 0};
        pg8::EpiDftA E{PQT, PQTC};
#ifdef PROBE_SUB
        for (int rep_ = 0; rep_ < (PROBE_SUB == 3 ? 2 : 1); ++rep_)
#endif
        pg8::gemm_phase<pg8::EpiDftA, pg8::DftASched, false, true>(F.lds + RING_OFF, P, S, E, rows_lds, F.wave);
        __syncthreads();
        { unsigned char* probe_ws_ = args.ws; (void)probe_ws_; PROBE_MARK(17); }
        {
            const int nun = (l == 0) ? 272 : 256;
#ifdef PROBE_SUB
            for (int rep_ = 0; rep_ < (PROBE_SUB == 1 ? 2 : 1); ++rep_)
#endif
            for (int un = blockIdx.x; un < 256; un += F.G) att::attn_unit(F.lds + RING_OFF, U, MIX, INP(10) + l * 8, un, tid);
            { const int first = (F.G >= 152) ? 136 : 0; for (int un = 256 + (int)blockIdx.x - first; un >= 256 && un < nun; un += F.G) att::attn_unit(F.lds + RING_OFF, U, MIX, INP(10) + l * 8, un, tid); }
        }

        { unsigned char* probe_ws_ = args.ws; (void)probe_ws_; PROBE_MARK(18); }
        {
            const int nti = (l == 0) ? 272 : 256;
            { __syncthreads(); conv_fill_w(F.lds + RING_OFF, INP(12) + l * 31 * 512, tid); }
#ifdef PROBE_SUB
            for (int rep_ = 0; rep_ < (PROBE_SUB == 2 ? 2 : 1); ++rep_)
#endif
            for (int ti = blockIdx.x; ti < 256; ti += F.G) conv_tile(F.lds + RING_OFF, U, MIX, INP(11) + l * 3 * 512, INP(13) + l * 512, INP(14) + l * 512, INP(15) + l * 512, ti, tid);
            { const int first = (F.G >= 168) ? 152 : 0; for (int ti = 256 + (int)blockIdx.x - first; ti >= 256 && ti < nti; ti += F.G) conv_tile(F.lds + RING_OFF, U, MIX, INP(11) + l * 3 * 512, INP(13) + l * 512, INP(14) + l * 512, INP(15) + l * 512, ti, tid); }
        }
        if (l == 0) {
            constexpr int I_IN = (D / 64) * (IN_DIM / 32), I_OUT = (D / 64) * (D / 32), I_GU = (D / 64) * (DEXP / 32), I_DN = (DEXP / 64) * (D / 32);
            constexpr int PER_E = 2 * I_GU + I_DN, PER_L = I_IN + I_OUT + NEXP * PER_E;
            const bool full = F.G >= 176; const int bx = (int)blockIdx.x;
            __syncthreads();
            if (!full || bx < 136 || bx >= 168) {
                LAS float* scr = (LAS float*)(F.lds + F.wave * 8448);
                const int npart = full ? F.G - 32 : F.G, rank = (full && bx >= 168) ? bx - 32 : bx;
                for (int itd = rank * NWAVES + F.wave; itd < I_OUT + DEF0_EXP; itd += npart * NWAVES) {
                    if (itd < I_OUT) { const int r = itd; const int nb = r % (D / 32); p0_transpose_item(w_out, D, D, Wout_t, nb * 32, scr, r, lane); continue; }
                    int r = (PER_L - DEF0_EXP + (itd - I_OUT)) - I_IN - I_OUT;
                    const int e = r / PER_E; r %= PER_E;
                    const size_t le = (size_t)e;
                    if (r < 2 * I_GU) { const int up = r >= I_GU; if (up) r -= I_GU; const int nb = r % (DEXP / 32); const int n0 = nb * 32;
                        const int rowb = (n0 >> 7) * 256 + (n0 & 127) + up * 128;
                        p0_transpose_item((up ? w_up : w_gate) + le * D * DEXP, D, DEXP, Wgu_t + le * (2 * DEXP) * D, rowb, scr, r, lane); continue; } r -= 2 * I_GU;
                    { const int nb = r % (D / 32); p0_transpose_item(w_down + le * DEXP * D, DEXP, D, Wdn_t + le * D * DEXP, nb * 32, scr, r, lane); }
                }
            }
        }
    }
    if (kk == 3) {
        PHASE_PROLOG;
        if (l == 0) {
            pg8::Prob P{CSC, PQTC, 2 * CTXL, 2 * CTXL, 2 * CTXL, 0, 0, 0, 0, (long long)256 * 2 * CTXL, (long long)512 * 2 * CTXL, 0};
            pg8::DftBSched S{4, F.G, (F.G == 256 && blockIdx.x >= 4) ? (int)blockIdx.x - 4 : ((F.G == 256) ? 4 : (int)blockIdx.x), 1};
            pg8::EpiDftB E{PARTC - (size_t)MLAT * 512, MLAT, 0, CTXL};
            pg8::gemm_phase<pg8::EpiDftB, pg8::DftBSched, false, true>(F.lds + RING_OFF, P, S, E, rows_lds, F.wave);
            __syncthreads();
        }
        {
            const int pairq = F.wave >> 1, hh = F.wave & 1;
            LAS unsigned short* rowbuf = (LAS unsigned short*)(F.lds + RING_OFF) + pairq * 8192;
            LAS float* altp = (LAS float*)(F.lds + RING_OFF + 65536);
            const bool ctxwg_ = (l == 0) && F.G == 256 && blockIdx.x >= 4 && blockIdx.x < 8;
            const int xb_ = (int)blockIdx.x - 4;
            int extra_ = ((l == 0) && F.G == 256 && blockIdx.x >= 8 && blockIdx.x < 12) ? ((xb_ & 7) * (F.G >> 3) + (xb_ >> 3)) * 4 : 2 * 512;
            int it0 = ctxwg_ ? 2 * 512 : F.vcu * 4;
#pragma unroll 1
            for (;; it0 += F.G * 4) {
                if (it0 >= 2 * 512) { if (extra_ >= 2 * 512) break; it0 = extra_; extra_ = 2 * 512; }
                const int it = it0 + pairq;
                const int ln = opqv(lane);
                const bf16_t* src = PQT + (size_t)it * 8192;
                pg8::u32x4 rv[8];
#pragma unroll
                for (int i = 0; i < 8; ++i) rv[i] = *(const pg8::u32x4*)(src + (size_t)(ln + 64 * (8 * hh + i)) * 8);
#pragma unroll
                for (int i = 0; i < 8; ++i) *(LAS pg8::u32x4*)(rowbuf + (ln + 64 * (8 * hh + i)) * 8) = rv[i];
                __syncthreads();
                const int b = it >> 9, n = it & 511;
                bf16_t* pe_row = PEQO + (size_t)((b * 2 + 0) * 512 + n) * 2048; bf16_t* qo_row = PEQO + (size_t)((b * 2 + 1) * 512 + n) * 2048;
                float alt = 0.f;
#pragma unroll
                for (int i2 = 0; i2 < 2; ++i2) {
                    const int t0 = 8 * (ln + 64 * (2 * hh + i2));
                    float p8[8], q8[8], pm[8], qm[8];
                    unpack8(*(const LAS pg8::u32x4*)(rowbuf + t0), p8); unpack8(*(const LAS pg8::u32x4*)(rowbuf + 4096 + t0), q8);
                    unpack8(*(const LAS pg8::u32x4*)(rowbuf + 4096 - t0 - 8), pm); unpack8(*(const LAS pg8::u32x4*)(rowbuf + 8192 - t0 - 8), qm);
                    const float pm0 = bf2f(rowbuf[4096 - t0]), qm0 = bf2f(rowbuf[(8192 - t0) & 8191]);
                    float pe[8], qo[8];
                    pe[0] = (t0 == 0) ? p8[0] : p8[0] + pm0; qo[0] = (t0 == 0) ? 0.f : q8[0] - qm0;
#pragma unroll
                    for (int j = 1; j < 8; ++j) { pe[j] = p8[j] + pm[8 - j]; qo[j] = q8[j] - qm[8 - j]; }
#pragma unroll
                    for (int j = 0; j < 8; ++j) alt += (j & 1) ? -pe[j] : pe[j];
                    pg8::u32x4 o1, o2;
#pragma unroll
                    for (int e = 0; e < 4; ++e) { o1[e] = pg8::cvt_pk_bf16(pe[2 * e], pe[2 * e + 1]); o2[e] = pg8::cvt_pk_bf16(qo[2 * e], qo[2 * e + 1]); }
                    *(pg8::u32x4*)(pe_row + t0) = o1; *(pg8::u32x4*)(qo_row + t0) = o2;
                }
                alt = wave_sum(alt);
                if (ln == 0) altp[pairq * 2 + hh] = alt;
                __syncthreads();
                if (hh == 0 && ln == 0) { const float ph = bf2f(rowbuf[2048]); AUXB[b * 1024 + n] = altp[pairq * 2] + altp[pairq * 2 + 1] + ph; AUXB[b * 1024 + 512 + n] = ph; }
                __syncthreads();
            }
        }
        __syncthreads();
    }
    if (kk == 4) {
        PHASE_PROLOG;
        pg8::Prob P{CS, PEQO, 2048, 2048, 512, 0, (long long)256 * 2048, 0, 512, (long long)256 * 2048, (long long)2 * 512 * 2048, 512};
        pg8::DftB2Sched S{256, F.G, (int)blockIdx.x, 0};
        pg8::EpiDftB2 E{(bf16_t*)PART};
        pg8::gemm_phase<pg8::EpiDftB2, pg8::DftB2Sched, false, true>(F.lds + RING_OFF, P, S, E, rows_lds, F.wave);
    }
    if (kk == 5) {
        PHASE_PROLOG;
        float sc_lat = 0.001381067932f, sc_ctx = 0.005524271728f;
        asm volatile("" : "+v"(sc_lat), "+v"(sc_ctx));
        for (int it = blockIdx.x * (NWAVES * 64) + tid; it < 2 * 2048 * 128; it += F.G * NWAVES * 64) {
            const int b = it >> 18, tp = (it >> 7) & 2047, n = (it & 127) * 4;
            f32x4 e = {0.f, 0.f, 0.f, 0.f}, o = e;
            { const bf16_t* pb = (const bf16_t*)PART;
#pragma unroll
              for (int sp = 0; sp < 4; ++sp) { const pg8::u32x2 a = *(const pg8::u32x2*)(pb + ((size_t)(((sp * 2 + 0) * 2 + b) * 2048 + tp)) * 512 + n), c = *(const pg8::u32x2*)(pb + ((size_t)(((sp * 2 + 1) * 2 + b) * 2048 + tp)) * 512 + n);
                  e[0] += __uint_as_float(a.x << 16); e[1] += __uint_as_float(a.x & 0xffff0000u); e[2] += __uint_as_float(a.y << 16); e[3] += __uint_as_float(a.y & 0xffff0000u);
                  o[0] += __uint_as_float(c.x << 16); o[1] += __uint_as_float(c.x & 0xffff0000u); o[2] += __uint_as_float(c.y << 16); o[3] += __uint_as_float(c.y & 0xffff0000u); } }
            f32x4 ph = *(const f32x4*)(AUXB + b * 1024 + 512 + n); if (tp & 1) ph = -ph;
            const f32x4 o1 = (e - o + ph) * sc_lat;
            f32x4 o2 = (e + o + ph) * sc_lat;
            if (tp == 0) o2 = *(const f32x4*)(AUXB + b * 1024 + n) * sc_lat;
            const int r2 = (tp == 0) ? 2048 : SEQ - tp;
            pg8::u32x2 w1, w2; w1.x = pk2(o1[0], o1[1]); w1.y = pk2(o1[2], o1[3]); w2.x = pk2(o2[0], o2[1]); w2.y = pk2(o2[2], o2[3]);
            *(pg8::u32x2*)(MIX + (size_t)(b * SEQ + tp) * D + 512 + n) = w1;
            *(pg8::u32x2*)(MIX + (size_t)(b * SEQ + r2) * D + 512 + n) = w2;
        }
        if (l == 0) {
            for (int it = blockIdx.x * (NWAVES * 64) + tid; it < MCTX * 128; it += F.G * NWAVES * 64) {
                const int r = it >> 7, n = (it & 127) * 4;
                const f32x4 a = *(const f32x4*)(PARTC + (size_t)r * 512 + n) * sc_ctx;
                pg8::u32x2 w; w.x = pk2(a[0], a[1]); w.y = pk2(a[2], a[3]); *(pg8::u32x2*)(MIX + (size_t)(MLAT + r) * D + 512 + n) = w;
            }
        }
    }
    if (kk == 6) {
        PHASE_PROLOG; const float* modl = modv + (size_t)l * 3 * NMOD * D; (void)modl;
        pg8::Prob P{MIX, Wout_t + (size_t)l * D * D, D, D, D, 0, (long long)256 * D, 0, 0, (long long)256 * D, 0, 0};
        pg8::StaticOrder S; S.init(mrows / 256, D / 256, F.G, (int)blockIdx.x);
        pg8::EpiG2 E{X, l == 0 ? x_in : X, l == 0 ? ctx_in : X + (size_t)MLAT * D, modl};
        pg8::gemm_phase<pg8::EpiG2, pg8::StaticOrder, false, true>(F.lds + RING_OFF, P, S, E, rows_lds, F.wave);
        if (l == 0) {
            constexpr int I_IN = (D / 64) * (IN_DIM / 32), I_OUT = (D / 64) * (D / 32), I_GU = (D / 64) * (DEXP / 32), I_DN = (DEXP / 64) * (D / 32);
            constexpr int PER_E = 2 * I_GU + I_DN;
            const int nunits = (mrows / 256) * (D / 256), nextra = (nunits > F.G && nunits - F.G < F.G) ? nunits - F.G : 0;
            __syncthreads();
            if ((int)blockIdx.x >= nextra) {
                LAS float* scr = (LAS float*)(F.lds + F.wave * 8448);
                const int npart = F.G - nextra, rank = (int)blockIdx.x - nextra;
                for (int it = rank * NWAVES + F.wave; it < NEXP * PER_E; it += npart * NWAVES) {
                    const int e = it / PER_E; int r = it % PER_E;
                    const size_t le = (size_t)NEXP + e;
                    if (r < 2 * I_GU) { const int up = r >= I_GU; if (up) r -= I_GU; const int nb = r % (DEXP / 32); const int n0 = nb * 32;
                        const int rowb = (n0 >> 7) * 256 + (n0 & 127) + up * 128;
                        p0_transpose_item((up ? w_up : w_gate) + le * D * DEXP, D, DEXP, Wgu_t + le * (2 * DEXP) * D, rowb, scr, r, lane); continue; } r -= 2 * I_GU;
                    { const int nb = r % (D / 32); p0_transpose_item(w_down + le * DEXP * D, DEXP, D, Wdn_t + le * D * DEXP, nb * 32, scr, r, lane); }
                }
            }
        }
    }
    if (kk == 7) {
        PHASE_PROLOG; const float* modl = modv + (size_t)l * 3 * NMOD * D; (void)modl;
        LAS int* sel = (LAS int*)(F.lds + RING_OFF + 139264);
        LAS float* vg = (LAS float*)(F.lds + RING_OFF + 81920);
        for (int e = tid; e < D / 4; e += NWAVES * 64) {
            *(LAS f32x4*)(vg + 4 * e) = *(const f32x4*)(g_norm2 + l * D + 4 * e);
#pragma unroll
            for (int s_ = 0; s_ < 3; ++s_) { const float* shp_ = modl + (size_t)s_ * (NMOD * D) + 3 * D;
                *(LAS f32x4*)(vg + D + (s_ * 2 + 0) * D + 4 * e) = *(const f32x4*)(shp_ + 4 * e); *(LAS f32x4*)(vg + D + (s_ * 2 + 1) * D + 4 * e) = *(const f32x4*)(shp_ + D + 4 * e); }
        }
        __syncthreads();
        LAS float* wt = (LAS float*)(F.lds + RING_OFF);
        unsigned* cnt = F.ctl + 2048 + 1024 * l;
        const int nr = (mrows + F.G - 1) / F.G;
        const int rbeg = F.vcu * nr, rend = min(mrows, rbeg + nr);
        for (int rb = rbeg; rb < rend; rb += 40) {
            const int lim = min(rend, rb + 40);
            N2Ctx C{X, H, vg, vg + D, w_rg + (size_t)l * D * 4, w_re + (size_t)l * D * 16, b_rg + l * 4, b_re + l * 16, tok_e, tok_w, sel, rb};
            n2_pass(C, wt, rb, lim, F.wave, lane, tid, args.ws);
            { unsigned char* probe_ws_ = args.ws; (void)probe_ws_; PROBE_MARK(4); }
            __syncthreads();
            if (F.wave < 2) {
                const int ln = opqv(lane); const int nrw = lim - rb; const int slot = F.wave;
                const int e = (ln < nrw) ? sel[ln * 2 + slot] : -1;
                int rank = 0, mycnt = 0;
#pragma unroll
                for (int x = 0; x < NEXP; ++x) { const unsigned long long m = __ballot(e == x); if (e == x) rank = __popcll(m & ((1ull << ln) - 1ull)); if (ln == x) mycnt = __popcll(m); }
                unsigned base = 0u;
                if (ln < NEXP && mycnt > 0) base = atomicAdd(cnt + 64 * ln, (unsigned)mycnt);
                const unsigned mybase = (unsigned)__shfl((int)base, e < 0 ? 0 : e);
                if (e >= 0) list[(size_t)e * (2 * MROWS) + mybase + rank] = (unsigned)((rb + ln) * 2 + slot);
            }
            __syncthreads();
            { unsigned char* probe_ws_ = args.ws; (void)probe_ws_; PROBE_MARK(5); }
        }
        __syncthreads();
    }
    if (kk == 8 || kk == 9 || kk == 10) {
        PHASE_PROLOG;
        const unsigned* cnt = F.ctl + 2048 + 1024 * l;
        __syncthreads();
        LAS unsigned* cnt_lds = (LAS unsigned*)(F.lds + MISC_OFF + 128);
        if (tid < NEXP) { const unsigned c_ = __hip_atomic_load(cnt + 64 * tid, RLX_AGENT); cnt_lds[tid] = c_; ulist[64 - NEXP + tid] = (int)((c_ + 255u) >> 8); }
        __syncthreads();
        if (tid == 0) { LAS int* pre = ulist + 40; int run = 0; int tl[NEXP];
#pragma unroll
            for (int e = 0; e < NEXP; ++e) tl[e] = ulist[64 - NEXP + e];
            pre[0] = 0;
#pragma unroll
            for (int e = 0; e < NEXP; ++e) { run += tl[e]; pre[e + 1] = run; } }
        __syncthreads();
        const int T = __builtin_amdgcn_readfirstlane(ulist[40 + NEXP]);
        const int G = F.G, bid = (int)blockIdx.x;
        const int NU = 4 * T, ND = 8 * T;
        const int nheavy = min(G, max(0, NU - G)), nlight = G - nheavy;
        const bool lightB = nlight >= G / 4;
        const int Te = lightB ? min(T, G / 4) : 0;
        int ufirst = 0, ustride = 1, ulimit = 0, kind = 0;
        const int hv = (nheavy % 8 == 0) ? (bid % 8) * (nheavy / 8) + bid / 8 : bid;
        if (kk == 8) { kind = 0; ufirst = F.vcu; ustride = G; ulimit = min(NU, G); }
        else if (kk == 9) { if (bid < nheavy) { kind = 0; ufirst = hv + G; ustride = G; ulimit = NU; }
                            else if (lightB) { kind = 1; ufirst = bid - nheavy; ustride = nlight; ulimit = 8 * Te; } }
        else { kind = 1; ufirst = 8 * Te + bid; ustride = G; ulimit = ND; }
        const int NPN = kind ? 8 : 4;
        for (int u0 = ufirst; u0 < ulimit; u0 += 4 * ustride) {
            __syncthreads();
            if (tid == 0) { const LAS int* pre = ulist + 40; int n = 0;
                for (int i = 0; i < 4; ++i) { const int L = u0 + i * ustride; if (L >= ulimit) break; const int tau = L / NPN; int e = 0; while (pre[e + 1] <= tau) ++e;
                    ulist[n * 4] = tau; ulist[n * 4 + 1] = L % NPN; ulist[n * 4 + 2] = e; ulist[n * 4 + 3] = tau - pre[e]; ++n; }
                ulist[32] = n; }
            __syncthreads();
            const int nu = __builtin_amdgcn_readfirstlane(ulist[32]);
            for (int i = 0; i < nu; ++i) { const int e = ulist[i * 4 + 2], rt = ulist[i * 4 + 3]; const unsigned ce = cnt_lds[e];
                for (int r = tid; r < 256; r += NWAVES * 64) { const unsigned idx = (unsigned)rt * 256u + (unsigned)r; ((LAS unsigned*)(F.lds + ROWS_OFF))[i * 256 + r] = idx < ce ? list[(size_t)e * (2 * MROWS) + idx] : 0xFFFFFFFFu; } }
            __syncthreads();
            pg8::ListSched S{(const PG8_LAS int*)ulist, nu};
            if (kind == 0) {
                pg8::Prob P{H, Wgu_t + (size_t)l * NEXP * (2 * DEXP) * D, D, D, D, 0, 0, 0, 0, (long long)256 * D, (long long)(2 * DEXP) * D, 0};
                pg8::EpiMoeUp E{HIDB, tok_w, rows_lds};
                pg8::gemm_phase<pg8::EpiMoeUp, pg8::ListSched, true, true>(F.lds + RING_OFF, P, S, E, rows_lds, F.wave);
            } else {
                pg8::Prob P{HIDB, Wdn_t + (size_t)l * NEXP * D * DEXP, DEXP, DEXP, DEXP, 0, (long long)256 * DEXP, 0, 0, (long long)256 * DEXP, (long long)D * DEXP, 0};
                pg8::EpiMoeDown E{Y2, rows_lds};
                pg8::gemm_phase<pg8::EpiMoeDown, pg8::ListSched, false, true>(F.lds + RING_OFF, P, S, E, rows_lds, F.wave);
            }
        }
        if (kk == 10 && l == 0) {
            constexpr int I_IN = (D / 64) * (IN_DIM / 32), I_OUT = (D / 64) * (D / 32);
            __syncthreads();
            if (bid >= G / 2) {
                LAS float* scr = (LAS float*)(F.lds + F.wave * 8448);
                const int npart = G - G / 2, rank = bid - G / 2;
                for (int it = rank * NWAVES + F.wave; it < I_IN + I_OUT; it += npart * NWAVES) {
                    int r = it;
                    if (r < I_IN) { const int nb = r % (IN_DIM / 32); p0_transpose_item(w_in + (size_t)D * IN_DIM, D, IN_DIM, Win_t + (size_t)IN_DIM * D, nb * 32, scr, r, lane); continue; } r -= I_IN;
                    { const int nb = r % (D / 32); p0_transpose_item(w_out + (size_t)D * D, D, D, Wout_t + (size_t)D * D, nb * 32, scr, r, lane); }
                }
            }
        }
    }
    if (kk == -2) {
        PHASE_PROLOG;
        const float* modl1 = modv + (size_t)3 * NMOD * D;
        const int l4 = lane * 4;
        LAS float* vg = (LAS float*)(F.lds + RING_OFF);
        for (int e = tid; e < D / 4; e += NWAVES * 64) {
            *(LAS f32x4*)(vg + 4 * e) = *(const f32x4*)(g_final + 4 * e);
#pragma unroll
            for (int s_ = 0; s_ < 3; ++s_) *(LAS f32x4*)(vg + (1 + s_) * D + 4 * e) = *(const f32x4*)(modl1 + (size_t)s_ * (NMOD * D) + 5 * D + 4 * e);
        }
        __syncthreads();
        f32x4 vn[8]; pg8::u32x2 yn0[8], yn1[8];
        int row = gw;
        { const int r0 = min(row, MLAT - 1);
#pragma unroll
            for (int j = 0; j < 8; ++j) { vn[j] = *(const f32x4*)(X + (size_t)r0 * D + l4 + 256 * j); yn0[j] = *(const pg8::u32x2*)(Y2 + (size_t)(2 * r0) * D + l4 + 256 * j); yn1[j] = *(const pg8::u32x2*)(Y2 + (size_t)(2 * r0 + 1) * D + l4 + 256 * j); } }
#pragma unroll 1
        for (; row < MLAT; row += NGW) {
            const int l4 = opqv(lane * 4);
            const int s = modsel(row);
            const float* ga = modl1 + (size_t)s * (NMOD * D) + 5 * D;
            f32x4 v[8]; pg8::u32x2 y0[8], y1[8];
#pragma unroll
            for (int j = 0; j < 8; ++j) { v[j] = vn[j]; y0[j] = yn0[j]; y1[j] = yn1[j]; }
            const int nrow = min(row + NGW, MLAT - 1);
            {
#pragma unroll
                for (int j = 0; j < 8; ++j) { vn[j] = *(const f32x4*)(X + (size_t)nrow * D + l4 + 256 * j); yn0[j] = *(const pg8::u32x2*)(Y2 + (size_t)(2 * nrow) * D + l4 + 256 * j); yn1[j] = *(const pg8::u32x2*)(Y2 + (size_t)(2 * nrow + 1) * D + l4 + 256 * j); } }
            float ss = 0.f;
#pragma unroll
            for (int j = 0; j < 8; ++j) { const int col = l4 + 256 * j; const f32x4 g = *(const LAS f32x4*)(vg + (1 + s) * D + col);
                v[j][0] += g[0] * (__uint_as_float(y0[j].x << 16) + __uint_as_float(y1[j].x << 16)); v[j][1] += g[1] * (__uint_as_float(y0[j].x & 0xffff0000u) + __uint_as_float(y1[j].x & 0xffff0000u));
                v[j][2] += g[2] * (__uint_as_float(y0[j].y << 16) + __uint_as_float(y1[j].y << 16)); v[j][3] += g[3] * (__uint_as_float(y0[j].y & 0xffff0000u) + __uint_as_float(y1[j].y & 0xffff0000u));
                ss += v[j][0] * v[j][0] + v[j][1] * v[j][1] + v[j][2] * v[j][2] + v[j][3] * v[j][3]; }
            ss = wave_sum(ss);
            const float rstd = rsqrtf(ss * (1.f / D) + 1e-6f);
#pragma unroll
            for (int j = 0; j < 8; ++j) { const int col = l4 + 256 * j; const f32x4 g = *(const LAS f32x4*)(vg + col); *(f32x4*)(args.out + (size_t)row * D + col) = v[j] * rstd * g; }
        }
    }
    if (pi + 1 < hi) GRID_BAR();
#ifdef PROBE_TA
    if (blockIdx.x == PROBE_BLK && F.wave == 0 && hw_lane_id() == 0) TS_PTR[pi + 1] = rt_now();
#endif
  }
#undef gw
#undef NGW
#ifdef PROBE_TA
    if (blockIdx.x == PROBE_BLK && F.wave == 0 && hw_lane_id() == 0) {
        const unsigned long long dt = TS_PTR[PROBE_TB] - TS_PTR[PROBE_TA]; const unsigned long long t0 = __builtin_amdgcn_s_memrealtime();
        while (__builtin_amdgcn_s_memrealtime() - t0 < 4ull * dt) __builtin_amdgcn_s_sleep(8);
    }
#endif
#undef x_in
#undef c_in
#undef ctx_in
#undef c_ctx
#undef w_mod
#undef b_mod
#undef w_in
#undef w_out
#undef w_gate
#undef w_up
#undef w_down
#undef modv
#undef rope
#undef tok_w
#undef tok_e
#undef list
#undef X
#undef H
#undef U
#undef MIX
#undef Y2
#undef Win_t
#undef Wout_t
#undef Wgu_t
#undef Wdn_t
#undef CS
#undef CSC
#undef PEQO
#undef AUXB
#undef PARTC
#undef WC
#undef PQT
#undef PQTC
#undef PART
#undef HIDB
#undef g_norm1
#undef g_norm2
#undef g_final
#undef w_rg
#undef b_rg
#undef w_re
#undef b_re
#undef PC_OF
#undef GRID_BAR
}

static int g_grid = 0;
static void mega_launch(MArgs a, int lo, int hi, int layer, int use_bar, hipStream_t stream) {
    a.ph_lo = lo; a.ph_hi = hi; a.layer = layer; a.use_bar = use_bar;
    hipLaunchKernelGGL(mega_fwd, dim3(g_grid), dim3(NWAVES * 64), LDS_BYTES, stream, a);
}
extern "C" void kernel_launch(void* const* d_in, const int* in_sizes, int n_in, void* d_out, int out_size, void* d_ws, size_t ws_size, hipStream_t stream) {
    if (g_grid == 0) {
        int dev = 0, cus = 0;
        (void)hipGetDevice(&dev); (void)hipDeviceGetAttribute(&cus, hipDeviceAttributeMultiprocessorCount, dev);
        (void)hipFuncSetAttribute((const void*)mega_fwd, hipFuncAttributeMaxDynamicSharedMemorySize, LDS_BYTES);
        g_grid = cus > 0 ? cus : 256;
    }
    unsigned char* ws = (unsigned char*)d_ws;
    unsigned* ctl = (unsigned*)(ws + WS_CTL);
    float* out = (float*)d_out;
    MArgs a{};
    for (int i = 0; i < 24; ++i) a.in[i] = (const float*)d_in[i];
    a.out = out; a.ws = ws;
    (void)hipMemsetAsync(ctl, 0, 65536, stream);
#ifdef PROBE_DUP
    mega_launch(a, 0, 25, 0, 1, stream);
#else
    mega_launch(a, 0, 24, 0, 1, stream);
#endif
}
```
